# Optimizing an MI355X kernel written in HIP

```python
import math
import jax, jax.numpy as jnp
from jax import lax
import numpy as np

D_MODEL = 4096
BATCH = 4
SEQ = 2048
DEPTH = 1

CHUNK = 64
DN_HEADS = 16
DN_DK = 128
DN_DV = 128
DN_CONV = 4
DN_KEY = DN_HEADS * DN_DK
DN_VAL = DN_HEADS * DN_DV
DN_QKV = 2 * DN_KEY + DN_VAL
GLA_HEADS = 8
GLA_DK = 128
GLA_DV = 256
GLA_KEY = GLA_HEADS * GLA_DK
GLA_VAL = GLA_HEADS * GLA_DV
GLA_RANK = 16
GLA_TAU = 16
GLA_BLOCK = 16
D_FF = 11008
FFN_CONV = 3
EPS = 1e-6
IN_SIZES = (DN_QKV, DN_VAL, DN_HEADS, DN_HEADS, GLA_KEY, GLA_KEY, GLA_VAL, GLA_VAL, GLA_RANK, D_MODEL, D_MODEL)
IN_COLS = DN_QKV + DN_VAL + 2 * DN_HEADS + 2 * GLA_KEY + 2 * GLA_VAL + GLA_RANK + 2 * D_MODEL

kernel_name = 'hybrid_gdn_gla_convglu_block'


def rms_norm(x, w):
    xf = x.astype(jnp.float32)
    y = xf * lax.rsqrt(jnp.mean(xf * xf, axis=-1, keepdims=True) + EPS)
    return (y * w.astype(jnp.float32)).astype(x.dtype)


def gated_rms_norm(o, w, z):
    of = o.astype(jnp.float32)
    y = of * lax.rsqrt(jnp.mean(of * of, axis=-1, keepdims=True) + EPS)
    return y * w.astype(jnp.float32) * jax.nn.silu(z.astype(jnp.float32))


def l2_norm(x):
    return x * lax.rsqrt(jnp.sum(x * x, axis=-1, keepdims=True) + EPS)


def causal_dwconv(x, w):
    K = w.shape[0]
    T = x.shape[1]
    xp = jnp.pad(x, ((0, 0), (K - 1, 0), (0, 0)))
    y = xp[:, 0:T, :] * w[0]
    for i in range(1, K):
        y = y + xp[:, i:i + T, :] * w[i]
    return y


def gated_deltanet_chunked(q, k, v, beta, g):
    Bsz, T, H, dk = q.shape
    dv = v.shape[-1]
    N = T // CHUNK

    def chunks(t):
        return t.reshape(Bsz, N, CHUNK, H, t.shape[-1]).transpose(1, 0, 3, 2, 4)

    q = chunks(q) * (DN_DK ** -0.5)
    k = chunks(k)
    v = chunks(v)
    beta = chunks(beta[..., None])[..., 0]
    g = chunks(g[..., None])[..., 0]
    b = jnp.cumsum(g, axis=-1)
    tril = jnp.tril(jnp.ones((CHUNK, CHUNK), bool))
    decay = jnp.exp(jnp.where(tril, b[..., :, None] - b[..., None, :], -jnp.inf))
    k_beta = k * beta[..., None]
    a = jnp.einsum('nbhid,nbhjd->nbhij', k_beta, k) * decay
    eye = jnp.broadcast_to(jnp.eye(CHUNK, dtype=jnp.float32), a.shape)
    t_inv = lax.linalg.triangular_solve(a, eye, left_side=True, lower=True, unit_diagonal=True)
    w = t_inv @ (k_beta * jnp.exp(b)[..., None])
    u = t_inv @ (v * beta[..., None])
    att = jnp.einsum('nbhid,nbhjd->nbhij', q, k) * decay

    def step(S, c):
        qc, kc, uc, wc, attc, bc = c
        v_new = uc - wc @ S
        o = (qc * jnp.exp(bc)[..., None]) @ S + attc @ v_new
        b_last = bc[..., -1:]
        S = jnp.exp(b_last)[..., None] * S + jnp.einsum('bhcd,bhce->bhde', kc * jnp.exp(b_last - bc)[..., None], v_new)
        return S, o

    S0 = jnp.zeros((Bsz, H, dk, dv), jnp.float32)
    _, o = lax.scan(step, S0, (q, k, u, w, att, b))
    return o.transpose(1, 0, 3, 2, 4).reshape(Bsz, T, H, dv)


def gla_chunked(q, k, v, gk):
    Bsz, T, H, dk = q.shape
    dv = v.shape[-1]
    N = T // GLA_BLOCK

    def blocks(t):
        return t.reshape(Bsz, N, GLA_BLOCK, H, t.shape[-1]).transpose(1, 0, 3, 2, 4)

    causal = jnp.tril(jnp.ones((GLA_BLOCK, GLA_BLOCK), bool))[:, :, None]

    def step(S, blk):
        qb, kb, vb, gb = blk
        b = jnp.cumsum(gb, axis=2)
        diff = jnp.where(causal, b[:, :, :, None, :] - b[:, :, None, :, :], -jnp.inf)
        att = jnp.sum(qb[:, :, :, None, :] * kb[:, :, None, :, :] * jnp.exp(diff), axis=-1)
        o = jnp.einsum('bhid,bhde->bhie', qb * jnp.exp(b), S) + jnp.einsum('bhij,bhje->bhie', att, vb)
        b_last = b[:, :, -1:, :]
        S = jnp.exp(b_last[:, :, 0, :, None]) * S + jnp.einsum('bhjd,bhje->bhde', kb * jnp.exp(b_last - b), vb)
        return S, o

    S0 = jnp.zeros((Bsz, H, dk, dv), jnp.float32)
    _, o = lax.scan(step, S0, (blocks(q * (GLA_DK ** -0.5)), blocks(k), blocks(v), blocks(gk)))
    return o.transpose(1, 0, 3, 2, 4).reshape(Bsz, T, H, dv)


def mixer_sublayer(x, norm_w, w_in, dn_conv_w, dn_a_log, dn_dt_bias, dn_norm_w,
                   gla_w_alpha2, gla_b_alpha, gla_norm_w, w_branch_dn, w_branch_gla, w_out):
    Bsz, T, _ = x.shape
    f32 = jnp.float32
    h = rms_norm(x, norm_w)
    proj = h @ w_in
    split_at = list(np.cumsum(IN_SIZES)[:-1])
    (dn_qkv, dn_z, dn_b, dn_a, gl_q, gl_k, gl_v, gl_r, gl_lr, gate_dn, gate_gla) = jnp.split(proj, split_at, axis=-1)

    qkv = jax.nn.silu(causal_dwconv(dn_qkv, dn_conv_w)).astype(f32)
    dq, dk, dv = jnp.split(qkv, [DN_KEY, 2 * DN_KEY], axis=-1)
    dq = l2_norm(dq.reshape(Bsz, T, DN_HEADS, DN_DK))
    dk = l2_norm(dk.reshape(Bsz, T, DN_HEADS, DN_DK))
    dv = dv.reshape(Bsz, T, DN_HEADS, DN_DV)
    beta = jax.nn.sigmoid(dn_b.astype(f32))
    g = -jnp.exp(dn_a_log.astype(f32)) * jax.nn.softplus(dn_a.astype(f32) + dn_dt_bias.astype(f32))
    o_dn = gated_deltanet_chunked(dq, dk, dv, beta, g)
    o_dn = gated_rms_norm(o_dn, dn_norm_w, dn_z.reshape(Bsz, T, DN_HEADS, DN_DV))
    o_dn = o_dn.reshape(Bsz, T, DN_VAL).astype(x.dtype)

    gq = gl_q.astype(f32).reshape(Bsz, T, GLA_HEADS, GLA_DK)
    gk_ = gl_k.astype(f32).reshape(Bsz, T, GLA_HEADS, GLA_DK)
    gv = gl_v.astype(f32).reshape(Bsz, T, GLA_HEADS, GLA_DV)
    log_alpha = jax.nn.log_sigmoid((gl_lr @ gla_w_alpha2 + gla_b_alpha).astype(f32)) / GLA_TAU
    log_alpha = log_alpha.reshape(Bsz, T, GLA_HEADS, GLA_DK)
    o_gla = gla_chunked(gq, gk_, gv, log_alpha)
    o_gla = gated_rms_norm(o_gla, gla_norm_w, gl_r.reshape(Bsz, T, GLA_HEADS, GLA_DV))
    o_gla = o_gla.reshape(Bsz, T, GLA_VAL).astype(x.dtype)

    merged = jax.nn.sigmoid(gate_dn) * (o_dn @ w_branch_dn) + jax.nn.sigmoid(gate_gla) * (o_gla @ w_branch_gla)
    return x + merged @ w_out


def ffn_sublayer(x, norm_w, w_ffn_in, ffn_conv_w, ffn_conv_b, w_ffn_out):
    h = rms_norm(x, norm_w)
    gate, up = jnp.split(h @ w_ffn_in, 2, axis=-1)
    gate = causal_dwconv(gate, ffn_conv_w) + ffn_conv_b
    return x + (jax.nn.silu(gate) * up) @ w_ffn_out


def setup_inputs(seed: int = 0) -> dict:
    key = jax.random.key(seed)
    ks = jax.random.split(key, 20)
    f32 = jnp.float32
    L = DEPTH

    def nrm(k, shape, scale):
        return jax.random.normal(k, shape, f32) * scale

    x = jax.random.normal(ks[0], (BATCH, SEQ, D_MODEL), f32)
    norm_mix_w = 1.0 + nrm(ks[1], (L, D_MODEL), 0.01)
    w_in = nrm(ks[2], (L, D_MODEL, IN_COLS), D_MODEL ** -0.5)
    dn_conv_w = nrm(ks[3], (L, DN_CONV, DN_QKV), DN_CONV ** -0.5)
    dn_a_log = jnp.log(jax.random.uniform(ks[4], (L, DN_HEADS), f32, 1.0, 16.0))
    dt = jnp.exp(jax.random.uniform(ks[5], (L, DN_HEADS), f32, math.log(1e-3), math.log(1e-1)))
    dn_dt_bias = dt + jnp.log(-jnp.expm1(-dt))
    dn_norm_w = 1.0 + nrm(ks[6], (L, DN_DV), 0.01)
    gla_w_alpha2 = nrm(ks[7], (L, GLA_RANK, GLA_KEY), GLA_RANK ** -0.5)
    gla_b_alpha = nrm(ks[8], (L, GLA_KEY), 0.01)
    gla_norm_w = 1.0 + nrm(ks[9], (L, GLA_DV), 0.01)
    w_branch_dn = nrm(ks[10], (L, DN_VAL, D_MODEL), DN_VAL ** -0.5)
    w_branch_gla = nrm(ks[11], (L, GLA_VAL, D_MODEL), GLA_VAL ** -0.5)
    w_out = nrm(ks[12], (L, D_MODEL, D_MODEL), D_MODEL ** -0.5)
    norm_ffn_w = 1.0 + nrm(ks[13], (L, D_MODEL), 0.01)
    w_ffn_in = nrm(ks[14], (L, D_MODEL, 2 * D_FF), D_MODEL ** -0.5)
    ffn_conv_w = nrm(ks[15], (L, FFN_CONV, D_FF), FFN_CONV ** -0.5)
    ffn_conv_b = nrm(ks[16], (L, D_FF), 0.01)
    w_ffn_out = nrm(ks[17], (L, D_FF, D_MODEL), D_FF ** -0.5)
    norm_final_w = 1.0 + nrm(ks[18], (D_MODEL,), 0.01)
    return {'x': x, 'norm_mix_w': norm_mix_w, 'w_in': w_in, 'dn_conv_w': dn_conv_w,
            'dn_a_log': dn_a_log, 'dn_dt_bias': dn_dt_bias, 'dn_norm_w': dn_norm_w,
            'gla_w_alpha2': gla_w_alpha2, 'gla_b_alpha': gla_b_alpha, 'gla_norm_w': gla_norm_w,
            'w_branch_dn': w_branch_dn, 'w_branch_gla': w_branch_gla, 'w_out': w_out,
            'norm_ffn_w': norm_ffn_w, 'w_ffn_in': w_ffn_in, 'ffn_conv_w': ffn_conv_w,
            'ffn_conv_b': ffn_conv_b, 'w_ffn_out': w_ffn_out, 'norm_final_w': norm_final_w}


def reference(x, norm_mix_w, w_in, dn_conv_w, dn_a_log, dn_dt_bias, dn_norm_w,
              gla_w_alpha2, gla_b_alpha, gla_norm_w, w_branch_dn, w_branch_gla, w_out,
              norm_ffn_w, w_ffn_in, ffn_conv_w, ffn_conv_b, w_ffn_out, norm_final_w):
    for l in range(DEPTH):
        x = mixer_sublayer(x, norm_mix_w[l], w_in[l], dn_conv_w[l], dn_a_log[l], dn_dt_bias[l], dn_norm_w[l],
                           gla_w_alpha2[l], gla_b_alpha[l], gla_norm_w[l], w_branch_dn[l], w_branch_gla[l], w_out[l])
        x = ffn_sublayer(x, norm_ffn_w[l], w_ffn_in[l], ffn_conv_w[l], ffn_conv_b[l], w_ffn_out[l])
    return rms_norm(x, norm_final_w)
```

```cpp
#define MK_ONE_LAUNCH 0
#include <hip/hip_runtime.h>
#include <cstdio>
#include <cstdint>
namespace pg8 {
#define PG8_LAS __attribute__((address_space(3)))
typedef unsigned short bf16_t;
typedef short bf16x8 __attribute__((ext_vector_type(8)));
typedef float f32x4 __attribute__((ext_vector_type(4)));
typedef unsigned u32x4 __attribute__((ext_vector_type(4)));
constexpr int BM = 256, BK = 64, HALF = 128, HTB = HALF * BK * 2  , STAGE_BYTES = 8 * HTB, NXCD = 8, WGM = 8;

__host__ __device__ __forceinline__ int lds_byte(int r, int c) { const int st = (r >> 4) * 2 + (c >> 5), rr = r & 15, cc = c & 31, ob = rr * 64 + cc * 2; return st * 1024 + (ob ^ (((ob >> 9) & 1) << 5)); }
__host__ __device__ __forceinline__ void stage_rc(int b, int& R, int& C) { const int st = b / 1024, sb = b % 1024, swz = sb ^ (((sb >> 9) & 1) << 5); R = (st >> 1) * 16 + swz / 64; C = (st & 1) * 32 + (swz % 64) / 2; }
__host__ __device__ __forceinline__ int perm32(int rho) { const int n = rho >> 4, i = rho & 15; return 8 * (i >> 2) + 4 * n + (i & 3); }

struct Unit { int pm, pn; };
struct Gemm { const bf16_t* A; const bf16_t* Bt; int M, N, K; };

struct StaticOrder {
    int nM, nN, nwg, G, c;
    __host__ __device__ void init(int M, int N, int G_, int c_) { nM = M / BM; nN = N / BM; nwg = nM * nN; G = G_; c = c_; }
    __host__ __device__ bool next(int i, Unit& u) const {
        const long L = (long)i * G + c; if (L >= nwg) return false;
        int wgid = (int)L; { const int q = nwg / NXCD, r = nwg % NXCD, xcd = wgid % NXCD, off = wgid / NXCD; wgid = (xcd < r ? xcd * (q + 1) : r * (q + 1) + (xcd - r) * q) + off; }
        const int nig = WGM * nN, gid = wgid / nig, fm = gid * WGM, gsz = (nM - fm) < WGM ? (nM - fm) : WGM;
        u.pm = fm + ((wgid % nig) % gsz); u.pn = (wgid % nig) / gsz; return true;
    }
    __device__ __forceinline__ void a_ready(const Unit&) const {}
    __device__ __forceinline__ void done(const Unit&) const {}
};

__device__ __forceinline__ unsigned cvt_pk_bf16(float lo, float hi) { unsigned r; asm volatile("v_cvt_pk_bf16_f32 %0, %1, %2" : "=v"(r) : "v"(lo), "v"(hi)); return r; }
__device__ __forceinline__ float bf_lo(unsigned w) { return __uint_as_float(w << 16); }
__device__ __forceinline__ float bf_hi(unsigned w) { return __uint_as_float(w & 0xffff0000u); }
__device__ __forceinline__ float sigm(float x) { return 1.0f / (1.0f + __expf(-x)); }
enum { EPI_BF16 = 0, EPI_BRA = 1, EPI_BRB = 2, EPI_RES = 3 };
template <int MODE> struct Epi {
    static constexpr bool PERM = true, AFTER_DRAIN = false;
    bf16_t* Ob; int ldo; float* Of; int ldf; const float* R; int ldr; const bf16_t* Gt; int ldg;
    __device__ __forceinline__ void operator()(const f32x4 (&acc)[2][2][4][2], const Unit& u, int wr, int wc, int fr, int fq) const {
        const int row0 = u.pm * BM + wr * 64 + fr, col0 = u.pn * BM + wc * 32 + 8 * fq;
#pragma unroll
        for (int ai = 0; ai < 2; ++ai)
#pragma unroll
            for (int m = 0; m < 4; ++m) { const size_t row = (size_t)(row0 + ai * HALF + m * 16);
#pragma unroll
                for (int bj = 0; bj < 2; ++bj) { const int col = col0 + bj * HALF; f32x4 v0 = acc[ai][bj][m][0], v1 = acc[ai][bj][m][1];
                    if (MODE == EPI_BRA || MODE == EPI_BRB) { const u32x4 g = *(const u32x4*)(Gt + row * ldg + col);
                        v0[0] *= sigm(bf_lo(g.x)); v0[1] *= sigm(bf_hi(g.x)); v0[2] *= sigm(bf_lo(g.y)); v0[3] *= sigm(bf_hi(g.y));
                        v1[0] *= sigm(bf_lo(g.z)); v1[1] *= sigm(bf_hi(g.z)); v1[2] *= sigm(bf_lo(g.w)); v1[3] *= sigm(bf_hi(g.w)); }
                    if (MODE == EPI_BRB) { const float* t = Of + row * ldf + col; v0 += *(const f32x4*)t; v1 += *(const f32x4*)(t + 4); }
                    if (MODE == EPI_RES) { const float* t = R + row * ldr + col; v0 += *(const f32x4*)t; v1 += *(const f32x4*)(t + 4); }
                    if (MODE == EPI_BF16 || MODE == EPI_BRB) { u32x4 w; w.x = cvt_pk_bf16(v0[0], v0[1]); w.y = cvt_pk_bf16(v0[2], v0[3]); w.z = cvt_pk_bf16(v1[0], v1[1]); w.w = cvt_pk_bf16(v1[2], v1[3]);
                        *(u32x4*)(Ob + row * ldo + col) = w; }
                    else { float* o = Of + row * ldf + col; *(f32x4*)o = v0; *(f32x4*)(o + 4) = v1; } }
                asm volatile("" ::: "memory"); }
    }
};

template <class Epi, class Sched, bool ALIGN_EPI = false, bool SP2 = false>
__device__ __forceinline__ void gemm_phase(PG8_LAS unsigned char* lds, const Gemm g, const Sched& S, const Epi& E) {
    const int tid = threadIdx.x, wid = __builtin_amdgcn_readfirstlane(tid >> 6), lane = tid & 63, wr = wid >> 2, wc = wid & 3, fr = lane & 15, fq = lane >> 4;
    const int K = g.K, nt = K / BK;
    unsigned voffA[2], voffB[2];
#pragma unroll
    for (int i = 0; i < 2; ++i) { int R, C; stage_rc(tid * 16 + i * 8192, R, C); const int Rb = Epi::PERM ? ((R & ~31) + perm32(R & 31)) : R;
        voffA[i] = (unsigned)(R * K + C) * 2u; voffB[i] = (unsigned)(Rb * K + C) * 2u; }
    const size_t kstep = (size_t)(BK * 2);
    const size_t hstep = (size_t)HALF * K * 2;
    const size_t tstep = 2 * hstep;
    const unsigned ldsw = (unsigned)wid * 1024u;
    const int aoff = lds_byte(wr * 64 + fr, fq * 8), boff = lds_byte(wc * 32 + fr, fq * 8);
#define PG8_SA(b, h) (((b) * 2 + (h)) * HTB)
#define PG8_SB(b, h) ((4 + (b) * 2 + (h)) * HTB)
#define PG8_STAGE(bufoff, gbase, voff) do { _Pragma("unroll") for (int _i = 0; _i < 2; ++_i) \
        __builtin_amdgcn_global_load_lds((const unsigned*)((const char*)(gbase) + (voff)[_i]), (PG8_LAS unsigned*)(lds + (bufoff) + ldsw + _i * 8192), 16, 0, 0); } while (0)
#define PG8_LDA(dst, b, h) do { _Pragma("unroll") for (int m = 0; m < 4; ++m) _Pragma("unroll") for (int k = 0; k < 2; ++k) dst[m][k] = *(const PG8_LAS bf16x8*)(lds + PG8_SA(b, h) + aoff + m * 2048 + k * 1024); } while (0)
#define PG8_LDB(dst, b, h) do { _Pragma("unroll") for (int n = 0; n < 2; ++n) _Pragma("unroll") for (int k = 0; k < 2; ++k) dst[n][k] = *(const PG8_LAS bf16x8*)(lds + PG8_SB(b, h) + boff + n * 2048 + k * 1024); } while (0)
#define PG8_MMA(ai, bj, At, Bt) do { __builtin_amdgcn_s_setprio(1); _Pragma("unroll") for (int m = 0; m < 4; ++m) _Pragma("unroll") for (int n = 0; n < 2; ++n) _Pragma("unroll") for (int k = 0; k < 2; ++k) \
        acc[ai][bj][m][n] = __builtin_amdgcn_mfma_f32_16x16x32_bf16(Bt[n][k], At[m][k], acc[ai][bj][m][n], 0, 0, 0); __builtin_amdgcn_s_setprio(0); } while (0)
#define PG8_WAIT_V(n) asm volatile("s_waitcnt vmcnt(" #n ")" ::: "memory")
#define PG8_WAIT_L(n) asm volatile("s_waitcnt lgkmcnt(" #n ")" ::: "memory")
#define PG8_BAR __builtin_amdgcn_s_barrier()
#define PG8_SCHED __builtin_amdgcn_sched_barrier(0)
    Unit cur, nxt; int ui = 0;
    if (!S.next(0, cur)) return;
    f32x4 acc[2][2][4][2];
#pragma unroll
    for (int a = 0; a < 2; ++a)
#pragma unroll
        for (int b = 0; b < 2; ++b)
#pragma unroll
            for (int m = 0; m < 4; ++m)
#pragma unroll
                for (int n = 0; n < 2; ++n) acc[a][b][m][n] = (f32x4){0.f, 0.f, 0.f, 0.f};
    bf16x8 At[4][2], B0[2][2], B1[2][2];
    const char* cA = (const char*)g.A + (size_t)cur.pm * tstep; const char* cB = (const char*)g.Bt + (size_t)cur.pn * tstep;
    S.a_ready(cur);
    if constexpr (SP2) {
        PG8_STAGE(PG8_SB(0, 0), cB, voffB); PG8_STAGE(PG8_SB(0, 1), cB + hstep, voffB); PG8_STAGE(PG8_SA(0, 0), cA, voffA); PG8_STAGE(PG8_SA(0, 1), cA + hstep, voffA);
        if (wr == 1) PG8_BAR;
        PG8_WAIT_V(2); PG8_BAR;
        PG8_STAGE(PG8_SB(1, 0), cB + kstep, voffB); PG8_STAGE(PG8_SA(1, 0), cA + kstep, voffA); PG8_STAGE(PG8_SB(1, 1), cB + hstep + kstep, voffB);
        PG8_WAIT_V(6); PG8_BAR;
    } else {
        PG8_STAGE(PG8_SB(0, 0), cB, voffB); PG8_STAGE(PG8_SA(0, 0), cA, voffA); PG8_STAGE(PG8_SB(0, 1), cB + hstep, voffB); PG8_STAGE(PG8_SA(0, 1), cA + hstep, voffA);
        if (wr == 1) PG8_BAR;
        PG8_WAIT_V(4); PG8_BAR;
        PG8_STAGE(PG8_SB(1, 0), cB + kstep, voffB); PG8_STAGE(PG8_SA(1, 0), cA + kstep, voffA); PG8_STAGE(PG8_SB(1, 1), cB + hstep + kstep, voffB);
        PG8_WAIT_V(6); PG8_BAR;
    }
    for (;;) {
        const bool has_next = S.next(ui + 1, nxt);
        const char* nA = has_next ? (const char*)g.A + (size_t)nxt.pm * tstep : cA; const char* nB = has_next ? (const char*)g.Bt + (size_t)nxt.pn * tstep : cB;
        for (int t = 0; t < nt; t += 2) {
            const bool last = (t == nt - 2);
            const char* a1 = cA + (size_t)(t + 1) * kstep;
            const char* a2 = last ? nA : cA + (size_t)(t + 2) * kstep; const char* b2 = last ? nB : cB + (size_t)(t + 2) * kstep;
            const char* a3 = a2 + kstep; const char* b3 = b2 + kstep;
            if (last && has_next) S.a_ready(nxt);
            if constexpr (SP2) {
            PG8_LDB(B0, 0, 0); PG8_LDB(B1, 0, 1); PG8_SCHED; PG8_LDA(At, 0, 0); PG8_STAGE(PG8_SA(1, 1), a1 + hstep, voffA);
            PG8_WAIT_V(8); PG8_WAIT_L(0); PG8_BAR; PG8_MMA(0, 0, At, B0); PG8_MMA(0, 1, At, B1); PG8_BAR; PG8_SCHED;
            PG8_LDA(At, 0, 1); PG8_STAGE(PG8_SB(0, 0), b2, voffB); PG8_STAGE(PG8_SB(0, 1), b2 + hstep, voffB); PG8_STAGE(PG8_SA(0, 0), a2, voffA);
            PG8_WAIT_V(8); PG8_WAIT_L(0); PG8_BAR; PG8_MMA(1, 0, At, B0); PG8_MMA(1, 1, At, B1); PG8_BAR; PG8_SCHED;
            PG8_LDB(B0, 1, 0); PG8_LDB(B1, 1, 1); PG8_SCHED; PG8_LDA(At, 1, 0); PG8_STAGE(PG8_SA(0, 1), a2 + hstep, voffA);
            PG8_WAIT_V(8); PG8_WAIT_L(0); PG8_BAR; PG8_MMA(0, 0, At, B0); PG8_MMA(0, 1, At, B1); PG8_BAR; PG8_SCHED;
            PG8_LDA(At, 1, 1); PG8_STAGE(PG8_SB(1, 0), b3, voffB); PG8_STAGE(PG8_SB(1, 1), b3 + hstep, voffB); PG8_STAGE(PG8_SA(1, 0), a3, voffA);
            PG8_WAIT_V(8); PG8_WAIT_L(0); PG8_BAR; PG8_MMA(1, 0, At, B0); PG8_MMA(1, 1, At, B1); PG8_BAR; PG8_SCHED;
            } else {
            PG8_LDB(B0, 0, 0); PG8_SCHED; PG8_LDA(At, 0, 0); PG8_STAGE(PG8_SA(1, 1), a1 + hstep, voffA);
            PG8_WAIT_L(8); PG8_BAR; PG8_WAIT_L(0); PG8_MMA(0, 0, At, B0); PG8_BAR; PG8_SCHED;
            PG8_LDB(B1, 0, 1); PG8_STAGE(PG8_SB(0, 0), b2, voffB);
            PG8_BAR; PG8_WAIT_L(0); PG8_MMA(0, 1, At, B1); PG8_BAR;
            PG8_LDA(At, 0, 1); PG8_STAGE(PG8_SA(0, 0), a2, voffA);
            PG8_BAR; PG8_WAIT_L(0); PG8_MMA(1, 0, At, B0); PG8_BAR; PG8_SCHED;
            PG8_STAGE(PG8_SB(0, 1), b2 + hstep, voffB);
            PG8_WAIT_V(6); PG8_BAR; PG8_MMA(1, 1, At, B1); PG8_BAR;
            PG8_LDB(B0, 1, 0); PG8_SCHED; PG8_LDA(At, 1, 0); PG8_STAGE(PG8_SA(0, 1), a2 + hstep, voffA);
            PG8_WAIT_L(8); PG8_BAR; PG8_WAIT_L(0); PG8_MMA(0, 0, At, B0); PG8_BAR; PG8_SCHED;
            PG8_LDB(B1, 1, 1); PG8_STAGE(PG8_SB(1, 0), b3, voffB);
            PG8_BAR; PG8_WAIT_L(0); PG8_MMA(0, 1, At, B1); PG8_BAR;
            PG8_LDA(At, 1, 1); PG8_STAGE(PG8_SA(1, 0), a3, voffA);
            PG8_BAR; PG8_WAIT_L(0); PG8_MMA(1, 0, At, B0); PG8_BAR; PG8_SCHED;
            PG8_STAGE(PG8_SB(1, 1), b3 + hstep, voffB);
            PG8_WAIT_V(6); PG8_BAR; PG8_MMA(1, 1, At, B1); PG8_BAR;
            }
        }
        if constexpr (ALIGN_EPI) { if (wr == 0) PG8_BAR; }
        if constexpr (!Epi::AFTER_DRAIN) { E(acc, cur, wr, wc, fr, fq); S.done(cur); }
        if (!has_next) break;
#pragma unroll
        for (int a = 0; a < 2; ++a)
#pragma unroll
            for (int b = 0; b < 2; ++b)
#pragma unroll
                for (int m = 0; m < 4; ++m)
#pragma unroll
                    for (int n = 0; n < 2; ++n) acc[a][b][m][n] = (f32x4){0.f, 0.f, 0.f, 0.f};
        cur = nxt; cA = nA; cB = nB; ++ui;
        if constexpr (ALIGN_EPI) { if (wr == 1) PG8_BAR; }
    }
    PG8_WAIT_V(0);
    if constexpr (!ALIGN_EPI) { if (wr == 0) PG8_BAR; }
    PG8_BAR;
    if constexpr (Epi::AFTER_DRAIN) { E.fused(acc, cur, wr, wc, fr, fq, lds, wid, lane); S.done(cur); }
#undef PG8_SA
#undef PG8_SB
#undef PG8_STAGE
#undef PG8_LDA
#undef PG8_LDB
#undef PG8_MMA
#undef PG8_WAIT_V
#undef PG8_WAIT_L
#undef PG8_BAR
#undef PG8_SCHED
}
}

constexpr int NWAVES = 8;
constexpr int BATCH = 4, SEQ = 2048, D = 4096, M = BATCH * SEQ;
constexpr int DN_H = 16, DN_DK = 128, DN_DV = 128, DN_KEY = 2048, DN_VAL = 2048, DN_QKV = 6144;
constexpr int GL_H = 8, GL_DK = 128, GL_DV = 256, GL_KEY = 1024, GL_VAL = 2048, GL_RANK = 16;
constexpr int DFF = 11008, IN_COLS = 22576;
constexpr float EPS = 1e-6f;
constexpr int PN = 22528;
constexpr int PC_QKV = 0, PC_Z = 6144, PC_GQ = 8192, PC_GK = 9216, PC_GV = 10240, PC_GR = 12288, PC_GATE_DN = 14336, PC_GATE_GLA = 18432;
constexpr int PSM = 64;
constexpr int NGU = 2 * DFF;

constexpr size_t MiB = 1u << 20;
constexpr size_t WS_CTL = 0, CTL_ZERO_BYTES = 1 * MiB;
constexpr size_t WS_WIN = 1 * MiB, WS_WSM = 177 * MiB, WS_WBDN = 178 * MiB, WS_WBGLA = 194 * MiB, WS_WOUT = 210 * MiB, WS_WFIN = 242 * MiB, WS_WFOUT = 414 * MiB;
constexpr size_t WS_H = 500 * MiB, WS_PROJ = 564 * MiB, WS_PSMALL = 916 * MiB;
constexpr size_t WS_QF = 918 * MiB, WS_KF = 982 * MiB, WS_VF = 1046 * MiB, WS_EK = 1110 * MiB, WS_BETA = 1142 * MiB, WS_G = 1143 * MiB;
constexpr size_t WS_ODN = 1144 * MiB, WS_OGLA = 1208 * MiB, WS_ONDN = 1272 * MiB, WS_ONGLA = 1304 * MiB, WS_END = 1336 * MiB;
constexpr size_t WS_TMP = 918 * MiB, WS_MERGED = 1046 * MiB, WS_X1 = 1110 * MiB, WS_GU = WS_PROJ, WS_HID = WS_WIN;
static_assert(WS_WIN + (size_t)PN * D * 2 <= WS_WSM && WS_WFIN + (size_t)NGU * D * 2 <= WS_WFOUT && WS_WFOUT + (size_t)D * DFF * 2 <= WS_H, "ws map (weights)");
static_assert(WS_PROJ + (size_t)M * PN * 2 <= WS_PSMALL && WS_GU + (size_t)M * NGU * 2 <= WS_PSMALL && WS_HID + (size_t)M * DFF * 2 <= WS_WSM, "ws map (activations)");
static_assert(WS_X1 + (size_t)M * D * 4 <= WS_ONDN, "ws map (x1)");
constexpr int CW_BAR = 4096;

constexpr int RING_OFF = 0, RING_BYTES = 131072;
constexpr int LDSCTL_OFF = RING_BYTES, MISC_OFF = LDSCTL_OFF + 320;
constexpr int LDS_BYTES = 147456;

#define GAS __attribute__((address_space(1)))
#define LAS __attribute__((address_space(3)))
typedef unsigned short bf16;
typedef unsigned v4u __attribute__((ext_vector_type(4)));
typedef unsigned v2u __attribute__((ext_vector_type(2)));
typedef float f32x4 __attribute__((ext_vector_type(4)));
typedef float f32x2 __attribute__((ext_vector_type(2)));
typedef short bf16x8 __attribute__((ext_vector_type(8)));
typedef GAS unsigned gu32;
#define RLX_AGENT __ATOMIC_RELAXED, __HIP_MEMORY_SCOPE_AGENT
#define LDS_WAIT() asm volatile("s_waitcnt lgkmcnt(0)" ::: "memory")
#define VM_WAIT() asm volatile("s_waitcnt vmcnt(0)" ::: "memory")
__device__ __forceinline__ unsigned f2bf(float f) { unsigned u = __builtin_bit_cast(unsigned, f); return (u + 0x7fffu + ((u >> 16) & 1u)) >> 16; }
__device__ __forceinline__ unsigned pk2(float lo, float hi) { return f2bf(lo) | (f2bf(hi) << 16); }
__device__ __forceinline__ float bflo(unsigned w) { return __uint_as_float(w << 16); }
__device__ __forceinline__ float bfhi(unsigned w) { return __uint_as_float(w & 0xffff0000u); }
__device__ __forceinline__ float bf1(bf16 b) { return __uint_as_float((unsigned)b << 16); }
__device__ __forceinline__ float sigmoid_f(float x) { return 1.0f / (1.0f + expf(-x)); }
__device__ __forceinline__ float silu_f(float x) { return x / (1.0f + expf(-x)); }
__device__ __forceinline__ float softplus_f(float x) { return fmaxf(x, 0.f) + log1pf(expf(-fabsf(x))); }
__device__ __forceinline__ float logsigmoid_f(float x) { return fminf(x, 0.f) - log1pf(expf(-fabsf(x))); }
__device__ __forceinline__ float wave_sum(float v) {
#pragma unroll
    for (int o = 1; o < 64; o <<= 1) v += __shfl_xor(v, o);
    return v;
}

#define XB_TMO      128
#define XB_XCNT(j)  (256  + 64 * (j))
#define XB_XSUB(j)  (1280 + 64 * (j))
#define XB_XGEN(j)  (2304 + 64 * (j))
#define XB_TOP      3328
#define XB_TOPGEN   3392
#define XCD_BAR_WORDS 3456
#define XB_SPIN_CAP (1u << 18)

__device__ __forceinline__ unsigned xb_ld(unsigned* p)              { return __hip_atomic_load(p, __ATOMIC_RELAXED, __HIP_MEMORY_SCOPE_AGENT); }
__device__ __forceinline__ unsigned xb_add(unsigned* p, unsigned v) { return __hip_atomic_fetch_add(p, v, __ATOMIC_RELAXED, __HIP_MEMORY_SCOPE_AGENT); }
__device__ __forceinline__ unsigned xb_xcc_id() { return (unsigned)__builtin_amdgcn_s_getreg((3 << 11) | 20) & 0xFu; }
#define XB_SPIN(cond, bar) do { unsigned _sp = 0; while (cond) { __builtin_amdgcn_s_sleep(1); \
    if ((++_sp & 255u) == 0u) { if (xb_ld(&(bar)[XB_TMO])) break; if (_sp > XB_SPIN_CAP) { atomicAdd(&(bar)[XB_TMO], 1u); break; } } } } while (0)

struct XcdBarrier {
    unsigned* bar; unsigned x;
    volatile LAS unsigned* st;
};

__device__ __forceinline__ XcdBarrier xcd_barrier_post(unsigned* bar, volatile LAS unsigned* st) {
    XcdBarrier b; b.bar = bar; b.x = xb_xcc_id(); b.st = st;
    if (threadIdx.x == 0) (void)xb_add(&bar[XB_XCNT(b.x)], 1u);
    return b;
}
__device__ __forceinline__ void xcd_barrier_complete(unsigned* bar, unsigned x, unsigned& nloc, unsigned& nx) {
    const unsigned G = gridDim.x * gridDim.y * gridDim.z;
    unsigned sum, cnt, mine, sp = 0u;
    for (;;) {
        sum = 0u; cnt = 0u; mine = 0u;
#pragma unroll
        for (unsigned j = 0; j < 16; ++j) { const unsigned c = xb_ld(&bar[XB_XCNT(j)]); sum += c; cnt += (c > 0u) ? 1u : 0u; mine = (j == x) ? c : mine; }
        if (sum == G) break;
        __builtin_amdgcn_s_sleep(1);
        if ((++sp & 255u) == 0u) { if (xb_ld(&bar[XB_TMO])) break; if (sp > XB_SPIN_CAP) { atomicAdd(&bar[XB_TMO], 1u); break; } }
    }
    nloc = mine > 0u ? mine : 1u; nx = cnt > 0u ? cnt : 1u;
}

__device__ __forceinline__ void xcd_barrier(const XcdBarrier& b) {
    asm volatile("s_waitcnt vmcnt(0)" ::: "memory");
    __syncthreads();
    if (threadIdx.x == 0) {
        unsigned* bar = b.bar;
        __builtin_amdgcn_s_waitcnt(0);
        unsigned nloc = b.st[0], nx = b.st[1];
        if (nloc == 0u) { xcd_barrier_complete(bar, b.x, nloc, nx); b.st[0] = nloc; b.st[1] = nx; }
        const unsigned old = xb_add(&bar[XB_XSUB(b.x)], 1u);
        const unsigned gen = old / nloc;
        if (old + 1u == (gen + 1u) * nloc) {
            __builtin_amdgcn_fence(__ATOMIC_RELEASE, "agent");
            asm volatile("s_waitcnt vmcnt(0)" ::: "memory");
            const unsigned og = xb_add(&bar[XB_TOP], 1u);
            const unsigned tg = og / nx;
            if (og + 1u == (tg + 1u) * nx) xb_add(&bar[XB_TOPGEN], 1u);
            else XB_SPIN(xb_ld(&bar[XB_TOPGEN]) == tg, bar);
            __builtin_amdgcn_fence(__ATOMIC_ACQUIRE, "agent");
            xb_add(&bar[XB_XGEN(b.x)], 1u);
            asm volatile("s_waitcnt vmcnt(0)" ::: "memory");
        } else {
            XB_SPIN(xb_ld(&bar[XB_XGEN(b.x)]) == gen, bar);
            __builtin_amdgcn_fence(__ATOMIC_ACQUIRE, "agent");
            asm volatile("s_waitcnt vmcnt(0)" ::: "memory");
        }
    }
    __syncthreads();
}

struct Frame {
    LAS unsigned char* lds;
    volatile LAS unsigned* MISC;
    gu32* ctl;
    int tid, lane, wave;
    int vcu, G;
    unsigned char* ws;
    const float* in[19];
    float* out;
};
enum { I_X = 0, I_NORM_MIX, I_W_IN, I_DN_CONV, I_DN_ALOG, I_DN_DTB, I_DN_NORM, I_GL_WA2, I_GL_BA, I_GL_NORM, I_W_BDN, I_W_BGLA, I_W_OUT, I_NORM_FFN, I_W_FIN, I_FFN_CW, I_FFN_CB, I_W_FOUT, I_NORM_FIN };

__device__ __forceinline__ void transpose_item(const float* W, size_t ldw, int k0, int sn0, bf16* WT, size_t ldk, int dn0, LAS float* scr, int lane) {
#pragma unroll 8
    for (int i = 0; i < 32; ++i) { const int kk = 2 * i + (lane >> 5); scr[kk * 33 + (lane & 31)] = W[(size_t)(k0 + kk) * ldw + sn0 + (lane & 31)]; }
    LDS_WAIT(); asm volatile("" ::: "memory");
    const int c = lane & 7;
#pragma unroll
    for (int j = 0; j < 4; ++j) { const int n = (lane >> 3) + 8 * j; const LAS float* s = scr + (8 * c) * 33 + n;
        v4u o; o.x = pk2(s[0 * 33], s[1 * 33]); o.y = pk2(s[2 * 33], s[3 * 33]); o.z = pk2(s[4 * 33], s[5 * 33]); o.w = pk2(s[6 * 33], s[7 * 33]);
        *(GAS v4u*)(WT + (size_t)(dn0 + n) * ldk + k0 + 8 * c) = o; }
    LDS_WAIT(); asm volatile("" ::: "memory");
}
__device__ __forceinline__ void rms_row(const float* xrow, const float* w, bf16* obf, float* of32, int lane) {
    const GAS f32x4* xr = (const GAS f32x4*)xrow + lane;
    f32x4 v[16]; float s = 0.f;
#pragma unroll
    for (int j = 0; j < 16; ++j) { v[j] = xr[64 * j]; s += (v[j].x * v[j].x + v[j].y * v[j].y) + (v[j].z * v[j].z + v[j].w * v[j].w); }
    const float rstd = 1.0f / sqrtf(wave_sum(s) * (1.f / D) + EPS);
    const GAS f32x4* wr = (const GAS f32x4*)w + lane;
    if (obf) { GAS v2u* o8 = (GAS v2u*)obf + lane;
#pragma unroll
        for (int j = 0; j < 16; ++j) { const f32x4 g = wr[64 * j]; v2u o; o.x = pk2(v[j].x * rstd * g.x, v[j].y * rstd * g.y); o.y = pk2(v[j].z * rstd * g.z, v[j].w * rstd * g.w); o8[64 * j] = o; } }
    else { GAS f32x4* o = (GAS f32x4*)of32 + lane;
#pragma unroll
        for (int j = 0; j < 16; ++j) { const f32x4 g = wr[64 * j]; o[64 * j] = (f32x4){v[j].x * rstd * g.x, v[j].y * rstd * g.y, v[j].z * rstd * g.z, v[j].w * rstd * g.w}; } }
}

__device__ __forceinline__ void p0_prologue(Frame& F) {
    LAS float* scr = (LAS float*)(F.lds + RING_OFF + F.wave * 16384);
    const int gw = F.vcu * NWAVES + F.wave, NGW = F.G * NWAVES;
    bf16* WIN = (bf16*)(F.ws + WS_WIN); bf16* WSM = (bf16*)(F.ws + WS_WSM); bf16* WBDN = (bf16*)(F.ws + WS_WBDN); bf16* WBGLA = (bf16*)(F.ws + WS_WBGLA);
    bf16* WOUT = (bf16*)(F.ws + WS_WOUT); bf16* WFIN = (bf16*)(F.ws + WS_WFIN); bf16* WFOUT = (bf16*)(F.ws + WS_WFOUT);
    constexpr int NB_IN = PN / 32, I_IN = (D / 64) * NB_IN;
    constexpr int I_SM = (D / 64) * 2;
    constexpr int I_BR = (2048 / 64) * (D / 32);
    constexpr int I_OUT = (D / 64) * (D / 32);
    constexpr int NB_FI = NGU / 32, I_FI = (D / 64) * NB_FI;
    constexpr int I_FO = (DFF / 64) * (D / 32);
    constexpr int NITEMS = I_IN + I_SM + 2 * I_BR + I_OUT + I_FI + I_FO;
    for (int it = gw; it < NITEMS; it += NGW) {
        int r = it;
        if (r < I_IN) { const int kb = r / NB_IN, nb = r % NB_IN, n0 = 32 * nb; const int sn0 = n0 + (n0 >= PC_GATE_DN ? 48 : (n0 >= PC_GQ ? 32 : 0));
            transpose_item(F.in[I_W_IN], IN_COLS, 64 * kb, sn0, WIN, D, n0, scr, F.lane); continue; } r -= I_IN;
        if (r < I_SM) { const int kb = r >> 1, nb = r & 1; transpose_item(F.in[I_W_IN], IN_COLS, 64 * kb, nb ? 14368 : 8192, WSM, D, 32 * nb, scr, F.lane); continue; } r -= I_SM;
        if (r < I_BR) { const int kb = r / (D / 32), nb = r % (D / 32); transpose_item(F.in[I_W_BDN], D, 64 * kb, 32 * nb, WBDN, 2048, 32 * nb, scr, F.lane); continue; } r -= I_BR;
        if (r < I_BR) { const int kb = r / (D / 32), nb = r % (D / 32); transpose_item(F.in[I_W_BGLA], D, 64 * kb, 32 * nb, WBGLA, 2048, 32 * nb, scr, F.lane); continue; } r -= I_BR;
        if (r < I_OUT) { const int kb = r / (D / 32), nb = r % (D / 32); transpose_item(F.in[I_W_OUT], D, 64 * kb, 32 * nb, WOUT, D, 32 * nb, scr, F.lane); continue; } r -= I_OUT;
        if (r < I_FI) { const int kb = r / NB_FI, nb = r % NB_FI, n0 = 32 * nb, j = n0 >> 8, i = n0 & 255; const int sn0 = (i < 128) ? (128 * j + i) : (DFF + 128 * j + (i - 128));
            transpose_item(F.in[I_W_FIN], NGU, 64 * kb, sn0, WFIN, D, n0, scr, F.lane); continue; } r -= I_FI;
        { const int kb = r / (D / 32), nb = r % (D / 32); transpose_item(F.in[I_W_FOUT], D, 64 * kb, 32 * nb, WFOUT, DFF, 32 * nb, scr, F.lane); }
    }
    bf16* H = (bf16*)(F.ws + WS_H);
    for (int m = gw; m < M; m += NGW) rms_row(F.in[I_X] + (size_t)m * D, F.in[I_NORM_MIX], H + (size_t)m * D, nullptr, F.lane);
}

__device__ __forceinline__ void p1_skinny(Frame& F) {
    const bf16* H = (const bf16*)(F.ws + WS_H); const bf16* WSM = (const bf16*)(F.ws + WS_WSM); float* PS = (float*)(F.ws + WS_PSMALL);
    const int lane = F.lane, fr = lane & 15, fq = lane >> 4;
    for (int t = (int)blockIdx.x + F.G * F.wave; t < M / 16; t += F.G * NWAVES) {
        const int row0 = 16 * t;
        const bf16* ap = H + (size_t)(row0 + fr) * D + 8 * fq; const bf16* bp = WSM + (size_t)fr * D + 8 * fq;
        f32x4 acc[4] = {{0.f, 0.f, 0.f, 0.f}, {0.f, 0.f, 0.f, 0.f}, {0.f, 0.f, 0.f, 0.f}, {0.f, 0.f, 0.f, 0.f}};
#pragma unroll 4
        for (int kk = 0; kk < D / 32; ++kk) {
            const bf16x8 a = *(const GAS bf16x8*)(ap + kk * 32);
#pragma unroll
            for (int cb = 0; cb < 4; ++cb) { const bf16x8 b = *(const GAS bf16x8*)(bp + (size_t)cb * 16 * D + kk * 32); acc[cb] = __builtin_amdgcn_mfma_f32_16x16x32_bf16(a, b, acc[cb], 0, 0, 0); }
        }
#pragma unroll
        for (int cb = 0; cb < 4; ++cb)
#pragma unroll
            for (int r = 0; r < 4; ++r) PS[(size_t)(row0 + 4 * fq + r) * PSM + cb * 16 + fr] = acc[cb][r];
    }
}

__device__ __forceinline__ void p2_prep(Frame& F) {
    const int gw = F.vcu * NWAVES + F.wave, NGW = F.G * NWAVES, lane = F.lane;
    const bf16* PROJ = (const bf16*)(F.ws + WS_PROJ); const float* PS = (const float*)(F.ws + WS_PSMALL);
    float* QF = (float*)(F.ws + WS_QF); float* KF = (float*)(F.ws + WS_KF); float* VF = (float*)(F.ws + WS_VF);
    float* EK = (float*)(F.ws + WS_EK); float* BETA = (float*)(F.ws + WS_BETA); float* GD = (float*)(F.ws + WS_G);
    const float* cw = F.in[I_DN_CONV];
    for (int id = gw; id < M * DN_H; id += NGW) {
        const int tg = id >> 4, h = id & 15, t = tg & (SEQ - 1), d0 = 2 * lane;
        float res[3][2];
#pragma unroll
        for (int p = 0; p < 3; ++p) { const int col = p * 2048 + h * 128 + d0; float y0 = 0.f, y1 = 0.f;
#pragma unroll
            for (int i = 0; i < 4; ++i) { const int tt = t - 3 + i; if (tt >= 0) { const unsigned xw = *(const GAS unsigned*)(PROJ + (size_t)(tg - 3 + i) * PN + PC_QKV + col);
                    const f32x2 w = *(const GAS f32x2*)(cw + (size_t)i * DN_QKV + col); y0 += w.x * bflo(xw); y1 += w.y * bfhi(xw); } }
            res[p][0] = silu_f(y0); res[p][1] = silu_f(y1); }
        const float sq = wave_sum(res[0][0] * res[0][0] + res[0][1] * res[0][1]), sk = wave_sum(res[1][0] * res[1][0] + res[1][1] * res[1][1]);
        const float iq = (1.0f / sqrtf(sq + EPS)) * 0.08838834764831845f, ik = 1.0f / sqrtf(sk + EPS);
        const size_t o = (size_t)tg * DN_KEY + h * 128 + d0;
        *(GAS f32x2*)(QF + o) = (f32x2){res[0][0] * iq, res[0][1] * iq}; *(GAS f32x2*)(KF + o) = (f32x2){res[1][0] * ik, res[1][1] * ik}; *(GAS f32x2*)(VF + o) = (f32x2){res[2][0], res[2][1]};
        if (lane == 0) { BETA[id] = sigmoid_f(PS[(size_t)tg * PSM + h]); GD[id] = -expf(F.in[I_DN_ALOG][h]) * softplus_f(PS[(size_t)tg * PSM + 16 + h] + F.in[I_DN_DTB][h]); }
    }
    const float* wa2 = F.in[I_GL_WA2]; const float* ba = F.in[I_GL_BA];
    for (int id = gw; id < M * GL_H; id += NGW) {
        const int tg = id >> 3, h = id & 7, c = h * 128 + 2 * lane;
        f32x2 x = *(const GAS f32x2*)(ba + c);
#pragma unroll
        for (int r = 0; r < GL_RANK; ++r) { const float lr = PS[(size_t)tg * PSM + 32 + r]; const f32x2 w = *(const GAS f32x2*)(wa2 + (size_t)r * GL_KEY + c); x.x += lr * w.x; x.y += lr * w.y; }
        *(GAS f32x2*)(EK + (size_t)tg * GL_KEY + c) = (f32x2){expf(logsigmoid_f(x.x) * (1.f / 16.f)), expf(logsigmoid_f(x.y) * (1.f / 16.f))};
    }
}

__device__ __forceinline__ void p3_scan_naive(Frame& F) {
    LAS float* sh = (LAS float*)(F.lds + RING_OFF);
    const int tid = F.tid; const int wg = (int)blockIdx.x;
    if (wg < 32) {
        const int sub = tid >> 8, tt = tid & 255, e = tt >> 1, half = tt & 1, bh = wg * 2 + sub, b = bh >> 4, h = bh & 15;
        const float* QF = (const float*)(F.ws + WS_QF); const float* KF = (const float*)(F.ws + WS_KF); const float* VF = (const float*)(F.ws + WS_VF);
        const float* BETA = (const float*)(F.ws + WS_BETA); const float* GD = (const float*)(F.ws + WS_G); float* ODN = (float*)(F.ws + WS_ODN);
        float S[64];
#pragma unroll
        for (int d = 0; d < 64; ++d) S[d] = 0.f;
        const float* KQ = (tt < 128) ? KF : QF;
        size_t o = (size_t)(b * SEQ) * DN_KEY + h * 128; int gi = (b * SEQ) * DN_H + h;
        float kqr = KQ[o + (tt & 127)], vr = VF[o + e], be = BETA[gi], gg = GD[gi];
        for (int t = 0; t < SEQ; ++t) {
            LAS float* kq = sh + ((t & 1) * 2 + sub) * 256;
            kq[tt] = kqr; const float v = vr, beta = be, decay = expf(gg); const size_t oc = o;
            if (t + 1 < SEQ) { o += DN_KEY; gi += DN_H; kqr = KQ[o + (tt & 127)]; vr = VF[o + e]; be = BETA[gi]; gg = GD[gi]; }
            __syncthreads();
            const LAS float* kp = kq + 64 * half; const LAS float* qp = kq + 128 + 64 * half;
            float ks0 = 0.f, ks1 = 0.f, ks2 = 0.f, ks3 = 0.f;
#pragma unroll
            for (int d = 0; d < 64; d += 4) { const f32x4 k4 = *(const LAS f32x4*)(kp + d); ks0 += k4.x * S[d]; ks1 += k4.y * S[d + 1]; ks2 += k4.z * S[d + 2]; ks3 += k4.w * S[d + 3]; }
            float ks = (ks0 + ks1) + (ks2 + ks3); ks += __shfl_xor(ks, 1);
            const float delta = beta * (v - decay * ks);
            float o0 = 0.f, o1 = 0.f, o2 = 0.f, o3 = 0.f;
#pragma unroll
            for (int d = 0; d < 64; d += 4) { const f32x4 k4 = *(const LAS f32x4*)(kp + d); const f32x4 q4 = *(const LAS f32x4*)(qp + d);
                S[d] = k4.x * delta + decay * S[d]; S[d + 1] = k4.y * delta + decay * S[d + 1]; S[d + 2] = k4.z * delta + decay * S[d + 2]; S[d + 3] = k4.w * delta + decay * S[d + 3];
                o0 += q4.x * S[d]; o1 += q4.y * S[d + 1]; o2 += q4.z * S[d + 2]; o3 += q4.w * S[d + 3]; }
            float ov = (o0 + o1) + (o2 + o3); ov += __shfl_xor(ov, 1);
            if (half == 0) ODN[oc + e] = ov;
        }
    } else if (wg < 64) {
        const int e = tid >> 1, half = tid & 1, bh = wg - 32, b = bh >> 3, h = bh & 7;
        const bf16* PROJ = (const bf16*)(F.ws + WS_PROJ); const float* EK = (const float*)(F.ws + WS_EK); float* OGLA = (float*)(F.ws + WS_OGLA);
        float S[64];
#pragma unroll
        for (int d = 0; d < 64; ++d) S[d] = 0.f;
        const int ee = tid & 127, role = tid >> 7;
        size_t tg = (size_t)b * SEQ;
        float a0 = (role == 0) ? EK[tg * GL_KEY + h * 128 + ee] : (role == 1) ? bf1(PROJ[tg * PN + PC_GK + h * 128 + ee]) : bf1(PROJ[tg * PN + PC_GQ + h * 128 + ee]) * 0.08838834764831845f;
        float vr = bf1(PROJ[tg * PN + PC_GV + h * 256 + e]);
        for (int t = 0; t < SEQ; ++t) {
            LAS float* buf = sh + (t & 1) * 384;
            if (role < 3) buf[tid] = a0;
            const float v = vr; const size_t tc = tg;
            if (t + 1 < SEQ) { ++tg; a0 = (role == 0) ? EK[tg * GL_KEY + h * 128 + ee] : (role == 1) ? bf1(PROJ[tg * PN + PC_GK + h * 128 + ee]) : bf1(PROJ[tg * PN + PC_GQ + h * 128 + ee]) * 0.08838834764831845f;
                vr = bf1(PROJ[tg * PN + PC_GV + h * 256 + e]); }
            __syncthreads();
            const LAS float* gp = buf + 64 * half;
            float o0 = 0.f, o1 = 0.f, o2 = 0.f, o3 = 0.f;
#pragma unroll
            for (int d = 0; d < 64; d += 4) { const f32x4 g4 = *(const LAS f32x4*)(gp + d); const f32x4 k4 = *(const LAS f32x4*)(gp + 128 + d); const f32x4 q4 = *(const LAS f32x4*)(gp + 256 + d);
                S[d] = g4.x * S[d] + k4.x * v; S[d + 1] = g4.y * S[d + 1] + k4.y * v; S[d + 2] = g4.z * S[d + 2] + k4.z * v; S[d + 3] = g4.w * S[d + 3] + k4.w * v;
                o0 += q4.x * S[d]; o1 += q4.y * S[d + 1]; o2 += q4.z * S[d + 2]; o3 += q4.w * S[d + 3]; }
            float ov = (o0 + o1) + (o2 + o3); ov += __shfl_xor(ov, 1);
            if (half == 0) OGLA[tc * GL_VAL + h * 256 + e] = ov;
        }
    }
}

__device__ __forceinline__ void p4_gated_norm(Frame& F) {
    const int gw = F.vcu * NWAVES + F.wave, NGW = F.G * NWAVES, lane = F.lane;
    const bf16* PROJ = (const bf16*)(F.ws + WS_PROJ); const float* ODN = (const float*)(F.ws + WS_ODN); const float* OGLA = (const float*)(F.ws + WS_OGLA);
    bf16* ONDN = (bf16*)(F.ws + WS_ONDN); bf16* ONGLA = (bf16*)(F.ws + WS_ONGLA);
    for (int id = gw; id < M * DN_H; id += NGW) {
        const int tg = id >> 4, h = id & 15, d0 = 2 * lane; const size_t o = (size_t)tg * DN_VAL + h * 128 + d0;
        const f32x2 v = *(const GAS f32x2*)(ODN + o); const float rstd = 1.0f / sqrtf(wave_sum(v.x * v.x + v.y * v.y) * (1.f / 128.f) + EPS);
        const f32x2 w = *(const GAS f32x2*)(F.in[I_DN_NORM] + d0); const unsigned z = *(const GAS unsigned*)(PROJ + (size_t)tg * PN + PC_Z + h * 128 + d0);
        *(GAS unsigned*)(ONDN + o) = pk2(v.x * rstd * w.x * silu_f(bflo(z)), v.y * rstd * w.y * silu_f(bfhi(z)));
    }
    for (int id = gw; id < M * GL_H; id += NGW) {
        const int tg = id >> 3, h = id & 7, d0 = 4 * lane; const size_t o = (size_t)tg * GL_VAL + h * 256 + d0;
        const f32x4 v = *(const GAS f32x4*)(OGLA + o); const float rstd = 1.0f / sqrtf(wave_sum((v.x * v.x + v.y * v.y) + (v.z * v.z + v.w * v.w)) * (1.f / 256.f) + EPS);
        const f32x4 w = *(const GAS f32x4*)(F.in[I_GL_NORM] + d0); const v2u r = *(const GAS v2u*)(PROJ + (size_t)tg * PN + PC_GR + h * 256 + d0);
        v2u ob; ob.x = pk2(v.x * rstd * w.x * silu_f(bflo(r.x)), v.y * rstd * w.y * silu_f(bfhi(r.x))); ob.y = pk2(v.z * rstd * w.z * silu_f(bflo(r.y)), v.w * rstd * w.w * silu_f(bfhi(r.y)));
        *(GAS v2u*)(ONGLA + o) = ob;
    }
}

__device__ __forceinline__ void p9_convglu(Frame& F) {
    const bf16* GU = (const bf16*)(F.ws + WS_GU); bf16* HID = (bf16*)(F.ws + WS_HID);
    const float* cw = F.in[I_FFN_CW]; const float* cb = F.in[I_FFN_CB];
    const size_t gt = (size_t)F.vcu * (NWAVES * 64) + F.tid, NT = (size_t)F.G * NWAVES * 64;
    constexpr int CG = DFF / 8;
    for (size_t id = gt; id < (size_t)M * CG; id += NT) {
        const int tg = (int)(id / CG), cg = (int)(id % CG), c0 = 8 * cg, j = c0 >> 7, i = c0 & 127, t = tg & (SEQ - 1);
        const bf16* gp = GU + (size_t)tg * NGU + 256 * j + i;
        float y[8];
#pragma unroll
        for (int q = 0; q < 8; ++q) y[q] = cb[c0 + q];
#pragma unroll
        for (int k = 0; k < 3; ++k) { const int dt = k - 2; if (t + dt >= 0) { const v4u g = *(const GAS v4u*)(gp + (ptrdiff_t)dt * NGU);
                const f32x4 w0 = *(const GAS f32x4*)(cw + (size_t)k * DFF + c0), w1 = *(const GAS f32x4*)(cw + (size_t)k * DFF + c0 + 4);
                y[0] += w0.x * bflo(g.x); y[1] += w0.y * bfhi(g.x); y[2] += w0.z * bflo(g.y); y[3] += w0.w * bfhi(g.y);
                y[4] += w1.x * bflo(g.z); y[5] += w1.y * bfhi(g.z); y[6] += w1.z * bflo(g.w); y[7] += w1.w * bfhi(g.w); } }
        const v4u up = *(const GAS v4u*)(gp + 128);
        v4u o; o.x = pk2(silu_f(y[0]) * bflo(up.x), silu_f(y[1]) * bfhi(up.x)); o.y = pk2(silu_f(y[2]) * bflo(up.y), silu_f(y[3]) * bfhi(up.y));
        o.z = pk2(silu_f(y[4]) * bflo(up.z), silu_f(y[5]) * bfhi(up.z)); o.w = pk2(silu_f(y[6]) * bflo(up.w), silu_f(y[7]) * bfhi(up.w));
        *(GAS v4u*)(HID + (size_t)tg * DFF + c0) = o;
    }
}

#ifndef MK_ONE_LAUNCH
#define MK_ONE_LAUNCH 0
#endif
constexpr int N_PHASES = 12;
struct Args { const float* in[19]; float* out; unsigned char* ws; int ph_lo, ph_hi; };
__global__ void __launch_bounds__(NWAVES * 64, 2) mk_fwd(Args args) {
    extern __shared__ __attribute__((aligned(16))) unsigned char lds[];
    Frame F;
    F.lds = (LAS unsigned char*)lds;
    F.MISC = (volatile LAS unsigned*)(F.lds + MISC_OFF);
    F.tid = threadIdx.x; F.lane = F.tid & 63; F.wave = __builtin_amdgcn_readfirstlane(F.tid >> 6);
    F.G = gridDim.x; { const int bx = blockIdx.x; F.vcu = (F.G % 8 == 0) ? (bx % 8) * (F.G / 8) + bx / 8 : bx; }
    F.ws = args.ws; F.ctl = (gu32*)(args.ws + WS_CTL); F.out = args.out;
#pragma unroll
    for (int i = 0; i < 19; ++i) F.in[i] = args.in[i];
    for (int u = F.tid; u < (LDS_BYTES - LDSCTL_OFF) / 4; u += NWAVES * 64) ((LAS unsigned*)(F.lds + LDSCTL_OFF))[u] = 0u;
    __syncthreads();
    XcdBarrier bar; bar.bar = (unsigned*)(F.ctl + CW_BAR); bar.x = 0; bar.st = nullptr;
    if (MK_ONE_LAUNCH) bar = xcd_barrier_post((unsigned*)(F.ctl + CW_BAR), F.MISC + 8);
    const int lo = args.ph_lo, hi = args.ph_hi;
#define IN(k) (lo <= (k) && (k) < hi)
#define SEAM(k) do { if (IN(k) && IN((k) + 1)) xcd_barrier(bar); } while (0)
    bf16* H = (bf16*)(F.ws + WS_H); bf16* PROJ = (bf16*)(F.ws + WS_PROJ);

    if (IN(0)) { p0_prologue(F); } SEAM(0);
    if (IN(1)) {
        p1_skinny(F);
        pg8::Gemm g{H, (const bf16*)(F.ws + WS_WIN), M, PN, D}; pg8::StaticOrder S; S.init(M, PN, F.G, (int)blockIdx.x);
        pg8::Epi<pg8::EPI_BF16> E{PROJ, PN, nullptr, 0, nullptr, 0, nullptr, 0};
        pg8::gemm_phase<pg8::Epi<pg8::EPI_BF16>, pg8::StaticOrder, true, true>(F.lds + RING_OFF, g, S, E);
    } SEAM(1);
    if (IN(2)) { p2_prep(F); } SEAM(2);
    if (IN(3)) { p3_scan_naive(F); } SEAM(3);
    if (IN(4)) { p4_gated_norm(F); } SEAM(4);
    if (IN(5)) {
        { pg8::Gemm g{(const bf16*)(F.ws + WS_ONDN), (const bf16*)(F.ws + WS_WBDN), M, D, DN_VAL}; pg8::StaticOrder S; S.init(M, D, F.G, (int)blockIdx.x);
          pg8::Epi<pg8::EPI_BRA> E{nullptr, 0, (float*)(F.ws + WS_TMP), D, nullptr, 0, PROJ + PC_GATE_DN, PN};
          pg8::gemm_phase<pg8::Epi<pg8::EPI_BRA>, pg8::StaticOrder, true, true>(F.lds + RING_OFF, g, S, E); }
        { pg8::Gemm g{(const bf16*)(F.ws + WS_ONGLA), (const bf16*)(F.ws + WS_WBGLA), M, D, GL_VAL}; pg8::StaticOrder S; S.init(M, D, F.G, (int)blockIdx.x);
          pg8::Epi<pg8::EPI_BRB> E{(bf16*)(F.ws + WS_MERGED), D, (float*)(F.ws + WS_TMP), D, nullptr, 0, PROJ + PC_GATE_GLA, PN};
          pg8::gemm_phase<pg8::Epi<pg8::EPI_BRB>, pg8::StaticOrder, true, true>(F.lds + RING_OFF, g, S, E); }
    } SEAM(5);
    if (IN(6)) {
        pg8::Gemm g{(const bf16*)(F.ws + WS_MERGED), (const bf16*)(F.ws + WS_WOUT), M, D, D}; pg8::StaticOrder S; S.init(M, D, F.G, (int)blockIdx.x);
        pg8::Epi<pg8::EPI_RES> E{nullptr, 0, (float*)(F.ws + WS_X1), D, F.in[I_X], D, nullptr, 0};
        pg8::gemm_phase<pg8::Epi<pg8::EPI_RES>, pg8::StaticOrder, true, true>(F.lds + RING_OFF, g, S, E);
    } SEAM(6);
    if (IN(7)) { const int gw = F.vcu * NWAVES + F.wave, NGW = F.G * NWAVES; const float* X1 = (const float*)(F.ws + WS_X1);
        for (int m = gw; m < M; m += NGW) rms_row(X1 + (size_t)m * D, F.in[I_NORM_FFN], H + (size_t)m * D, nullptr, F.lane); } SEAM(7);
    if (IN(8)) {
        pg8::Gemm g{H, (const bf16*)(F.ws + WS_WFIN), M, NGU, D}; pg8::StaticOrder S; S.init(M, NGU, F.G, (int)blockIdx.x);
        pg8::Epi<pg8::EPI_BF16> E{(bf16*)(F.ws + WS_GU), NGU, nullptr, 0, nullptr, 0, nullptr, 0};
        pg8::gemm_phase<pg8::Epi<pg8::EPI_BF16>, pg8::StaticOrder, true, true>(F.lds + RING_OFF, g, S, E);
    } SEAM(8);
    if (IN(9)) { p9_convglu(F); } SEAM(9);
    if (IN(10)) {
        pg8::Gemm g{(const bf16*)(F.ws + WS_HID), (const bf16*)(F.ws + WS_WFOUT), M, D, DFF}; pg8::StaticOrder S; S.init(M, D, F.G, (int)blockIdx.x);
        pg8::Epi<pg8::EPI_RES> E{nullptr, 0, F.out, D, (const float*)(F.ws + WS_X1), D, nullptr, 0};
        pg8::gemm_phase<pg8::Epi<pg8::EPI_RES>, pg8::StaticOrder, true, true>(F.lds + RING_OFF, g, S, E);
    } SEAM(10);
    if (IN(11)) { const int gw = F.vcu * NWAVES + F.wave, NGW = F.G * NWAVES;
        for (int m = gw; m < M; m += NGW) rms_row(F.out + (size_t)m * D, F.in[I_NORM_FIN], nullptr, F.out + (size_t)m * D, F.lane); }
#undef IN
#undef SEAM
}

extern "C" void kernel_launch(void* const* d_in, const int* in_sizes, int n_in, void* d_out, int out_size, void* d_ws, size_t ws_size, hipStream_t stream) {
    static int grid = 0;
    if (grid == 0) {
        if (n_in != 19 || in_sizes[0] != M * D || out_size != M * D || ws_size < WS_END) { fprintf(stderr, "kernel_launch: unexpected shapes: n_in %d in0 %d out %d ws %zu (need %zu)\n", n_in, n_in > 0 ? in_sizes[0] : -1, out_size, ws_size, (size_t)WS_END); grid = -1; return; }
        int dev = 0, cus = 0, per_cu = 0;
        if (hipGetDevice(&dev) != hipSuccess || hipDeviceGetAttribute(&cus, hipDeviceAttributeMultiprocessorCount, dev) != hipSuccess) { grid = -1; return; }
        if (hipFuncSetAttribute((const void*)mk_fwd, hipFuncAttributeMaxDynamicSharedMemorySize, LDS_BYTES) != hipSuccess) { fprintf(stderr, "kernel_launch: hipFuncSetAttribute failed\n"); grid = -1; return; }
        if (hipOccupancyMaxActiveBlocksPerMultiprocessor(&per_cu, (const void*)mk_fwd, NWAVES * 64, LDS_BYTES) != hipSuccess || per_cu < 1) fprintf(stderr, "kernel_launch: occupancy query says %d\n", per_cu);
        (void)hipGetLastError();
        grid = cus;
    }
    if (grid < 0) return;
    if (hipMemsetAsync((char*)d_ws + WS_CTL, 0, CTL_ZERO_BYTES, stream) != hipSuccess) return;
    Args a{};
    for (int i = 0; i < 19; ++i) a.in[i] = (const float*)d_in[i];
    a.out = (float*)d_out; a.ws = (unsigned char*)d_ws;
#if MK_ONE_LAUNCH
    a.ph_lo = 0; a.ph_hi = N_PHASES;
    hipLaunchKernelGGL(mk_fwd, dim3(grid), dim3(NWAVES * 64), LDS_BYTES, stream, a);
#else
    for (int p = 0; p < N_PHASES; ++p) { a.ph_lo = p; a.ph_hi = p + 1; hipLaunchKernelGGL(mk_fwd, dim3(grid), dim3(NWAVES * 64), LDS_BYTES, stream, a); }
#endif
}
```

```cpp
#define MK_ONE_LAUNCH 1
#include <hip/hip_runtime.h>
#include <cstdio>
#include <cstdint>
namespace pg8 {
#define PG8_LAS __attribute__((address_space(3)))
typedef unsigned short bf16_t;
typedef short bf16x8 __attribute__((ext_vector_type(8)));
typedef float f32x4 __attribute__((ext_vector_type(4)));
typedef unsigned u32x4 __attribute__((ext_vector_type(4)));
constexpr int BM = 256, BK = 64, HALF = 128, HTB = HALF * BK * 2  , STAGE_BYTES = 8 * HTB, NXCD = 8, WGM = 8;

__host__ __device__ __forceinline__ int lds_byte(int r, int c) { const int st = (r >> 4) * 2 + (c >> 5), rr = r & 15, cc = c & 31, ob = rr * 64 + cc * 2; return st * 1024 + (ob ^ (((ob >> 9) & 1) << 5)); }
__host__ __device__ __forceinline__ void stage_rc(int b, int& R, int& C) { const int st = b / 1024, sb = b % 1024, swz = sb ^ (((sb >> 9) & 1) << 5); R = (st >> 1) * 16 + swz / 64; C = (st & 1) * 32 + (swz % 64) / 2; }
__host__ __device__ __forceinline__ int perm32(int rho) { const int n = rho >> 4, i = rho & 15; return 8 * (i >> 2) + 4 * n + (i & 3); }

struct Unit { int pm, pn; };
struct Gemm { const bf16_t* A; const bf16_t* Bt; int M, N, K; };

struct StaticOrder {
    int nM, nN, nwg, G, c;
    __host__ __device__ void init(int M, int N, int G_, int c_) { nM = M / BM; nN = N / BM; nwg = nM * nN; G = G_; c = c_; }
    __host__ __device__ bool next(int i, Unit& u) const {
        const long L = (long)i * G + c; if (L >= nwg) return false;
        int wgid = (int)L; { const int q = nwg / NXCD, r = nwg % NXCD, xcd = wgid % NXCD, off = wgid / NXCD; wgid = (xcd < r ? xcd * (q + 1) : r * (q + 1) + (xcd - r) * q) + off; }
        const int nig = WGM * nN, gid = wgid / nig, fm = gid * WGM, gsz = (nM - fm) < WGM ? (nM - fm) : WGM;
        u.pm = fm + ((wgid % nig) % gsz); u.pn = (wgid % nig) / gsz; return true;
    }
    __device__ __forceinline__ void a_ready(const Unit&) const {}
    __device__ __forceinline__ void done(const Unit&) const {}
};

__device__ __forceinline__ unsigned cvt_pk_bf16(float lo, float hi) { unsigned r; asm volatile("v_cvt_pk_bf16_f32 %0, %1, %2" : "=v"(r) : "v"(lo), "v"(hi)); return r; }
__device__ __forceinline__ float bf_lo(unsigned w) { return __uint_as_float(w << 16); }
__device__ __forceinline__ float bf_hi(unsigned w) { return __uint_as_float(w & 0xffff0000u); }
__device__ __forceinline__ float sigm(float x) { return 1.0f / (1.0f + __expf(-x)); }
enum { EPI_BF16 = 0, EPI_BRA = 1, EPI_BRB = 2, EPI_RES = 3 };
template <int MODE> struct Epi {
    static constexpr bool PERM = true, AFTER_DRAIN = false;
    bf16_t* Ob; int ldo; float* Of; int ldf; const float* R; int ldr; const bf16_t* Gt; int ldg;
    __device__ __forceinline__ void operator()(const f32x4 (&acc)[2][2][4][2], const Unit& u, int wr, int wc, int fr, int fq) const {
        const int row0 = u.pm * BM + wr * 64 + fr, col0 = u.pn * BM + wc * 32 + 8 * fq;
#pragma unroll
        for (int ai = 0; ai < 2; ++ai)
#pragma unroll
            for (int m = 0; m < 4; ++m) { const size_t row = (size_t)(row0 + ai * HALF + m * 16);
#pragma unroll
                for (int bj = 0; bj < 2; ++bj) { const int col = col0 + bj * HALF; f32x4 v0 = acc[ai][bj][m][0], v1 = acc[ai][bj][m][1];
                    if (MODE == EPI_BRA || MODE == EPI_BRB) { const u32x4 g = *(const u32x4*)(Gt + row * ldg + col);
                        v0[0] *= sigm(bf_lo(g.x)); v0[1] *= sigm(bf_hi(g.x)); v0[2] *= sigm(bf_lo(g.y)); v0[3] *= sigm(bf_hi(g.y));
                        v1[0] *= sigm(bf_lo(g.z)); v1[1] *= sigm(bf_hi(g.z)); v1[2] *= sigm(bf_lo(g.w)); v1[3] *= sigm(bf_hi(g.w)); }
                    if (MODE == EPI_BRB) { const float* t = Of + row * ldf + col; v0 += *(const f32x4*)t; v1 += *(const f32x4*)(t + 4); }
                    if (MODE == EPI_RES) { const float* t = R + row * ldr + col; v0 += *(const f32x4*)t; v1 += *(const f32x4*)(t + 4); }
                    if (MODE == EPI_BF16 || MODE == EPI_BRB) { u32x4 w; w.x = cvt_pk_bf16(v0[0], v0[1]); w.y = cvt_pk_bf16(v0[2], v0[3]); w.z = cvt_pk_bf16(v1[0], v1[1]); w.w = cvt_pk_bf16(v1[2], v1[3]);
                        *(u32x4*)(Ob + row * ldo + col) = w; }
                    else { float* o = Of + row * ldf + col; *(f32x4*)o = v0; *(f32x4*)(o + 4) = v1; } }
                asm volatile("" ::: "memory"); }
    }
};

template <class Epi, class Sched, bool ALIGN_EPI = false, bool SP2 = false>
__device__ __forceinline__ void gemm_phase(PG8_LAS unsigned char* lds, const Gemm g, const Sched& S, const Epi& E) {
    const int tid = threadIdx.x, wid = __builtin_amdgcn_readfirstlane(tid >> 6), lane = tid & 63, wr = wid >> 2, wc = wid & 3, fr = lane & 15, fq = lane >> 4;
    const int K = g.K, nt = K / BK;
    unsigned voffA[2], voffB[2];
#pragma unroll
    for (int i = 0; i < 2; ++i) { int R, C; stage_rc(tid * 16 + i * 8192, R, C); const int Rb = Epi::PERM ? ((R & ~31) + perm32(R & 31)) : R;
        voffA[i] = (unsigned)(R * K + C) * 2u; voffB[i] = (unsigned)(Rb * K + C) * 2u; }
    const size_t kstep = (size_t)(BK * 2);
    const size_t hstep = (size_t)HALF * K * 2;
    const size_t tstep = 2 * hstep;
    const unsigned ldsw = (unsigned)wid * 1024u;
    const int aoff = lds_byte(wr * 64 + fr, fq * 8), boff = lds_byte(wc * 32 + fr, fq * 8);
#define PG8_SA(b, h) (((b) * 2 + (h)) * HTB)
#define PG8_SB(b, h) ((4 + (b) * 2 + (h)) * HTB)
#define PG8_STAGE(bufoff, gbase, voff) do { _Pragma("unroll") for (int _i = 0; _i < 2; ++_i) \
        __builtin_amdgcn_global_load_lds((const unsigned*)((const char*)(gbase) + (voff)[_i]), (PG8_LAS unsigned*)(lds + (bufoff) + ldsw + _i * 8192), 16, 0, 0); } while (0)
#define PG8_LDA(dst, b, h) do { _Pragma("unroll") for (int m = 0; m < 4; ++m) _Pragma("unroll") for (int k = 0; k < 2; ++k) dst[m][k] = *(const PG8_LAS bf16x8*)(lds + PG8_SA(b, h) + aoff + m * 2048 + k * 1024); } while (0)
#define PG8_LDB(dst, b, h) do { _Pragma("unroll") for (int n = 0; n < 2; ++n) _Pragma("unroll") for (int k = 0; k < 2; ++k) dst[n][k] = *(const PG8_LAS bf16x8*)(lds + PG8_SB(b, h) + boff + n * 2048 + k * 1024); } while (0)
#define PG8_MMA(ai, bj, At, Bt) do { __builtin_amdgcn_s_setprio(1); _Pragma("unroll") for (int m = 0; m < 4; ++m) _Pragma("unroll") for (int n = 0; n < 2; ++n) _Pragma("unroll") for (int k = 0; k < 2; ++k) \
        acc[ai][bj][m][n] = __builtin_amdgcn_mfma_f32_16x16x32_bf16(Bt[n][k], At[m][k], acc[ai][bj][m][n], 0, 0, 0); __builtin_amdgcn_s_setprio(0); } while (0)
#define PG8_WAIT_V(n) asm volatile("s_waitcnt vmcnt(" #n ")" ::: "memory")
#define PG8_WAIT_L(n) asm volatile("s_waitcnt lgkmcnt(" #n ")" ::: "memory")
#define PG8_BAR __builtin_amdgcn_s_barrier()
#define PG8_SCHED __builtin_amdgcn_sched_barrier(0)
    Unit cur, nxt; int ui = 0;
    if (!S.next(0, cur)) return;
    f32x4 acc[2][2][4][2];
#pragma unroll
    for (int a = 0; a < 2; ++a)
#pragma unroll
        for (int b = 0; b < 2; ++b)
#pragma unroll
            for (int m = 0; m < 4; ++m)
#pragma unroll
                for (int n = 0; n < 2; ++n) acc[a][b][m][n] = (f32x4){0.f, 0.f, 0.f, 0.f};
    bf16x8 At[4][2], B0[2][2], B1[2][2];
    const char* cA = (const char*)g.A + (size_t)cur.pm * tstep; const char* cB = (const char*)g.Bt + (size_t)cur.pn * tstep;
    S.a_ready(cur);
    if constexpr (SP2) {
        PG8_STAGE(PG8_SB(0, 0), cB, voffB); PG8_STAGE(PG8_SB(0, 1), cB + hstep, voffB); PG8_STAGE(PG8_SA(0, 0), cA, voffA); PG8_STAGE(PG8_SA(0, 1), cA + hstep, voffA);
        if (wr == 1) PG8_BAR;
        PG8_WAIT_V(2); PG8_BAR;
        PG8_STAGE(PG8_SB(1, 0), cB + kstep, voffB); PG8_STAGE(PG8_SA(1, 0), cA + kstep, voffA); PG8_STAGE(PG8_SB(1, 1), cB + hstep + kstep, voffB);
        PG8_WAIT_V(6); PG8_BAR;
    } else {
        PG8_STAGE(PG8_SB(0, 0), cB, voffB); PG8_STAGE(PG8_SA(0, 0), cA, voffA); PG8_STAGE(PG8_SB(0, 1), cB + hstep, voffB); PG8_STAGE(PG8_SA(0, 1), cA + hstep, voffA);
        if (wr == 1) PG8_BAR;
        PG8_WAIT_V(4); PG8_BAR;
        PG8_STAGE(PG8_SB(1, 0), cB + kstep, voffB); PG8_STAGE(PG8_SA(1, 0), cA + kstep, voffA); PG8_STAGE(PG8_SB(1, 1), cB + hstep + kstep, voffB);
        PG8_WAIT_V(6); PG8_BAR;
    }
    for (;;) {
        const bool has_next = S.next(ui + 1, nxt);
        const char* nA = has_next ? (const char*)g.A + (size_t)nxt.pm * tstep : cA; const char* nB = has_next ? (const char*)g.Bt + (size_t)nxt.pn * tstep : cB;
        for (int t = 0; t < nt; t += 2) {
            const bool last = (t == nt - 2);
            const char* a1 = cA + (size_t)(t + 1) * kstep;
            const char* a2 = last ? nA : cA + (size_t)(t + 2) * kstep; const char* b2 = last ? nB : cB + (size_t)(t + 2) * kstep;
            const char* a3 = a2 + kstep; const char* b3 = b2 + kstep;
            if (last && has_next) S.a_ready(nxt);
            if constexpr (SP2) {
            PG8_LDB(B0, 0, 0); PG8_LDB(B1, 0, 1); PG8_SCHED; PG8_LDA(At, 0, 0); PG8_STAGE(PG8_SA(1, 1), a1 + hstep, voffA);
            PG8_WAIT_V(8); PG8_WAIT_L(0); PG8_BAR; PG8_MMA(0, 0, At, B0); PG8_MMA(0, 1, At, B1); PG8_BAR; PG8_SCHED;
            PG8_LDA(At, 0, 1); PG8_STAGE(PG8_SB(0, 0), b2, voffB); PG8_STAGE(PG8_SB(0, 1), b2 + hstep, voffB); PG8_STAGE(PG8_SA(0, 0), a2, voffA);
            PG8_WAIT_V(8); PG8_WAIT_L(0); PG8_BAR; PG8_MMA(1, 0, At, B0); PG8_MMA(1, 1, At, B1); PG8_BAR; PG8_SCHED;
            PG8_LDB(B0, 1, 0); PG8_LDB(B1, 1, 1); PG8_SCHED; PG8_LDA(At, 1, 0); PG8_STAGE(PG8_SA(0, 1), a2 + hstep, voffA);
            PG8_WAIT_V(8); PG8_WAIT_L(0); PG8_BAR; PG8_MMA(0, 0, At, B0); PG8_MMA(0, 1, At, B1); PG8_BAR; PG8_SCHED;
            PG8_LDA(At, 1, 1); PG8_STAGE(PG8_SB(1, 0), b3, voffB); PG8_STAGE(PG8_SB(1, 1), b3 + hstep, voffB); PG8_STAGE(PG8_SA(1, 0), a3, voffA);
            PG8_WAIT_V(8); PG8_WAIT_L(0); PG8_BAR; PG8_MMA(1, 0, At, B0); PG8_MMA(1, 1, At, B1); PG8_BAR; PG8_SCHED;
            } else {
            PG8_LDB(B0, 0, 0); PG8_SCHED; PG8_LDA(At, 0, 0); PG8_STAGE(PG8_SA(1, 1), a1 + hstep, voffA);
            PG8_WAIT_L(8); PG8_BAR; PG8_WAIT_L(0); PG8_MMA(0, 0, At, B0); PG8_BAR; PG8_SCHED;
            PG8_LDB(B1, 0, 1); PG8_STAGE(PG8_SB(0, 0), b2, voffB);
            PG8_BAR; PG8_WAIT_L(0); PG8_MMA(0, 1, At, B1); PG8_BAR;
            PG8_LDA(At, 0, 1); PG8_STAGE(PG8_SA(0, 0), a2, voffA);
            PG8_BAR; PG8_WAIT_L(0); PG8_MMA(1, 0, At, B0); PG8_BAR; PG8_SCHED;
            PG8_STAGE(PG8_SB(0, 1), b2 + hstep, voffB);
            PG8_WAIT_V(6); PG8_BAR; PG8_MMA(1, 1, At, B1); PG8_BAR;
            PG8_LDB(B0, 1, 0); PG8_SCHED; PG8_LDA(At, 1, 0); PG8_STAGE(PG8_SA(0, 1), a2 + hstep, voffA);
            PG8_WAIT_L(8); PG8_BAR; PG8_WAIT_L(0); PG8_MMA(0, 0, At, B0); PG8_BAR; PG8_SCHED;
            PG8_LDB(B1, 1, 1); PG8_STAGE(PG8_SB(1, 0), b3, voffB);
            PG8_BAR; PG8_WAIT_L(0); PG8_MMA(0, 1, At, B1); PG8_BAR;
            PG8_LDA(At, 1, 1); PG8_STAGE(PG8_SA(1, 0), a3, voffA);
            PG8_BAR; PG8_WAIT_L(0); PG8_MMA(1, 0, At, B0); PG8_BAR; PG8_SCHED;
            PG8_STAGE(PG8_SB(1, 1), b3 + hstep, voffB);
            PG8_WAIT_V(6); PG8_BAR; PG8_MMA(1, 1, At, B1); PG8_BAR;
            }
        }
        if constexpr (ALIGN_EPI) { if (wr == 0) PG8_BAR; }
        if constexpr (!Epi::AFTER_DRAIN) { E(acc, cur, wr, wc, fr, fq); S.done(cur); }
        if (!has_next) break;
#pragma unroll
        for (int a = 0; a < 2; ++a)
#pragma unroll
            for (int b = 0; b < 2; ++b)
#pragma unroll
                for (int m = 0; m < 4; ++m)
#pragma unroll
                    for (int n = 0; n < 2; ++n) acc[a][b][m][n] = (f32x4){0.f, 0.f, 0.f, 0.f};
        cur = nxt; cA = nA; cB = nB; ++ui;
        if constexpr (ALIGN_EPI) { if (wr == 1) PG8_BAR; }
    }
    PG8_WAIT_V(0);
    if constexpr (!ALIGN_EPI) { if (wr == 0) PG8_BAR; }
    PG8_BAR;
    if constexpr (Epi::AFTER_DRAIN) { E.fused(acc, cur, wr, wc, fr, fq, lds, wid, lane); S.done(cur); }
#undef PG8_SA
#undef PG8_SB
#undef PG8_STAGE
#undef PG8_LDA
#undef PG8_LDB
#undef PG8_MMA
#undef PG8_WAIT_V
#undef PG8_WAIT_L
#undef PG8_BAR
#undef PG8_SCHED
}
}

constexpr int NWAVES = 8;
constexpr int BATCH = 4, SEQ = 2048, D = 4096, M = BATCH * SEQ;
constexpr int DN_H = 16, DN_DK = 128, DN_DV = 128, DN_KEY = 2048, DN_VAL = 2048, DN_QKV = 6144;
constexpr int GL_H = 8, GL_DK = 128, GL_DV = 256, GL_KEY = 1024, GL_VAL = 2048, GL_RANK = 16;
constexpr int DFF = 11008, IN_COLS = 22576;
constexpr float EPS = 1e-6f;
constexpr int PN = 22528;
constexpr int PC_QKV = 0, PC_Z = 6144, PC_GQ = 8192, PC_GK = 9216, PC_GV = 10240, PC_GR = 12288, PC_GATE_DN = 14336, PC_GATE_GLA = 18432;
constexpr int PSM = 64;
constexpr int NGU = 2 * DFF;

constexpr size_t MiB = 1u << 20;
constexpr size_t WS_CTL = 0, CTL_ZERO_BYTES = 1 * MiB;
constexpr size_t WS_WIN = 1 * MiB, WS_WSM = 177 * MiB, WS_WBDN = 178 * MiB, WS_WBGLA = 194 * MiB, WS_WOUT = 210 * MiB, WS_WFIN = 242 * MiB, WS_WFOUT = 414 * MiB;
constexpr size_t WS_H = 500 * MiB, WS_PROJ = 564 * MiB, WS_PSMALL = 916 * MiB;
constexpr size_t WS_QF = 918 * MiB, WS_KF = 982 * MiB, WS_VF = 1046 * MiB, WS_EK = 1110 * MiB, WS_BETA = 1142 * MiB, WS_G = 1143 * MiB;
constexpr size_t WS_ODN = 1144 * MiB, WS_OGLA = 1208 * MiB, WS_ONDN = 1272 * MiB, WS_ONGLA = 1304 * MiB, WS_END = 1336 * MiB;
constexpr size_t WS_TMP = 918 * MiB, WS_MERGED = 1046 * MiB, WS_X1 = 1110 * MiB, WS_GU = WS_PROJ, WS_HID = WS_WIN;
static_assert(WS_WIN + (size_t)PN * D * 2 <= WS_WSM && WS_WFIN + (size_t)NGU * D * 2 <= WS_WFOUT && WS_WFOUT + (size_t)D * DFF * 2 <= WS_H, "ws map (weights)");
static_assert(WS_PROJ + (size_t)M * PN * 2 <= WS_PSMALL && WS_GU + (size_t)M * NGU * 2 <= WS_PSMALL && WS_HID + (size_t)M * DFF * 2 <= WS_WSM, "ws map (activations)");
static_assert(WS_X1 + (size_t)M * D * 4 <= WS_ONDN, "ws map (x1)");
constexpr int CW_BAR = 4096;

constexpr int RING_OFF = 0, RING_BYTES = 131072;
constexpr int LDSCTL_OFF = RING_BYTES, MISC_OFF = LDSCTL_OFF + 320;
constexpr int LDS_BYTES = 147456;

#define GAS __attribute__((address_space(1)))
#define LAS __attribute__((address_space(3)))
typedef unsigned short bf16;
typedef unsigned v4u __attribute__((ext_vector_type(4)));
typedef unsigned v2u __attribute__((ext_vector_type(2)));
typedef float f32x4 __attribute__((ext_vector_type(4)));
typedef float f32x2 __attribute__((ext_vector_type(2)));
typedef short bf16x8 __attribute__((ext_vector_type(8)));
typedef GAS unsigned gu32;
#define RLX_AGENT __ATOMIC_RELAXED, __HIP_MEMORY_SCOPE_AGENT
#define LDS_WAIT() asm volatile("s_waitcnt lgkmcnt(0)" ::: "memory")
#define VM_WAIT() asm volatile("s_waitcnt vmcnt(0)" ::: "memory")
__device__ __forceinline__ unsigned f2bf(float f) { unsigned u = __builtin_bit_cast(unsigned, f); return (u + 0x7fffu + ((u >> 16) & 1u)) >> 16; }
__device__ __forceinline__ unsigned pk2(float lo, float hi) { return f2bf(lo) | (f2bf(hi) << 16); }
__device__ __forceinline__ float bflo(unsigned w) { return __uint_as_float(w << 16); }
__device__ __forceinline__ float bfhi(unsigned w) { return __uint_as_float(w & 0xffff0000u); }
__device__ __forceinline__ float bf1(bf16 b) { return __uint_as_float((unsigned)b << 16); }
__device__ __forceinline__ float sigmoid_f(float x) { return 1.0f / (1.0f + expf(-x)); }
__device__ __forceinline__ float silu_f(float x) { return x / (1.0f + expf(-x)); }
__device__ __forceinline__ float softplus_f(float x) { return fmaxf(x, 0.f) + log1pf(expf(-fabsf(x))); }
__device__ __forceinline__ float logsigmoid_f(float x) { return fminf(x, 0.f) - log1pf(expf(-fabsf(x))); }
__device__ __forceinline__ float wave_sum(float v) {
#pragma unroll
    for (int o = 1; o < 64; o <<= 1) v += __shfl_xor(v, o);
    return v;
}

#define XB_TMO      128
#define XB_XCNT(j)  (256  + 64 * (j))
#define XB_XSUB(j)  (1280 + 64 * (j))
#define XB_XGEN(j)  (2304 + 64 * (j))
#define XB_TOP      3328
#define XB_TOPGEN   3392
#define XCD_BAR_WORDS 3456
#define XB_SPIN_CAP (1u << 18)

__device__ __forceinline__ unsigned xb_ld(unsigned* p)              { return __hip_atomic_load(p, __ATOMIC_RELAXED, __HIP_MEMORY_SCOPE_AGENT); }
__device__ __forceinline__ unsigned xb_add(unsigned* p, unsigned v) { return __hip_atomic_fetch_add(p, v, __ATOMIC_RELAXED, __HIP_MEMORY_SCOPE_AGENT); }
__device__ __forceinline__ unsigned xb_xcc_id() { return (unsigned)__builtin_amdgcn_s_getreg((3 << 11) | 20) & 0xFu; }
#define XB_SPIN(cond, bar) do { unsigned _sp = 0; while (cond) { __builtin_amdgcn_s_sleep(1); \
    if ((++_sp & 255u) == 0u) { if (xb_ld(&(bar)[XB_TMO])) break; if (_sp > XB_SPIN_CAP) { atomicAdd(&(bar)[XB_TMO], 1u); break; } } } } while (0)

struct XcdBarrier {
    unsigned* bar; unsigned x;
    volatile LAS unsigned* st;
};

__device__ __forceinline__ XcdBarrier xcd_barrier_post(unsigned* bar, volatile LAS unsigned* st) {
    XcdBarrier b; b.bar = bar; b.x = xb_xcc_id(); b.st = st;
    if (threadIdx.x == 0) (void)xb_add(&bar[XB_XCNT(b.x)], 1u);
    return b;
}
__device__ __forceinline__ void xcd_barrier_complete(unsigned* bar, unsigned x, unsigned& nloc, unsigned& nx) {
    const unsigned G = gridDim.x * gridDim.y * gridDim.z;
    unsigned sum, cnt, mine, sp = 0u;
    for (;;) {
        sum = 0u; cnt = 0u; mine = 0u;
#pragma unroll
        for (unsigned j = 0; j < 16; ++j) { const unsigned c = xb_ld(&bar[XB_XCNT(j)]); sum += c; cnt += (c > 0u) ? 1u : 0u; mine = (j == x) ? c : mine; }
        if (sum == G) break;
        __builtin_amdgcn_s_sleep(1);
        if ((++sp & 255u) == 0u) { if (xb_ld(&bar[XB_TMO])) break; if (sp > XB_SPIN_CAP) { atomicAdd(&bar[XB_TMO], 1u); break; } }
    }
    nloc = mine > 0u ? mine : 1u; nx = cnt > 0u ? cnt : 1u;
}

__device__ __forceinline__ void xcd_barrier(const XcdBarrier& b) {
    asm volatile("s_waitcnt vmcnt(0)" ::: "memory");
    __syncthreads();
    if (threadIdx.x == 0) {
        unsigned* bar = b.bar;
        __builtin_amdgcn_s_waitcnt(0);
        unsigned nloc = b.st[0], nx = b.st[1];
        if (nloc == 0u) { xcd_barrier_complete(bar, b.x, nloc, nx); b.st[0] = nloc; b.st[1] = nx; }
        const unsigned old = xb_add(&bar[XB_XSUB(b.x)], 1u);
        const unsigned gen = old / nloc;
        if (old + 1u == (gen + 1u) * nloc) {
            __builtin_amdgcn_fence(__ATOMIC_RELEASE, "agent");
            asm volatile("s_waitcnt vmcnt(0)" ::: "memory");
            const unsigned og = xb_add(&bar[XB_TOP], 1u);
            const unsigned tg = og / nx;
            if (og + 1u == (tg + 1u) * nx) xb_add(&bar[XB_TOPGEN], 1u);
            else XB_SPIN(xb_ld(&bar[XB_TOPGEN]) == tg, bar);
            __builtin_amdgcn_fence(__ATOMIC_ACQUIRE, "agent");
            xb_add(&bar[XB_XGEN(b.x)], 1u);
            asm volatile("s_waitcnt vmcnt(0)" ::: "memory");
        } else {
            XB_SPIN(xb_ld(&bar[XB_XGEN(b.x)]) == gen, bar);
            __builtin_amdgcn_fence(__ATOMIC_ACQUIRE, "agent");
            asm volatile("s_waitcnt vmcnt(0)" ::: "memory");
        }
    }
    __syncthreads();
}

struct Frame {
    LAS unsigned char* lds;
    volatile LAS unsigned* MISC;
    gu32* ctl;
    int tid, lane, wave;
    int vcu, G;
    unsigned char* ws;
    const float* in[19];
    float* out;
};
enum { I_X = 0, I_NORM_MIX, I_W_IN, I_DN_CONV, I_DN_ALOG, I_DN_DTB, I_DN_NORM, I_GL_WA2, I_GL_BA, I_GL_NORM, I_W_BDN, I_W_BGLA, I_W_OUT, I_NORM_FFN, I_W_FIN, I_FFN_CW, I_FFN_CB, I_W_FOUT, I_NORM_FIN };

__device__ __forceinline__ void transpose_item(const float* W, size_t ldw, int k0, int sn0, bf16* WT, size_t ldk, int dn0, LAS float* scr, int lane) {
#pragma unroll 8
    for (int i = 0; i < 32; ++i) { const int kk = 2 * i + (lane >> 5); scr[kk * 33 + (lane & 31)] = W[(size_t)(k0 + kk) * ldw + sn0 + (lane & 31)]; }
    LDS_WAIT(); asm volatile("" ::: "memory");
    const int c = lane & 7;
#pragma unroll
    for (int j = 0; j < 4; ++j) { const int n = (lane >> 3) + 8 * j; const LAS float* s = scr + (8 * c) * 33 + n;
        v4u o; o.x = pk2(s[0 * 33], s[1 * 33]); o.y = pk2(s[2 * 33], s[3 * 33]); o.z = pk2(s[4 * 33], s[5 * 33]); o.w = pk2(s[6 * 33], s[7 * 33]);
        *(GAS v4u*)(WT + (size_t)(dn0 + n) * ldk + k0 + 8 * c) = o; }
    LDS_WAIT(); asm volatile("" ::: "memory");
}
__device__ __forceinline__ void rms_row(const float* xrow, const float* w, bf16* obf, float* of32, int lane) {
    const GAS f32x4* xr = (const GAS f32x4*)xrow + lane;
    f32x4 v[16]; float s = 0.f;
#pragma unroll
    for (int j = 0; j < 16; ++j) { v[j] = xr[64 * j]; s += (v[j].x * v[j].x + v[j].y * v[j].y) + (v[j].z * v[j].z + v[j].w * v[j].w); }
    const float rstd = 1.0f / sqrtf(wave_sum(s) * (1.f / D) + EPS);
    const GAS f32x4* wr = (const GAS f32x4*)w + lane;
    if (obf) { GAS v2u* o8 = (GAS v2u*)obf + lane;
#pragma unroll
        for (int j = 0; j < 16; ++j) { const f32x4 g = wr[64 * j]; v2u o; o.x = pk2(v[j].x * rstd * g.x, v[j].y * rstd * g.y); o.y = pk2(v[j].z * rstd * g.z, v[j].w * rstd * g.w); o8[64 * j] = o; } }
    else { GAS f32x4* o = (GAS f32x4*)of32 + lane;
#pragma unroll
        for (int j = 0; j < 16; ++j) { const f32x4 g = wr[64 * j]; o[64 * j] = (f32x4){v[j].x * rstd * g.x, v[j].y * rstd * g.y, v[j].z * rstd * g.z, v[j].w * rstd * g.w}; } }
}

__device__ __forceinline__ void p0_prologue(Frame& F) {
    LAS float* scr = (LAS float*)(F.lds + RING_OFF + F.wave * 16384);
    const int gw = F.vcu * NWAVES + F.wave, NGW = F.G * NWAVES;
    bf16* WIN = (bf16*)(F.ws + WS_WIN); bf16* WSM = (bf16*)(F.ws + WS_WSM); bf16* WBDN = (bf16*)(F.ws + WS_WBDN); bf16* WBGLA = (bf16*)(F.ws + WS_WBGLA);
    bf16* WOUT = (bf16*)(F.ws + WS_WOUT); bf16* WFIN = (bf16*)(F.ws + WS_WFIN); bf16* WFOUT = (bf16*)(F.ws + WS_WFOUT);
    constexpr int NB_IN = PN / 32, I_IN = (D / 64) * NB_IN;
    constexpr int I_SM = (D / 64) * 2;
    constexpr int I_BR = (2048 / 64) * (D / 32);
    constexpr int I_OUT = (D / 64) * (D / 32);
    constexpr int NB_FI = NGU / 32, I_FI = (D / 64) * NB_FI;
    constexpr int I_FO = (DFF / 64) * (D / 32);
    constexpr int NITEMS = I_IN + I_SM + 2 * I_BR + I_OUT + I_FI + I_FO;
    for (int it = gw; it < NITEMS; it += NGW) {
        int r = it;
        if (r < I_IN) { const int kb = r / NB_IN, nb = r % NB_IN, n0 = 32 * nb; const int sn0 = n0 + (n0 >= PC_GATE_DN ? 48 : (n0 >= PC_GQ ? 32 : 0));
            transpose_item(F.in[I_W_IN], IN_COLS, 64 * kb, sn0, WIN, D, n0, scr, F.lane); continue; } r -= I_IN;
        if (r < I_SM) { const int kb = r >> 1, nb = r & 1; transpose_item(F.in[I_W_IN], IN_COLS, 64 * kb, nb ? 14368 : 8192, WSM, D, 32 * nb, scr, F.lane); continue; } r -= I_SM;
        if (r < I_BR) { const int kb = r / (D / 32), nb = r % (D / 32); transpose_item(F.in[I_W_BDN], D, 64 * kb, 32 * nb, WBDN, 2048, 32 * nb, scr, F.lane); continue; } r -= I_BR;
        if (r < I_BR) { const int kb = r / (D / 32), nb = r % (D / 32); transpose_item(F.in[I_W_BGLA], D, 64 * kb, 32 * nb, WBGLA, 2048, 32 * nb, scr, F.lane); continue; } r -= I_BR;
        if (r < I_OUT) { const int kb = r / (D / 32), nb = r % (D / 32); transpose_item(F.in[I_W_OUT], D, 64 * kb, 32 * nb, WOUT, D, 32 * nb, scr, F.lane); continue; } r -= I_OUT;
        if (r < I_FI) { const int kb = r / NB_FI, nb = r % NB_FI, n0 = 32 * nb, j = n0 >> 8, i = n0 & 255; const int sn0 = (i < 128) ? (128 * j + i) : (DFF + 128 * j + (i - 128));
            transpose_item(F.in[I_W_FIN], NGU, 64 * kb, sn0, WFIN, D, n0, scr, F.lane); continue; } r -= I_FI;
        { const int kb = r / (D / 32), nb = r % (D / 32); transpose_item(F.in[I_W_FOUT], D, 64 * kb, 32 * nb, WFOUT, DFF, 32 * nb, scr, F.lane); }
    }
    bf16* H = (bf16*)(F.ws + WS_H);
    for (int m = gw; m < M; m += NGW) rms_row(F.in[I_X] + (size_t)m * D, F.in[I_NORM_MIX], H + (size_t)m * D, nullptr, F.lane);
}

__device__ __forceinline__ void p1_skinny(Frame& F) {
    const bf16* H = (const bf16*)(F.ws + WS_H); const bf16* WSM = (const bf16*)(F.ws + WS_WSM); float* PS = (float*)(F.ws + WS_PSMALL);
    const int lane = F.lane, fr = lane & 15, fq = lane >> 4;
    for (int t = (int)blockIdx.x + F.G * F.wave; t < M / 16; t += F.G * NWAVES) {
        const int row0 = 16 * t;
        const bf16* ap = H + (size_t)(row0 + fr) * D + 8 * fq; const bf16* bp = WSM + (size_t)fr * D + 8 * fq;
        f32x4 acc[4] = {{0.f, 0.f, 0.f, 0.f}, {0.f, 0.f, 0.f, 0.f}, {0.f, 0.f, 0.f, 0.f}, {0.f, 0.f, 0.f, 0.f}};
#pragma unroll 4
        for (int kk = 0; kk < D / 32; ++kk) {
            const bf16x8 a = *(const GAS bf16x8*)(ap + kk * 32);
#pragma unroll
            for (int cb = 0; cb < 4; ++cb) { const bf16x8 b = *(const GAS bf16x8*)(bp + (size_t)cb * 16 * D + kk * 32); acc[cb] = __builtin_amdgcn_mfma_f32_16x16x32_bf16(a, b, acc[cb], 0, 0, 0); }
        }
#pragma unroll
        for (int cb = 0; cb < 4; ++cb)
#pragma unroll
            for (int r = 0; r < 4; ++r) PS[(size_t)(row0 + 4 * fq + r) * PSM + cb * 16 + fr] = acc[cb][r];
    }
}

__device__ __forceinline__ void p2_prep(Frame& F) {
    const int gw = F.vcu * NWAVES + F.wave, NGW = F.G * NWAVES, lane = F.lane;
    const bf16* PROJ = (const bf16*)(F.ws + WS_PROJ); const float* PS = (const float*)(F.ws + WS_PSMALL);
    float* QF = (float*)(F.ws + WS_QF); float* KF = (float*)(F.ws + WS_KF); float* VF = (float*)(F.ws + WS_VF);
    float* EK = (float*)(F.ws + WS_EK); float* BETA = (float*)(F.ws + WS_BETA); float* GD = (float*)(F.ws + WS_G);
    const float* cw = F.in[I_DN_CONV];
    for (int id = gw; id < M * DN_H; id += NGW) {
        const int tg = id >> 4, h = id & 15, t = tg & (SEQ - 1), d0 = 2 * lane;
        float res[3][2];
#pragma unroll
        for (int p = 0; p < 3; ++p) { const int col = p * 2048 + h * 128 + d0; float y0 = 0.f, y1 = 0.f;
#pragma unroll
            for (int i = 0; i < 4; ++i) { const int tt = t - 3 + i; if (tt >= 0) { const unsigned xw = *(const GAS unsigned*)(PROJ + (size_t)(tg - 3 + i) * PN + PC_QKV + col);
                    const f32x2 w = *(const GAS f32x2*)(cw + (size_t)i * DN_QKV + col); y0 += w.x * bflo(xw); y1 += w.y * bfhi(xw); } }
            res[p][0] = silu_f(y0); res[p][1] = silu_f(y1); }
        const float sq = wave_sum(res[0][0] * res[0][0] + res[0][1] * res[0][1]), sk = wave_sum(res[1][0] * res[1][0] + res[1][1] * res[1][1]);
        const float iq = (1.0f / sqrtf(sq + EPS)) * 0.08838834764831845f, ik = 1.0f / sqrtf(sk + EPS);
        const size_t o = (size_t)tg * DN_KEY + h * 128 + d0;
        *(GAS f32x2*)(QF + o) = (f32x2){res[0][0] * iq, res[0][1] * iq}; *(GAS f32x2*)(KF + o) = (f32x2){res[1][0] * ik, res[1][1] * ik}; *(GAS f32x2*)(VF + o) = (f32x2){res[2][0], res[2][1]};
        if (lane == 0) { BETA[id] = sigmoid_f(PS[(size_t)tg * PSM + h]); GD[id] = -expf(F.in[I_DN_ALOG][h]) * softplus_f(PS[(size_t)tg * PSM + 16 + h] + F.in[I_DN_DTB][h]); }
    }
    const float* wa2 = F.in[I_GL_WA2]; const float* ba = F.in[I_GL_BA];
    for (int id = gw; id < M * GL_H; id += NGW) {
        const int tg = id >> 3, h = id & 7, c = h * 128 + 2 * lane;
        f32x2 x = *(const GAS f32x2*)(ba + c);
#pragma unroll
        for (int r = 0; r < GL_RANK; ++r) { const float lr = PS[(size_t)tg * PSM + 32 + r]; const f32x2 w = *(const GAS f32x2*)(wa2 + (size_t)r * GL_KEY + c); x.x += lr * w.x; x.y += lr * w.y; }
        *(GAS f32x2*)(EK + (size_t)tg * GL_KEY + c) = (f32x2){expf(logsigmoid_f(x.x) * (1.f / 16.f)), expf(logsigmoid_f(x.y) * (1.f / 16.f))};
    }
}

__device__ __forceinline__ void p3_scan_naive(Frame& F) {
    LAS float* sh = (LAS float*)(F.lds + RING_OFF);
    const int tid = F.tid; const int wg = (int)blockIdx.x;
    if (wg < 32) {
        const int sub = tid >> 8, tt = tid & 255, e = tt >> 1, half = tt & 1, bh = wg * 2 + sub, b = bh >> 4, h = bh & 15;
        const float* QF = (const float*)(F.ws + WS_QF); const float* KF = (const float*)(F.ws + WS_KF); const float* VF = (const float*)(F.ws + WS_VF);
        const float* BETA = (const float*)(F.ws + WS_BETA); const float* GD = (const float*)(F.ws + WS_G); float* ODN = (float*)(F.ws + WS_ODN);
        float S[64];
#pragma unroll
        for (int d = 0; d < 64; ++d) S[d] = 0.f;
        const float* KQ = (tt < 128) ? KF : QF;
        size_t o = (size_t)(b * SEQ) * DN_KEY + h * 128; int gi = (b * SEQ) * DN_H + h;
        float kqr = KQ[o + (tt & 127)], vr = VF[o + e], be = BETA[gi], gg = GD[gi];
        for (int t = 0; t < SEQ; ++t) {
            LAS float* kq = sh + ((t & 1) * 2 + sub) * 256;
            kq[tt] = kqr; const float v = vr, beta = be, decay = expf(gg); const size_t oc = o;
            if (t + 1 < SEQ) { o += DN_KEY; gi += DN_H; kqr = KQ[o + (tt & 127)]; vr = VF[o + e]; be = BETA[gi]; gg = GD[gi]; }
            __syncthreads();
            const LAS float* kp = kq + 64 * half; const LAS float* qp = kq + 128 + 64 * half;
            float ks0 = 0.f, ks1 = 0.f, ks2 = 0.f, ks3 = 0.f;
#pragma unroll
            for (int d = 0; d < 64; d += 4) { const f32x4 k4 = *(const LAS f32x4*)(kp + d); ks0 += k4.x * S[d]; ks1 += k4.y * S[d + 1]; ks2 += k4.z * S[d + 2]; ks3 += k4.w * S[d + 3]; }
            float ks = (ks0 + ks1) + (ks2 + ks3); ks += __shfl_xor(ks, 1);
            const float delta = beta * (v - decay * ks);
            float o0 = 0.f, o1 = 0.f, o2 = 0.f, o3 = 0.f;
#pragma unroll
            for (int d = 0; d < 64; d += 4) { const f32x4 k4 = *(const LAS f32x4*)(kp + d); const f32x4 q4 = *(const LAS f32x4*)(qp + d);
                S[d] = k4.x * delta + decay * S[d]; S[d + 1] = k4.y * delta + decay * S[d + 1]; S[d + 2] = k4.z * delta + decay * S[d + 2]; S[d + 3] = k4.w * delta + decay * S[d + 3];
                o0 += q4.x * S[d]; o1 += q4.y * S[d + 1]; o2 += q4.z * S[d + 2]; o3 += q4.w * S[d + 3]; }
            float ov = (o0 + o1) + (o2 + o3); ov += __shfl_xor(ov, 1);
            if (half == 0) ODN[oc + e] = ov;
        }
    } else if (wg < 64) {
        const int e = tid >> 1, half = tid & 1, bh = wg - 32, b = bh >> 3, h = bh & 7;
        const bf16* PROJ = (const bf16*)(F.ws + WS_PROJ); const float* EK = (const float*)(F.ws + WS_EK); float* OGLA = (float*)(F.ws + WS_OGLA);
        float S[64];
#pragma unroll
        for (int d = 0; d < 64; ++d) S[d] = 0.f;
        const int ee = tid & 127, role = tid >> 7;
        size_t tg = (size_t)b * SEQ;
        float a0 = (role == 0) ? EK[tg * GL_KEY + h * 128 + ee] : (role == 1) ? bf1(PROJ[tg * PN + PC_GK + h * 128 + ee]) : bf1(PROJ[tg * PN + PC_GQ + h * 128 + ee]) * 0.08838834764831845f;
        float vr = bf1(PROJ[tg * PN + PC_GV + h * 256 + e]);
        for (int t = 0; t < SEQ; ++t) {
            LAS float* buf = sh + (t & 1) * 384;
            if (role < 3) buf[tid] = a0;
            const float v = vr; const size_t tc = tg;
            if (t + 1 < SEQ) { ++tg; a0 = (role == 0) ? EK[tg * GL_KEY + h * 128 + ee] : (role == 1) ? bf1(PROJ[tg * PN + PC_GK + h * 128 + ee]) : bf1(PROJ[tg * PN + PC_GQ + h * 128 + ee]) * 0.08838834764831845f;
                vr = bf1(PROJ[tg * PN + PC_GV + h * 256 + e]); }
            __syncthreads();
            const LAS float* gp = buf + 64 * half;
            float o0 = 0.f, o1 = 0.f, o2 = 0.f, o3 = 0.f;
#pragma unroll
            for (int d = 0; d < 64; d += 4) { const f32x4 g4 = *(const LAS f32x4*)(gp + d); const f32x4 k4 = *(const LAS f32x4*)(gp + 128 + d); const f32x4 q4 = *(const LAS f32x4*)(gp + 256 + d);
                S[d] = g4.x * S[d] + k4.x * v; S[d + 1] = g4.y * S[d + 1] + k4.y * v; S[d + 2] = g4.z * S[d + 2] + k4.z * v; S[d + 3] = g4.w * S[d + 3] + k4.w * v;
                o0 += q4.x * S[d]; o1 += q4.y * S[d + 1]; o2 += q4.z * S[d + 2]; o3 += q4.w * S[d + 3]; }
            float ov = (o0 + o1) + (o2 + o3); ov += __shfl_xor(ov, 1);
            if (half == 0) OGLA[tc * GL_VAL + h * 256 + e] = ov;
        }
    }
}

__device__ __forceinline__ void p4_gated_norm(Frame& F) {
    const int gw = F.vcu * NWAVES + F.wave, NGW = F.G * NWAVES, lane = F.lane;
    const bf16* PROJ = (const bf16*)(F.ws + WS_PROJ); const float* ODN = (const float*)(F.ws + WS_ODN); const float* OGLA = (const float*)(F.ws + WS_OGLA);
    bf16* ONDN = (bf16*)(F.ws + WS_ONDN); bf16* ONGLA = (bf16*)(F.ws + WS_ONGLA);
    for (int id = gw; id < M * DN_H; id += NGW) {
        const int tg = id >> 4, h = id & 15, d0 = 2 * lane; const size_t o = (size_t)tg * DN_VAL + h * 128 + d0;
        const f32x2 v = *(const GAS f32x2*)(ODN + o); const float rstd = 1.0f / sqrtf(wave_sum(v.x * v.x + v.y * v.y) * (1.f / 128.f) + EPS);
        const f32x2 w = *(const GAS f32x2*)(F.in[I_DN_NORM] + d0); const unsigned z = *(const GAS unsigned*)(PROJ + (size_t)tg * PN + PC_Z + h * 128 + d0);
        *(GAS unsigned*)(ONDN + o) = pk2(v.x * rstd * w.x * silu_f(bflo(z)), v.y * rstd * w.y * silu_f(bfhi(z)));
    }
    for (int id = gw; id < M * GL_H; id += NGW) {
        const int tg = id >> 3, h = id & 7, d0 = 4 * lane; const size_t o = (size_t)tg * GL_VAL + h * 256 + d0;
        const f32x4 v = *(const GAS f32x4*)(OGLA + o); const float rstd = 1.0f / sqrtf(wave_sum((v.x * v.x + v.y * v.y) + (v.z * v.z + v.w * v.w)) * (1.f / 256.f) + EPS);
        const f32x4 w = *(const GAS f32x4*)(F.in[I_GL_NORM] + d0); const v2u r = *(const GAS v2u*)(PROJ + (size_t)tg * PN + PC_GR + h * 256 + d0);
        v2u ob; ob.x = pk2(v.x * rstd * w.x * silu_f(bflo(r.x)), v.y * rstd * w.y * silu_f(bfhi(r.x))); ob.y = pk2(v.z * rstd * w.z * silu_f(bflo(r.y)), v.w * rstd * w.w * silu_f(bfhi(r.y)));
        *(GAS v2u*)(ONGLA + o) = ob;
    }
}

__device__ __forceinline__ void p9_convglu(Frame& F) {
    const bf16* GU = (const bf16*)(F.ws + WS_GU); bf16* HID = (bf16*)(F.ws + WS_HID);
    const float* cw = F.in[I_FFN_CW]; const float* cb = F.in[I_FFN_CB];
    const size_t gt = (size_t)F.vcu * (NWAVES * 64) + F.tid, NT = (size_t)F.G * NWAVES * 64;
    constexpr int CG = DFF / 8;
    for (size_t id = gt; id < (size_t)M * CG; id += NT) {
        const int tg = (int)(id / CG), cg = (int)(id % CG), c0 = 8 * cg, j = c0 >> 7, i = c0 & 127, t = tg & (SEQ - 1);
        const bf16* gp = GU + (size_t)tg * NGU + 256 * j + i;
        float y[8];
#pragma unroll
        for (int q = 0; q < 8; ++q) y[q] = cb[c0 + q];
#pragma unroll
        for (int k = 0; k < 3; ++k) { const int dt = k - 2; if (t + dt >= 0) { const v4u g = *(const GAS v4u*)(gp + (ptrdiff_t)dt * NGU);
                const f32x4 w0 = *(const GAS f32x4*)(cw + (size_t)k * DFF + c0), w1 = *(const GAS f32x4*)(cw + (size_t)k * DFF + c0 + 4);
                y[0] += w0.x * bflo(g.x); y[1] += w0.y * bfhi(g.x); y[2] += w0.z * bflo(g.y); y[3] += w0.w * bfhi(g.y);
                y[4] += w1.x * bflo(g.z); y[5] += w1.y * bfhi(g.z); y[6] += w1.z * bflo(g.w); y[7] += w1.w * bfhi(g.w); } }
        const v4u up = *(const GAS v4u*)(gp + 128);
        v4u o; o.x = pk2(silu_f(y[0]) * bflo(up.x), silu_f(y[1]) * bfhi(up.x)); o.y = pk2(silu_f(y[2]) * bflo(up.y), silu_f(y[3]) * bfhi(up.y));
        o.z = pk2(silu_f(y[4]) * bflo(up.z), silu_f(y[5]) * bfhi(up.z)); o.w = pk2(silu_f(y[6]) * bflo(up.w), silu_f(y[7]) * bfhi(up.w));
        *(GAS v4u*)(HID + (size_t)tg * DFF + c0) = o;
    }
}

#ifndef MK_ONE_LAUNCH
#define MK_ONE_LAUNCH 0
#endif
constexpr int N_PHASES = 12;
struct Args { const float* in[19]; float* out; unsigned char* ws; int ph_lo, ph_hi; };
__global__ void __launch_bounds__(NWAVES * 64, 2) mk_fwd(Args args) {
    extern __shared__ __attribute__((aligned(16))) unsigned char lds[];
    Frame F;
    F.lds = (LAS unsigned char*)lds;
    F.MISC = (volatile LAS unsigned*)(F.lds + MISC_OFF);
    F.tid = threadIdx.x; F.lane = F.tid & 63; F.wave = __builtin_amdgcn_readfirstlane(F.tid >> 6);
    F.G = gridDim.x; { const int bx = blockIdx.x; F.vcu = (F.G % 8 == 0) ? (bx % 8) * (F.G / 8) + bx / 8 : bx; }
    F.ws = args.ws; F.ctl = (gu32*)(args.ws + WS_CTL); F.out = args.out;
#pragma unroll
    for (int i = 0; i < 19; ++i) F.in[i] = args.in[i];
    for (int u = F.tid; u < (LDS_BYTES - LDSCTL_OFF) / 4; u += NWAVES * 64) ((LAS unsigned*)(F.lds + LDSCTL_OFF))[u] = 0u;
    __syncthreads();
    XcdBarrier bar; bar.bar = (unsigned*)(F.ctl + CW_BAR); bar.x = 0; bar.st = nullptr;
    if (MK_ONE_LAUNCH) bar = xcd_barrier_post((unsigned*)(F.ctl + CW_BAR), F.MISC + 8);
    const int lo = args.ph_lo, hi = args.ph_hi;
#define IN(k) (lo <= (k) && (k) < hi)
#define SEAM(k) do { if (IN(k) && IN((k) + 1)) xcd_barrier(bar); } while (0)
    bf16* H = (bf16*)(F.ws + WS_H); bf16* PROJ = (bf16*)(F.ws + WS_PROJ);

    if (IN(0)) { p0_prologue(F); } SEAM(0);
    if (IN(1)) {
        p1_skinny(F);
        pg8::Gemm g{H, (const bf16*)(F.ws + WS_WIN), M, PN, D}; pg8::StaticOrder S; S.init(M, PN, F.G, (int)blockIdx.x);
        pg8::Epi<pg8::EPI_BF16> E{PROJ, PN, nullptr, 0, nullptr, 0, nullptr, 0};
        pg8::gemm_phase<pg8::Epi<pg8::EPI_BF16>, pg8::StaticOrder, true, true>(F.lds + RING_OFF, g, S, E);
    } SEAM(1);
    if (IN(2)) { p2_prep(F); } SEAM(2);
    if (IN(3)) { p3_scan_naive(F); } SEAM(3);
    if (IN(4)) { p4_gated_norm(F); } SEAM(4);
    if (IN(5)) {
        { pg8::Gemm g{(const bf16*)(F.ws + WS_ONDN), (const bf16*)(F.ws + WS_WBDN), M, D, DN_VAL}; pg8::StaticOrder S; S.init(M, D, F.G, (int)blockIdx.x);
          pg8::Epi<pg8::EPI_BRA> E{nullptr, 0, (float*)(F.ws + WS_TMP), D, nullptr, 0, PROJ + PC_GATE_DN, PN};
          pg8::gemm_phase<pg8::Epi<pg8::EPI_BRA>, pg8::StaticOrder, true, true>(F.lds + RING_OFF, g, S, E); }
        { pg8::Gemm g{(const bf16*)(F.ws + WS_ONGLA), (const bf16*)(F.ws + WS_WBGLA), M, D, GL_VAL}; pg8::StaticOrder S; S.init(M, D, F.G, (int)blockIdx.x);
          pg8::Epi<pg8::EPI_BRB> E{(bf16*)(F.ws + WS_MERGED), D, (float*)(F.ws + WS_TMP), D, nullptr, 0, PROJ + PC_GATE_GLA, PN};
          pg8::gemm_phase<pg8::Epi<pg8::EPI_BRB>, pg8::StaticOrder, true, true>(F.lds + RING_OFF, g, S, E); }
    } SEAM(5);
    if (IN(6)) {
        pg8::Gemm g{(const bf16*)(F.ws + WS_MERGED), (const bf16*)(F.ws + WS_WOUT), M, D, D}; pg8::StaticOrder S; S.init(M, D, F.G, (int)blockIdx.x);
        pg8::Epi<pg8::EPI_RES> E{nullptr, 0, (float*)(F.ws + WS_X1), D, F.in[I_X], D, nullptr, 0};
        pg8::gemm_phase<pg8::Epi<pg8::EPI_RES>, pg8::StaticOrder, true, true>(F.lds + RING_OFF, g, S, E);
    } SEAM(6);
    if (IN(7)) { const int gw = F.vcu * NWAVES + F.wave, NGW = F.G * NWAVES; const float* X1 = (const float*)(F.ws + WS_X1);
        for (int m = gw; m < M; m += NGW) rms_row(X1 + (size_t)m * D, F.in[I_NORM_FFN], H + (size_t)m * D, nullptr, F.lane); } SEAM(7);
    if (IN(8)) {
        pg8::Gemm g{H, (const bf16*)(F.ws + WS_WFIN), M, NGU, D}; pg8::StaticOrder S; S.init(M, NGU, F.G, (int)blockIdx.x);
        pg8::Epi<pg8::EPI_BF16> E{(bf16*)(F.ws + WS_GU), NGU, nullptr, 0, nullptr, 0, nullptr, 0};
        pg8::gemm_phase<pg8::Epi<pg8::EPI_BF16>, pg8::StaticOrder, true, true>(F.lds + RING_OFF, g, S, E);
    } SEAM(8);
    if (IN(9)) { p9_convglu(F); } SEAM(9);
    if (IN(10)) {
        pg8::Gemm g{(const bf16*)(F.ws + WS_HID), (const bf16*)(F.ws + WS_WFOUT), M, D, DFF}; pg8::StaticOrder S; S.init(M, D, F.G, (int)blockIdx.x);
        pg8::Epi<pg8::EPI_RES> E{nullptr, 0, F.out, D, (const float*)(F.ws + WS_X1), D, nullptr, 0};
        pg8::gemm_phase<pg8::Epi<pg8::EPI_RES>, pg8::StaticOrder, true, true>(F.lds + RING_OFF, g, S, E);
    } SEAM(10);
    if (IN(11)) { const int gw = F.vcu * NWAVES + F.wave, NGW = F.G * NWAVES;
        for (int m = gw; m < M; m += NGW) rms_row(F.out + (size_t)m * D, F.in[I_NORM_FIN], nullptr, F.out + (size_t)m * D, F.lane); }
#undef IN
#undef SEAM
}

extern "C" void kernel_launch(void* const* d_in, const int* in_sizes, int n_in, void* d_out, int out_size, void* d_ws, size_t ws_size, hipStream_t stream) {
    static int grid = 0;
    if (grid == 0) {
        if (n_in != 19 || in_sizes[0] != M * D || out_size != M * D || ws_size < WS_END) { fprintf(stderr, "kernel_launch: unexpected shapes: n_in %d in0 %d out %d ws %zu (need %zu)\n", n_in, n_in > 0 ? in_sizes[0] : -1, out_size, ws_size, (size_t)WS_END); grid = -1; return; }
        int dev = 0, cus = 0, per_cu = 0;
        if (hipGetDevice(&dev) != hipSuccess || hipDeviceGetAttribute(&cus, hipDeviceAttributeMultiprocessorCount, dev) != hipSuccess) { grid = -1; return; }
        if (hipFuncSetAttribute((const void*)mk_fwd, hipFuncAttributeMaxDynamicSharedMemorySize, LDS_BYTES) != hipSuccess) { fprintf(stderr, "kernel_launch: hipFuncSetAttribute failed\n"); grid = -1; return; }
        if (hipOccupancyMaxActiveBlocksPerMultiprocessor(&per_cu, (const void*)mk_fwd, NWAVES * 64, LDS_BYTES) != hipSuccess || per_cu < 1) fprintf(stderr, "kernel_launch: occupancy query says %d\n", per_cu);
        (void)hipGetLastError();
        grid = cus;
    }
    if (grid < 0) return;
    if (hipMemsetAsync((char*)d_ws + WS_CTL, 0, CTL_ZERO_BYTES, stream) != hipSuccess) return;
    Args a{};
    for (int i = 0; i < 19; ++i) a.in[i] = (const float*)d_in[i];
    a.out = (float*)d_out; a.ws = (unsigned char*)d_ws;
#if MK_ONE_LAUNCH
    a.ph_lo = 0; a.ph_hi = N_PHASES;
    hipLaunchKernelGGL(mk_fwd, dim3(grid), dim3(NWAVES * 64), LDS_BYTES, stream, a);
#else
    for (int p = 0; p < N_PHASES; ++p) { a.ph_lo = p; a.ph_hi = p + 1; hipLaunchKernelGGL(mk_fwd, dim3(grid), dim3(NWAVES * 64), LDS_BYTES, stream, a); }
#endif
}
```

```cpp
#define MK_ONE_LAUNCH 1
#include <hip/hip_runtime.h>
#include <cstdio>
#include <cstdint>
namespace pg8 {
#define PG8_LAS __attribute__((address_space(3)))
typedef unsigned short bf16_t;
typedef short bf16x8 __attribute__((ext_vector_type(8)));
typedef float f32x4 __attribute__((ext_vector_type(4)));
typedef unsigned u32x4 __attribute__((ext_vector_type(4)));
constexpr int BM = 256, BK = 64, HALF = 128, HTB = HALF * BK * 2  , STAGE_BYTES = 8 * HTB, NXCD = 8, WGM = 8;

__host__ __device__ __forceinline__ int lds_byte(int r, int c) { const int st = (r >> 4) * 2 + (c >> 5), rr = r & 15, cc = c & 31, ob = rr * 64 + cc * 2; return st * 1024 + (ob ^ (((ob >> 9) & 1) << 5)); }
__host__ __device__ __forceinline__ void stage_rc(int b, int& R, int& C) { const int st = b / 1024, sb = b % 1024, swz = sb ^ (((sb >> 9) & 1) << 5); R = (st >> 1) * 16 + swz / 64; C = (st & 1) * 32 + (swz % 64) / 2; }
__host__ __device__ __forceinline__ int perm32(int rho) { const int n = rho >> 4, i = rho & 15; return 8 * (i >> 2) + 4 * n + (i & 3); }

struct Unit { int pm, pn; };
struct Gemm { const bf16_t* A; const bf16_t* Bt; int M, N, K; };

struct StaticOrder {
    int nM, nN, nwg, G, c;
    __host__ __device__ void init(int M, int N, int G_, int c_) { nM = M / BM; nN = N / BM; nwg = nM * nN; G = G_; c = c_; }
    __host__ __device__ bool next(int i, Unit& u) const {
        const long L = (long)i * G + c; if (L >= nwg) return false;
        int wgid = (int)L; { const int q = nwg / NXCD, r = nwg % NXCD, xcd = wgid % NXCD, off = wgid / NXCD; wgid = (xcd < r ? xcd * (q + 1) : r * (q + 1) + (xcd - r) * q) + off; }
        const int nig = WGM * nN, gid = wgid / nig, fm = gid * WGM, gsz = (nM - fm) < WGM ? (nM - fm) : WGM;
        u.pm = fm + ((wgid % nig) % gsz); u.pn = (wgid % nig) / gsz; return true;
    }
    __device__ __forceinline__ void a_ready(const Unit&) const {}
    __device__ __forceinline__ void done(const Unit&) const {}
};

__device__ __forceinline__ unsigned cvt_pk_bf16(float lo, float hi) { unsigned r; asm volatile("v_cvt_pk_bf16_f32 %0, %1, %2" : "=v"(r) : "v"(lo), "v"(hi)); return r; }
__device__ __forceinline__ float bf_lo(unsigned w) { return __uint_as_float(w << 16); }
__device__ __forceinline__ float bf_hi(unsigned w) { return __uint_as_float(w & 0xffff0000u); }
__device__ __forceinline__ float sigm(float x) { return 1.0f / (1.0f + __expf(-x)); }
enum { EPI_BF16 = 0, EPI_BRA = 1, EPI_BRB = 2, EPI_RES = 3 };
template <int MODE> struct Epi {
    static constexpr bool PERM = true, AFTER_DRAIN = false;
    bf16_t* Ob; int ldo; float* Of; int ldf; const float* R; int ldr; const bf16_t* Gt; int ldg;
    __device__ __forceinline__ void operator()(const f32x4 (&acc)[2][2][4][2], const Unit& u, int wr, int wc, int fr, int fq) const {
        const int row0 = u.pm * BM + wr * 64 + fr, col0 = u.pn * BM + wc * 32 + 8 * fq;
#pragma unroll
        for (int ai = 0; ai < 2; ++ai)
#pragma unroll
            for (int m = 0; m < 4; ++m) { const size_t row = (size_t)(row0 + ai * HALF + m * 16);
#pragma unroll
                for (int bj = 0; bj < 2; ++bj) { const int col = col0 + bj * HALF; f32x4 v0 = acc[ai][bj][m][0], v1 = acc[ai][bj][m][1];
                    if (MODE == EPI_BRA || MODE == EPI_BRB) { const u32x4 g = *(const u32x4*)(Gt + row * ldg + col);
                        v0[0] *= sigm(bf_lo(g.x)); v0[1] *= sigm(bf_hi(g.x)); v0[2] *= sigm(bf_lo(g.y)); v0[3] *= sigm(bf_hi(g.y));
                        v1[0] *= sigm(bf_lo(g.z)); v1[1] *= sigm(bf_hi(g.z)); v1[2] *= sigm(bf_lo(g.w)); v1[3] *= sigm(bf_hi(g.w)); }
                    if (MODE == EPI_BRB) { const float* t = Of + row * ldf + col; v0 += *(const f32x4*)t; v1 += *(const f32x4*)(t + 4); }
                    if (MODE == EPI_RES) { const float* t = R + row * ldr + col; v0 += *(const f32x4*)t; v1 += *(const f32x4*)(t + 4); }
                    if (MODE == EPI_BF16 || MODE == EPI_BRB) { u32x4 w; w.x = cvt_pk_bf16(v0[0], v0[1]); w.y = cvt_pk_bf16(v0[2], v0[3]); w.z = cvt_pk_bf16(v1[0], v1[1]); w.w = cvt_pk_bf16(v1[2], v1[3]);
                        *(u32x4*)(Ob + row * ldo + col) = w; }
                    else { float* o = Of + row * ldf + col; *(f32x4*)o = v0; *(f32x4*)(o + 4) = v1; } }
                asm volatile("" ::: "memory"); }
    }
};

template <class Epi, class Sched, bool ALIGN_EPI = false, bool SP2 = false>
__device__ __forceinline__ void gemm_phase(PG8_LAS unsigned char* lds, const Gemm g, const Sched& S, const Epi& E) {
    const int tid = threadIdx.x, wid = __builtin_amdgcn_readfirstlane(tid >> 6), lane = tid & 63, wr = wid >> 2, wc = wid & 3, fr = lane & 15, fq = lane >> 4;
    const int K = g.K, nt = K / BK;
    unsigned voffA[2], voffB[2];
#pragma unroll
    for (int i = 0; i < 2; ++i) { int R, C; stage_rc(tid * 16 + i * 8192, R, C); const int Rb = Epi::PERM ? ((R & ~31) + perm32(R & 31)) : R;
        voffA[i] = (unsigned)(R * K + C) * 2u; voffB[i] = (unsigned)(Rb * K + C) * 2u; }
    const size_t kstep = (size_t)(BK * 2);
    const size_t hstep = (size_t)HALF * K * 2;
    const size_t tstep = 2 * hstep;
    const unsigned ldsw = (unsigned)wid * 1024u;
    const int aoff = lds_byte(wr * 64 + fr, fq * 8), boff = lds_byte(wc * 32 + fr, fq * 8);
#define PG8_SA(b, h) (((b) * 2 + (h)) * HTB)
#define PG8_SB(b, h) ((4 + (b) * 2 + (h)) * HTB)
#define PG8_STAGE(bufoff, gbase, voff) do { _Pragma("unroll") for (int _i = 0; _i < 2; ++_i) \
        __builtin_amdgcn_global_load_lds((const unsigned*)((const char*)(gbase) + (voff)[_i]), (PG8_LAS unsigned*)(lds + (bufoff) + ldsw + _i * 8192), 16, 0, 0); } while (0)
#define PG8_LDA(dst, b, h) do { _Pragma("unroll") for (int m = 0; m < 4; ++m) _Pragma("unroll") for (int k = 0; k < 2; ++k) dst[m][k] = *(const PG8_LAS bf16x8*)(lds + PG8_SA(b, h) + aoff + m * 2048 + k * 1024); } while (0)
#define PG8_LDB(dst, b, h) do { _Pragma("unroll") for (int n = 0; n < 2; ++n) _Pragma("unroll") for (int k = 0; k < 2; ++k) dst[n][k] = *(const PG8_LAS bf16x8*)(lds + PG8_SB(b, h) + boff + n * 2048 + k * 1024); } while (0)
#define PG8_MMA(ai, bj, At, Bt) do { __builtin_amdgcn_s_setprio(1); _Pragma("unroll") for (int m = 0; m < 4; ++m) _Pragma("unroll") for (int n = 0; n < 2; ++n) _Pragma("unroll") for (int k = 0; k < 2; ++k) \
        acc[ai][bj][m][n] = __builtin_amdgcn_mfma_f32_16x16x32_bf16(Bt[n][k], At[m][k], acc[ai][bj][m][n], 0, 0, 0); __builtin_amdgcn_s_setprio(0); } while (0)
#define PG8_WAIT_V(n) asm volatile("s_waitcnt vmcnt(" #n ")" ::: "memory")
#define PG8_WAIT_L(n) asm volatile("s_waitcnt lgkmcnt(" #n ")" ::: "memory")
#define PG8_BAR __builtin_amdgcn_s_barrier()
#define PG8_SCHED __builtin_amdgcn_sched_barrier(0)
    Unit cur, nxt; int ui = 0;
    if (!S.next(0, cur)) return;
    f32x4 acc[2][2][4][2];
#pragma unroll
    for (int a = 0; a < 2; ++a)
#pragma unroll
        for (int b = 0; b < 2; ++b)
#pragma unroll
            for (int m = 0; m < 4; ++m)
#pragma unroll
                for (int n = 0; n < 2; ++n) acc[a][b][m][n] = (f32x4){0.f, 0.f, 0.f, 0.f};
    bf16x8 At[4][2], B0[2][2], B1[2][2];
    const char* cA = (const char*)g.A + (size_t)cur.pm * tstep; const char* cB = (const char*)g.Bt + (size_t)cur.pn * tstep;
    S.a_ready(cur);
    if constexpr (SP2) {
        PG8_STAGE(PG8_SB(0, 0), cB, voffB); PG8_STAGE(PG8_SB(0, 1), cB + hstep, voffB); PG8_STAGE(PG8_SA(0, 0), cA, voffA); PG8_STAGE(PG8_SA(0, 1), cA + hstep, voffA);
        if (wr == 1) PG8_BAR;
        PG8_WAIT_V(2); PG8_BAR;
        PG8_STAGE(PG8_SB(1, 0), cB + kstep, voffB); PG8_STAGE(PG8_SA(1, 0), cA + kstep, voffA); PG8_STAGE(PG8_SB(1, 1), cB + hstep + kstep, voffB);
        PG8_WAIT_V(6); PG8_BAR;
    } else {
        PG8_STAGE(PG8_SB(0, 0), cB, voffB); PG8_STAGE(PG8_SA(0, 0), cA, voffA); PG8_STAGE(PG8_SB(0, 1), cB + hstep, voffB); PG8_STAGE(PG8_SA(0, 1), cA + hstep, voffA);
        if (wr == 1) PG8_BAR;
        PG8_WAIT_V(4); PG8_BAR;
        PG8_STAGE(PG8_SB(1, 0), cB + kstep, voffB); PG8_STAGE(PG8_SA(1, 0), cA + kstep, voffA); PG8_STAGE(PG8_SB(1, 1), cB + hstep + kstep, voffB);
        PG8_WAIT_V(6); PG8_BAR;
    }
    for (;;) {
        const bool has_next = S.next(ui + 1, nxt);
        const char* nA = has_next ? (const char*)g.A + (size_t)nxt.pm * tstep : cA; const char* nB = has_next ? (const char*)g.Bt + (size_t)nxt.pn * tstep : cB;
        for (int t = 0; t < nt; t += 2) {
            const bool last = (t == nt - 2);
            const char* a1 = cA + (size_t)(t + 1) * kstep;
            const char* a2 = last ? nA : cA + (size_t)(t + 2) * kstep; const char* b2 = last ? nB : cB + (size_t)(t + 2) * kstep;
            const char* a3 = a2 + kstep; const char* b3 = b2 + kstep;
            if (last && has_next) S.a_ready(nxt);
            if constexpr (SP2) {
            PG8_LDB(B0, 0, 0); PG8_LDB(B1, 0, 1); PG8_SCHED; PG8_LDA(At, 0, 0); PG8_STAGE(PG8_SA(1, 1), a1 + hstep, voffA);
            PG8_WAIT_V(8); PG8_WAIT_L(0); PG8_BAR; PG8_MMA(0, 0, At, B0); PG8_MMA(0, 1, At, B1); PG8_BAR; PG8_SCHED;
            PG8_LDA(At, 0, 1); PG8_STAGE(PG8_SB(0, 0), b2, voffB); PG8_STAGE(PG8_SB(0, 1), b2 + hstep, voffB); PG8_STAGE(PG8_SA(0, 0), a2, voffA);
            PG8_WAIT_V(8); PG8_WAIT_L(0); PG8_BAR; PG8_MMA(1, 0, At, B0); PG8_MMA(1, 1, At, B1); PG8_BAR; PG8_SCHED;
            PG8_LDB(B0, 1, 0); PG8_LDB(B1, 1, 1); PG8_SCHED; PG8_LDA(At, 1, 0); PG8_STAGE(PG8_SA(0, 1), a2 + hstep, voffA);
            PG8_WAIT_V(8); PG8_WAIT_L(0); PG8_BAR; PG8_MMA(0, 0, At, B0); PG8_MMA(0, 1, At, B1); PG8_BAR; PG8_SCHED;
            PG8_LDA(At, 1, 1); PG8_STAGE(PG8_SB(1, 0), b3, voffB); PG8_STAGE(PG8_SB(1, 1), b3 + hstep, voffB); PG8_STAGE(PG8_SA(1, 0), a3, voffA);
            PG8_WAIT_V(8); PG8_WAIT_L(0); PG8_BAR; PG8_MMA(1, 0, At, B0); PG8_MMA(1, 1, At, B1); PG8_BAR; PG8_SCHED;
            } else {
            PG8_LDB(B0, 0, 0); PG8_SCHED; PG8_LDA(At, 0, 0); PG8_STAGE(PG8_SA(1, 1), a1 + hstep, voffA);
            PG8_WAIT_L(8); PG8_BAR; PG8_WAIT_L(0); PG8_MMA(0, 0, At, B0); PG8_BAR; PG8_SCHED;
            PG8_LDB(B1, 0, 1); PG8_STAGE(PG8_SB(0, 0), b2, voffB);
            PG8_BAR; PG8_WAIT_L(0); PG8_MMA(0, 1, At, B1); PG8_BAR;
            PG8_LDA(At, 0, 1); PG8_STAGE(PG8_SA(0, 0), a2, voffA);
            PG8_BAR; PG8_WAIT_L(0); PG8_MMA(1, 0, At, B0); PG8_BAR; PG8_SCHED;
            PG8_STAGE(PG8_SB(0, 1), b2 + hstep, voffB);
            PG8_WAIT_V(6); PG8_BAR; PG8_MMA(1, 1, At, B1); PG8_BAR;
            PG8_LDB(B0, 1, 0); PG8_SCHED; PG8_LDA(At, 1, 0); PG8_STAGE(PG8_SA(0, 1), a2 + hstep, voffA);
            PG8_WAIT_L(8); PG8_BAR; PG8_WAIT_L(0); PG8_MMA(0, 0, At, B0); PG8_BAR; PG8_SCHED;
            PG8_LDB(B1, 1, 1); PG8_STAGE(PG8_SB(1, 0), b3, voffB);
            PG8_BAR; PG8_WAIT_L(0); PG8_MMA(0, 1, At, B1); PG8_BAR;
            PG8_LDA(At, 1, 1); PG8_STAGE(PG8_SA(1, 0), a3, voffA);
            PG8_BAR; PG8_WAIT_L(0); PG8_MMA(1, 0, At, B0); PG8_BAR; PG8_SCHED;
            PG8_STAGE(PG8_SB(1, 1), b3 + hstep, voffB);
            PG8_WAIT_V(6); PG8_BAR; PG8_MMA(1, 1, At, B1); PG8_BAR;
            }
        }
        if constexpr (ALIGN_EPI) { if (wr == 0) PG8_BAR; }
        if constexpr (!Epi::AFTER_DRAIN) { E(acc, cur, wr, wc, fr, fq); S.done(cur); }
        if (!has_next) break;
#pragma unroll
        for (int a = 0; a < 2; ++a)
#pragma unroll
            for (int b = 0; b < 2; ++b)
#pragma unroll
                for (int m = 0; m < 4; ++m)
#pragma unroll
                    for (int n = 0; n < 2; ++n) acc[a][b][m][n] = (f32x4){0.f, 0.f, 0.f, 0.f};
        cur = nxt; cA = nA; cB = nB; ++ui;
        if constexpr (ALIGN_EPI) { if (wr == 1) PG8_BAR; }
    }
    PG8_WAIT_V(0);
    if constexpr (!ALIGN_EPI) { if (wr == 0) PG8_BAR; }
    PG8_BAR;
    if constexpr (Epi::AFTER_DRAIN) { E.fused(acc, cur, wr, wc, fr, fq, lds, wid, lane); S.done(cur); }
#undef PG8_SA
#undef PG8_SB
#undef PG8_STAGE
#undef PG8_LDA
#undef PG8_LDB
#undef PG8_MMA
#undef PG8_WAIT_V
#undef PG8_WAIT_L
#undef PG8_BAR
#undef PG8_SCHED
}
}

constexpr int NWAVES = 8;
constexpr int BATCH = 4, SEQ = 2048, D = 4096, M = BATCH * SEQ;
constexpr int DN_H = 16, DN_DK = 128, DN_DV = 128, DN_KEY = 2048, DN_VAL = 2048, DN_QKV = 6144;
constexpr int GL_H = 8, GL_DK = 128, GL_DV = 256, GL_KEY = 1024, GL_VAL = 2048, GL_RANK = 16;
constexpr int DFF = 11008, IN_COLS = 22576;
constexpr float EPS = 1e-6f;
constexpr int PN = 22528;
constexpr int PC_QKV = 0, PC_Z = 6144, PC_GQ = 8192, PC_GK = 9216, PC_GV = 10240, PC_GR = 12288, PC_GATE_DN = 14336, PC_GATE_GLA = 18432;
constexpr int PSM = 64;
constexpr int NGU = 2 * DFF;

constexpr size_t MiB = 1u << 20;
constexpr size_t WS_CTL = 0, CTL_ZERO_BYTES = 1 * MiB;
constexpr size_t WS_WIN = 1 * MiB, WS_WSM = 177 * MiB, WS_WBDN = 178 * MiB, WS_WBGLA = 194 * MiB, WS_WOUT = 210 * MiB, WS_WFIN = 242 * MiB, WS_WFOUT = 414 * MiB;
constexpr size_t WS_H = 500 * MiB, WS_PROJ = 564 * MiB, WS_PSMALL = 916 * MiB;
constexpr size_t WS_DW = 918 * MiB, WS_DQE = 950 * MiB, WS_DKT = 982 * MiB, WS_DAT = 1014 * MiB, WS_DU = 1030 * MiB, WS_DDL = 1094 * MiB;
constexpr size_t WS_GQE = 1096 * MiB, WS_GKT = 1112 * MiB, WS_GAT = 1128 * MiB, WS_GVT = 1136 * MiB, WS_GDL = 1168 * MiB;
constexpr size_t WS_EK = 1170 * MiB;
constexpr size_t WS_QF = 918 * MiB, WS_KF = 982 * MiB, WS_VF = 1046 * MiB, WS_BETA = 1094 * MiB, WS_G = WS_BETA + 512 * 1024;
constexpr size_t WS_ODN = 1208 * MiB, WS_OGLA = 1272 * MiB, WS_ONDN = 1336 * MiB, WS_ONGLA = 1368 * MiB, WS_END = 1400 * MiB;
constexpr size_t WS_TMP = 918 * MiB, WS_MERGED = 1046 * MiB, WS_X1 = 1110 * MiB, WS_GU = WS_PROJ, WS_HID = WS_WIN;
static_assert(WS_WIN + (size_t)PN * D * 2 <= WS_WSM && WS_WFIN + (size_t)NGU * D * 2 <= WS_WFOUT && WS_WFOUT + (size_t)D * DFF * 2 <= WS_H, "ws map (weights)");
static_assert(WS_PROJ + (size_t)M * PN * 2 <= WS_PSMALL && WS_GU + (size_t)M * NGU * 2 <= WS_PSMALL && WS_HID + (size_t)M * DFF * 2 <= WS_WSM, "ws map (activations)");
static_assert(WS_X1 + (size_t)M * D * 4 <= WS_ONDN, "ws map (x1)");
constexpr int CW_BAR = 4096;

constexpr int RING_OFF = 0, RING_BYTES = 131072;
constexpr int LDSCTL_OFF = RING_BYTES, MISC_OFF = LDSCTL_OFF + 320;
constexpr int LDS_BYTES = 147456;

#define GAS __attribute__((address_space(1)))
#define LAS __attribute__((address_space(3)))
typedef unsigned short bf16;
typedef unsigned v4u __attribute__((ext_vector_type(4)));
typedef unsigned v2u __attribute__((ext_vector_type(2)));
typedef float f32x4 __attribute__((ext_vector_type(4)));
typedef float f32x2 __attribute__((ext_vector_type(2)));
typedef short bf16x8 __attribute__((ext_vector_type(8)));
typedef GAS unsigned gu32;
#define RLX_AGENT __ATOMIC_RELAXED, __HIP_MEMORY_SCOPE_AGENT
#define LDS_WAIT() asm volatile("s_waitcnt lgkmcnt(0)" ::: "memory")
#define VM_WAIT() asm volatile("s_waitcnt vmcnt(0)" ::: "memory")
__device__ __forceinline__ unsigned f2bf(float f) { unsigned u = __builtin_bit_cast(unsigned, f); return (u + 0x7fffu + ((u >> 16) & 1u)) >> 16; }
__device__ __forceinline__ unsigned pk2(float lo, float hi) { return f2bf(lo) | (f2bf(hi) << 16); }
__device__ __forceinline__ float bflo(unsigned w) { return __uint_as_float(w << 16); }
__device__ __forceinline__ float bfhi(unsigned w) { return __uint_as_float(w & 0xffff0000u); }
__device__ __forceinline__ float bf1(bf16 b) { return __uint_as_float((unsigned)b << 16); }
__device__ __forceinline__ float sigmoid_f(float x) { return 1.0f / (1.0f + expf(-x)); }
__device__ __forceinline__ float silu_f(float x) { return x / (1.0f + expf(-x)); }
__device__ __forceinline__ float softplus_f(float x) { return fmaxf(x, 0.f) + log1pf(expf(-fabsf(x))); }
__device__ __forceinline__ float logsigmoid_f(float x) { return fminf(x, 0.f) - log1pf(expf(-fabsf(x))); }
__device__ __forceinline__ float wave_sum(float v) {
#pragma unroll
    for (int o = 1; o < 64; o <<= 1) v += __shfl_xor(v, o);
    return v;
}

#define XB_TMO      128
#define XB_XCNT(j)  (256  + 64 * (j))
#define XB_XSUB(j)  (1280 + 64 * (j))
#define XB_XGEN(j)  (2304 + 64 * (j))
#define XB_TOP      3328
#define XB_TOPGEN   3392
#define XCD_BAR_WORDS 3456
#define XB_SPIN_CAP (1u << 18)

__device__ __forceinline__ unsigned xb_ld(unsigned* p)              { return __hip_atomic_load(p, __ATOMIC_RELAXED, __HIP_MEMORY_SCOPE_AGENT); }
__device__ __forceinline__ unsigned xb_add(unsigned* p, unsigned v) { return __hip_atomic_fetch_add(p, v, __ATOMIC_RELAXED, __HIP_MEMORY_SCOPE_AGENT); }
__device__ __forceinline__ unsigned xb_xcc_id() { return (unsigned)__builtin_amdgcn_s_getreg((3 << 11) | 20) & 0xFu; }
#define XB_SPIN(cond, bar) do { unsigned _sp = 0; while (cond) { __builtin_amdgcn_s_sleep(1); \
    if ((++_sp & 255u) == 0u) { if (xb_ld(&(bar)[XB_TMO])) break; if (_sp > XB_SPIN_CAP) { atomicAdd(&(bar)[XB_TMO], 1u); break; } } } } while (0)

struct XcdBarrier {
    unsigned* bar; unsigned x;
    volatile LAS unsigned* st;
};

__device__ __forceinline__ XcdBarrier xcd_barrier_post(unsigned* bar, volatile LAS unsigned* st) {
    XcdBarrier b; b.bar = bar; b.x = xb_xcc_id(); b.st = st;
    if (threadIdx.x == 0) (void)xb_add(&bar[XB_XCNT(b.x)], 1u);
    return b;
}
__device__ __forceinline__ void xcd_barrier_complete(unsigned* bar, unsigned x, unsigned& nloc, unsigned& nx) {
    const unsigned G = gridDim.x * gridDim.y * gridDim.z;
    unsigned sum, cnt, mine, sp = 0u;
    for (;;) {
        sum = 0u; cnt = 0u; mine = 0u;
#pragma unroll
        for (unsigned j = 0; j < 16; ++j) { const unsigned c = xb_ld(&bar[XB_XCNT(j)]); sum += c; cnt += (c > 0u) ? 1u : 0u; mine = (j == x) ? c : mine; }
        if (sum == G) break;
        __builtin_amdgcn_s_sleep(1);
        if ((++sp & 255u) == 0u) { if (xb_ld(&bar[XB_TMO])) break; if (sp > XB_SPIN_CAP) { atomicAdd(&bar[XB_TMO], 1u); break; } }
    }
    nloc = mine > 0u ? mine : 1u; nx = cnt > 0u ? cnt : 1u;
}

__device__ __forceinline__ void xcd_barrier(const XcdBarrier& b) {
    asm volatile("s_waitcnt vmcnt(0)" ::: "memory");
    __syncthreads();
    if (threadIdx.x == 0) {
        unsigned* bar = b.bar;
        __builtin_amdgcn_s_waitcnt(0);
        unsigned nloc = b.st[0], nx = b.st[1];
        if (nloc == 0u) { xcd_barrier_complete(bar, b.x, nloc, nx); b.st[0] = nloc; b.st[1] = nx; }
        const unsigned old = xb_add(&bar[XB_XSUB(b.x)], 1u);
        const unsigned gen = old / nloc;
        if (old + 1u == (gen + 1u) * nloc) {
            __builtin_amdgcn_fence(__ATOMIC_RELEASE, "agent");
            asm volatile("s_waitcnt vmcnt(0)" ::: "memory");
            const unsigned og = xb_add(&bar[XB_TOP], 1u);
            const unsigned tg = og / nx;
            if (og + 1u == (tg + 1u) * nx) xb_add(&bar[XB_TOPGEN], 1u);
            else XB_SPIN(xb_ld(&bar[XB_TOPGEN]) == tg, bar);
            __builtin_amdgcn_fence(__ATOMIC_ACQUIRE, "agent");
            xb_add(&bar[XB_XGEN(b.x)], 1u);
            asm volatile("s_waitcnt vmcnt(0)" ::: "memory");
        } else {
            XB_SPIN(xb_ld(&bar[XB_XGEN(b.x)]) == gen, bar);
            __builtin_amdgcn_fence(__ATOMIC_ACQUIRE, "agent");
            asm volatile("s_waitcnt vmcnt(0)" ::: "memory");
        }
    }
    __syncthreads();
}

struct Frame {
    LAS unsigned char* lds;
    volatile LAS unsigned* MISC;
    gu32* ctl;
    int tid, lane, wave;
    int vcu, G;
    unsigned char* ws;
    const float* in[19];
    float* out;
};
enum { I_X = 0, I_NORM_MIX, I_W_IN, I_DN_CONV, I_DN_ALOG, I_DN_DTB, I_DN_NORM, I_GL_WA2, I_GL_BA, I_GL_NORM, I_W_BDN, I_W_BGLA, I_W_OUT, I_NORM_FFN, I_W_FIN, I_FFN_CW, I_FFN_CB, I_W_FOUT, I_NORM_FIN };

__device__ __forceinline__ void transpose_item(const float* W, size_t ldw, int k0, int sn0, bf16* WT, size_t ldk, int dn0, LAS float* scr, int lane) {
#pragma unroll 8
    for (int i = 0; i < 32; ++i) { const int kk = 2 * i + (lane >> 5); scr[kk * 33 + (lane & 31)] = W[(size_t)(k0 + kk) * ldw + sn0 + (lane & 31)]; }
    LDS_WAIT(); asm volatile("" ::: "memory");
    const int c = lane & 7;
#pragma unroll
    for (int j = 0; j < 4; ++j) { const int n = (lane >> 3) + 8 * j; const LAS float* s = scr + (8 * c) * 33 + n;
        v4u o; o.x = pk2(s[0 * 33], s[1 * 33]); o.y = pk2(s[2 * 33], s[3 * 33]); o.z = pk2(s[4 * 33], s[5 * 33]); o.w = pk2(s[6 * 33], s[7 * 33]);
        *(GAS v4u*)(WT + (size_t)(dn0 + n) * ldk + k0 + 8 * c) = o; }
    LDS_WAIT(); asm volatile("" ::: "memory");
}
__device__ __forceinline__ void rms_row(const float* xrow, const float* w, bf16* obf, float* of32, int lane) {
    const GAS f32x4* xr = (const GAS f32x4*)xrow + lane;
    f32x4 v[16]; float s = 0.f;
#pragma unroll
    for (int j = 0; j < 16; ++j) { v[j] = xr[64 * j]; s += (v[j].x * v[j].x + v[j].y * v[j].y) + (v[j].z * v[j].z + v[j].w * v[j].w); }
    const float rstd = 1.0f / sqrtf(wave_sum(s) * (1.f / D) + EPS);
    const GAS f32x4* wr = (const GAS f32x4*)w + lane;
    if (obf) { GAS v2u* o8 = (GAS v2u*)obf + lane;
#pragma unroll
        for (int j = 0; j < 16; ++j) { const f32x4 g = wr[64 * j]; v2u o; o.x = pk2(v[j].x * rstd * g.x, v[j].y * rstd * g.y); o.y = pk2(v[j].z * rstd * g.z, v[j].w * rstd * g.w); o8[64 * j] = o; } }
    else { GAS f32x4* o = (GAS f32x4*)of32 + lane;
#pragma unroll
        for (int j = 0; j < 16; ++j) { const f32x4 g = wr[64 * j]; o[64 * j] = (f32x4){v[j].x * rstd * g.x, v[j].y * rstd * g.y, v[j].z * rstd * g.z, v[j].w * rstd * g.w}; } }
}

__device__ __forceinline__ void p0_prologue(Frame& F) {
    LAS float* scr = (LAS float*)(F.lds + RING_OFF + F.wave * 16384);
    const int gw = F.vcu * NWAVES + F.wave, NGW = F.G * NWAVES;
    bf16* WIN = (bf16*)(F.ws + WS_WIN); bf16* WSM = (bf16*)(F.ws + WS_WSM); bf16* WBDN = (bf16*)(F.ws + WS_WBDN); bf16* WBGLA = (bf16*)(F.ws + WS_WBGLA);
    bf16* WOUT = (bf16*)(F.ws + WS_WOUT); bf16* WFIN = (bf16*)(F.ws + WS_WFIN); bf16* WFOUT = (bf16*)(F.ws + WS_WFOUT);
    constexpr int NB_IN = PN / 32, I_IN = (D / 64) * NB_IN;
    constexpr int I_SM = (D / 64) * 2;
    constexpr int I_BR = (2048 / 64) * (D / 32);
    constexpr int I_OUT = (D / 64) * (D / 32);
    constexpr int NB_FI = NGU / 32, I_FI = (D / 64) * NB_FI;
    constexpr int I_FO = (DFF / 64) * (D / 32);
    constexpr int NITEMS = I_IN + I_SM + 2 * I_BR + I_OUT + I_FI + I_FO;
    for (int it = gw; it < NITEMS; it += NGW) {
        int r = it;
        if (r < I_IN) { const int kb = r / NB_IN, nb = r % NB_IN, n0 = 32 * nb; const int sn0 = n0 + (n0 >= PC_GATE_DN ? 48 : (n0 >= PC_GQ ? 32 : 0));
            transpose_item(F.in[I_W_IN], IN_COLS, 64 * kb, sn0, WIN, D, n0, scr, F.lane); continue; } r -= I_IN;
        if (r < I_SM) { const int kb = r >> 1, nb = r & 1; transpose_item(F.in[I_W_IN], IN_COLS, 64 * kb, nb ? 14368 : 8192, WSM, D, 32 * nb, scr, F.lane); continue; } r -= I_SM;
        if (r < I_BR) { const int kb = r / (D / 32), nb = r % (D / 32); transpose_item(F.in[I_W_BDN], D, 64 * kb, 32 * nb, WBDN, 2048, 32 * nb, scr, F.lane); continue; } r -= I_BR;
        if (r < I_BR) { const int kb = r / (D / 32), nb = r % (D / 32); transpose_item(F.in[I_W_BGLA], D, 64 * kb, 32 * nb, WBGLA, 2048, 32 * nb, scr, F.lane); continue; } r -= I_BR;
        if (r < I_OUT) { const int kb = r / (D / 32), nb = r % (D / 32); transpose_item(F.in[I_W_OUT], D, 64 * kb, 32 * nb, WOUT, D, 32 * nb, scr, F.lane); continue; } r -= I_OUT;
        if (r < I_FI) { const int kb = r / NB_FI, nb = r % NB_FI, n0 = 32 * nb, j = n0 >> 8, i = n0 & 255; const int sn0 = (i < 128) ? (128 * j + i) : (DFF + 128 * j + (i - 128));
            transpose_item(F.in[I_W_FIN], NGU, 64 * kb, sn0, WFIN, D, n0, scr, F.lane); continue; } r -= I_FI;
        { const int kb = r / (D / 32), nb = r % (D / 32); transpose_item(F.in[I_W_FOUT], D, 64 * kb, 32 * nb, WFOUT, DFF, 32 * nb, scr, F.lane); }
    }
    bf16* H = (bf16*)(F.ws + WS_H);
    for (int m = gw; m < M; m += NGW) rms_row(F.in[I_X] + (size_t)m * D, F.in[I_NORM_MIX], H + (size_t)m * D, nullptr, F.lane);
}

__device__ __forceinline__ void p1_skinny(Frame& F) {
    const bf16* H = (const bf16*)(F.ws + WS_H); const bf16* WSM = (const bf16*)(F.ws + WS_WSM); float* PS = (float*)(F.ws + WS_PSMALL);
    const int lane = F.lane, fr = lane & 15, fq = lane >> 4;
    for (int t = (int)blockIdx.x + F.G * F.wave; t < M / 16; t += F.G * NWAVES) {
        const int row0 = 16 * t;
        const bf16* ap = H + (size_t)(row0 + fr) * D + 8 * fq; const bf16* bp = WSM + (size_t)fr * D + 8 * fq;
        f32x4 acc[4] = {{0.f, 0.f, 0.f, 0.f}, {0.f, 0.f, 0.f, 0.f}, {0.f, 0.f, 0.f, 0.f}, {0.f, 0.f, 0.f, 0.f}};
#pragma unroll 4
        for (int kk = 0; kk < D / 32; ++kk) {
            const bf16x8 a = *(const GAS bf16x8*)(ap + kk * 32);
#pragma unroll
            for (int cb = 0; cb < 4; ++cb) { const bf16x8 b = *(const GAS bf16x8*)(bp + (size_t)cb * 16 * D + kk * 32); acc[cb] = __builtin_amdgcn_mfma_f32_16x16x32_bf16(a, b, acc[cb], 0, 0, 0); }
        }
#pragma unroll
        for (int cb = 0; cb < 4; ++cb)
#pragma unroll
            for (int r = 0; r < 4; ++r) PS[(size_t)(row0 + 4 * fq + r) * PSM + cb * 16 + fr] = acc[cb][r];
    }
}


constexpr int PQ = 136, PT = 72;
constexpr float QSCALE = 0.08838834764831845f;
__device__ __forceinline__ float silu_fast(float x) { return x / (1.0f + __expf(-x)); }
__device__ __forceinline__ v4u pack8(const float* y) { v4u o; o.x = pk2(y[0], y[1]); o.y = pk2(y[2], y[3]); o.z = pk2(y[4], y[5]); o.w = pk2(y[6], y[7]); return o; }
#define MFMA16(a, b, c) __builtin_amdgcn_mfma_f32_16x16x32_bf16((a), (b), (c), 0, 0, 0)

__device__ __forceinline__ void dn_conv16(const bf16* P, const float* cw, int tg, int t, int col, float (&y)[16]) {
#pragma unroll
    for (int c = 0; c < 16; ++c) y[c] = 0.f;
#pragma unroll
    for (int i = 0; i < 4; ++i) {
        if (t - 3 + i >= 0) {
            const bf16* src = P + (size_t)(tg - 3 + i) * PN + PC_QKV + col;
            const v4u x0 = *(const GAS v4u*)src, x1 = *(const GAS v4u*)(src + 8);
            const float* w = cw + (size_t)i * DN_QKV + col;
            const f32x4 w0 = *(const GAS f32x4*)w, w1 = *(const GAS f32x4*)(w + 4), w2 = *(const GAS f32x4*)(w + 8), w3 = *(const GAS f32x4*)(w + 12);
            y[0] += w0.x * bflo(x0.x); y[1] += w0.y * bfhi(x0.x); y[2] += w0.z * bflo(x0.y); y[3] += w0.w * bfhi(x0.y);
            y[4] += w1.x * bflo(x0.z); y[5] += w1.y * bfhi(x0.z); y[6] += w1.z * bflo(x0.w); y[7] += w1.w * bfhi(x0.w);
            y[8] += w2.x * bflo(x1.x); y[9] += w2.y * bfhi(x1.x); y[10] += w2.z * bflo(x1.y); y[11] += w2.w * bfhi(x1.y);
            y[12] += w3.x * bflo(x1.z); y[13] += w3.y * bfhi(x1.z); y[14] += w3.z * bflo(x1.w); y[15] += w3.w * bfhi(x1.w);
        }
    }
#pragma unroll
    for (int c = 0; c < 16; ++c) y[c] = silu_fast(y[c]);
}

constexpr int LP_KN = 0, LP_QN = 17408, LP_KB = 34816, LP_KDT = 52224, LP_RHS = 0, LP_A = 70656, LP_BV = 87040, LP_BETA = 87296;
__device__ __forceinline__ void dn_prep_chunk(Frame& F, int ch) {
    const int tid = F.tid, lane = F.lane, wave = F.wave, fr = lane & 15, fq = lane >> 4;
    const int h = ch & 15, bn = ch >> 4, n = bn & 31, b = bn >> 5, tg0 = b * SEQ + n * 64;
    const size_t id = (size_t)((b * DN_H + h) * 32 + n);
    LAS unsigned char* L = F.lds + RING_OFF;
    LAS bf16* Kn = (LAS bf16*)(L + LP_KN); LAS bf16* Qn = (LAS bf16*)(L + LP_QN); LAS bf16* KB = (LAS bf16*)(L + LP_KB); LAS bf16* KDTl = (LAS bf16*)(L + LP_KDT);
    LAS float* RHS = (LAS float*)(L + LP_RHS); LAS float* Al = (LAS float*)(L + LP_A); LAS float* bv = (LAS float*)(L + LP_BV); LAS float* betav = (LAS float*)(L + LP_BETA);
    const bf16* PROJ = (const bf16*)(F.ws + WS_PROJ); const float* PS = (const float*)(F.ws + WS_PSMALL);
    bf16* DW = (bf16*)(F.ws + WS_DW) + id * 8192; bf16* DQE = (bf16*)(F.ws + WS_DQE) + id * 8192; bf16* DKT = (bf16*)(F.ws + WS_DKT) + id * 8192;
    bf16* DAT = (bf16*)(F.ws + WS_DAT) + id * 4096; float* DU = (float*)(F.ws + WS_DU) + id * 8192; float* DDL = (float*)(F.ws + WS_DDL);
    if (tid < 64) {
        const int tg = tg0 + tid;
        float g = -expf(F.in[I_DN_ALOG][h]) * softplus_f(PS[(size_t)tg * PSM + 16 + h] + F.in[I_DN_DTB][h]);
#pragma unroll
        for (int o = 1; o < 64; o <<= 1) { const float tt = __shfl_up(g, o); if (lane >= o) g += tt; }
        bv[tid] = g; betav[tid] = sigmoid_f(PS[(size_t)tg * PSM + h]);
    }
    const int row = tid >> 3, cg = tid & 7, t = n * 64 + row, tg = tg0 + row, c0 = 16 * cg;
    float q[16], k[16], v[16];
    dn_conv16(PROJ, F.in[I_DN_CONV], tg, t, h * 128 + c0, q);
    dn_conv16(PROJ, F.in[I_DN_CONV], tg, t, 2048 + h * 128 + c0, k);
    dn_conv16(PROJ, F.in[I_DN_CONV], tg, t, 4096 + h * 128 + c0, v);
    float sq = 0.f, sk = 0.f;
#pragma unroll
    for (int c = 0; c < 16; ++c) { sq += q[c] * q[c]; sk += k[c] * k[c]; }
    sq += __shfl_xor(sq, 1); sq += __shfl_xor(sq, 2); sq += __shfl_xor(sq, 4);
    sk += __shfl_xor(sk, 1); sk += __shfl_xor(sk, 2); sk += __shfl_xor(sk, 4);
    const float iq = QSCALE / sqrtf(sq + EPS), ik = 1.0f / sqrtf(sk + EPS);
#pragma unroll
    for (int c = 0; c < 16; ++c) { q[c] *= iq; k[c] *= ik; }
    __syncthreads();
    const float bt = bv[row], bl = bv[63], beta = betav[row], eb = expf(bt), ekd = expf(bl - bt);
    {
        float tmp[16];
        *(LAS v4u*)(Kn + row * PQ + c0) = pack8(k); *(LAS v4u*)(Kn + row * PQ + c0 + 8) = pack8(k + 8);
        *(LAS v4u*)(Qn + row * PQ + c0) = pack8(q); *(LAS v4u*)(Qn + row * PQ + c0 + 8) = pack8(q + 8);
#pragma unroll
        for (int c = 0; c < 16; ++c) tmp[c] = k[c] * beta;
        *(LAS v4u*)(KB + row * PQ + c0) = pack8(tmp); *(LAS v4u*)(KB + row * PQ + c0 + 8) = pack8(tmp + 8);
#pragma unroll
        for (int c = 0; c < 16; ++c) KDTl[(c0 + c) * PT + row] = (bf16)f2bf(k[c] * ekd);
#pragma unroll
        for (int c = 0; c < 16; ++c) tmp[c] = q[c] * eb;
        *(GAS v4u*)(DQE + row * 128 + c0) = pack8(tmp); *(GAS v4u*)(DQE + row * 128 + c0 + 8) = pack8(tmp + 8);
        if (tid == 0) DDL[id] = expf(bl);
    }
    __syncthreads();
    {
        const int rb = wave >> 1;
        f32x4 kk[2] = {{0.f, 0.f, 0.f, 0.f}, {0.f, 0.f, 0.f, 0.f}}, qk[2] = {{0.f, 0.f, 0.f, 0.f}, {0.f, 0.f, 0.f, 0.f}};
#pragma unroll
        for (int ks = 0; ks < 4; ++ks) {
            const bf16x8 a = *(const LAS bf16x8*)(Kn + (16 * rb + fr) * PQ + 32 * ks + 8 * fq);
#pragma unroll
            for (int c2 = 0; c2 < 2; ++c2) { const int cb = (wave & 1) * 2 + c2;
                const bf16x8 b1 = *(const LAS bf16x8*)(KB + (16 * cb + fr) * PQ + 32 * ks + 8 * fq);
                const bf16x8 b2 = *(const LAS bf16x8*)(Qn + (16 * cb + fr) * PQ + 32 * ks + 8 * fq);
                kk[c2] = MFMA16(a, b1, kk[c2]); qk[c2] = MFMA16(a, b2, qk[c2]); }
        }
#pragma unroll
        for (int c2 = 0; c2 < 2; ++c2) { const int cb = (wave & 1) * 2 + c2, i = 16 * cb + fr, j0 = 16 * rb + 4 * fq; const float bi = bv[i];
            f32x4 av; float at[4];
#pragma unroll
            for (int r = 0; r < 4; ++r) { const int j = j0 + r; const float dec = (i >= j) ? expf(bi - bv[j]) : 0.f; av[r] = (i > j) ? kk[c2][r] * dec : 0.f; at[r] = (i >= j) ? qk[c2][r] * dec : 0.f; }
            *(LAS f32x4*)(Al + i * 64 + j0) = av;
            v2u w; w.x = pk2(at[0], at[1]); w.y = pk2(at[2], at[3]); *(GAS v2u*)(DAT + i * 64 + j0) = w; }
#pragma unroll
        for (int i = 0; i < 2; ++i) { const int id2 = tid + 512 * i, r = id2 >> 3, c = id2 & 7; *(GAS v4u*)(DKT + r * 64 + 8 * c) = *(const LAS v4u*)(KDTl + r * PT + 8 * c); }
    }
    __syncthreads();
    {
#pragma unroll
        for (int c = 0; c < 16; c += 4) {
            *(LAS f32x4*)(RHS + row * 256 + c0 + c) = (f32x4){k[c] * beta * eb, k[c + 1] * beta * eb, k[c + 2] * beta * eb, k[c + 3] * beta * eb};
            *(LAS f32x4*)(RHS + row * 256 + 128 + c0 + c) = (f32x4){v[c] * beta, v[c + 1] * beta, v[c + 2] * beta, v[c + 3] * beta}; }
    }
    __syncthreads();
    if (wave < 4) {
        const int c = 64 * wave + lane;
        float X[64];
#pragma unroll
        for (int i = 0; i < 64; ++i) {
            float x0 = RHS[i * 256 + c], x1 = 0.f, x2 = 0.f, x3 = 0.f;
#pragma unroll
            for (int j4 = 0; j4 < i; j4 += 4) {
                const f32x4 a = *(const LAS f32x4*)(Al + i * 64 + j4);
                x0 -= a.x * X[j4];
                if (j4 + 1 < i) x1 -= a.y * X[j4 + 1];
                if (j4 + 2 < i) x2 -= a.z * X[j4 + 2];
                if (j4 + 3 < i) x3 -= a.w * X[j4 + 3];
            }
            X[i] = (x0 + x1) + (x2 + x3);
            asm volatile("" ::: "memory");
        }
        if (wave < 2) {
#pragma unroll
            for (int i = 0; i < 64; ++i) DW[i * 128 + c] = (bf16)f2bf(-X[i]);
        } else {
#pragma unroll
            for (int i = 0; i < 64; ++i) DU[i * 128 + (c - 128)] = X[i];
        }
    }
    __syncthreads();
}

constexpr int LG_QE = 0, LG_KE = 17408, LG_VT = 34816, LG_LR = 71680, LG_TOT = 75776;
__device__ __forceinline__ void gla_prep_chunk(Frame& F, int ch) {
    const int tid = F.tid, lane = F.lane, wave = F.wave, fr = lane & 15, fq = lane >> 4;
    const int h = ch & 7, bn = ch >> 3, n = bn & 31, b = bn >> 5, tg0 = b * SEQ + n * 64;
    const size_t id = (size_t)((b * GL_H + h) * 32 + n);
    LAS unsigned char* L = F.lds + RING_OFF;
    LAS bf16* QEl = (LAS bf16*)(L + LG_QE); LAS bf16* KEl = (LAS bf16*)(L + LG_KE); LAS bf16* VTl = (LAS bf16*)(L + LG_VT);
    LAS float* lrl = (LAS float*)(L + LG_LR); LAS float* tot = (LAS float*)(L + LG_TOT);
    const bf16* PROJ = (const bf16*)(F.ws + WS_PROJ); const float* PS = (const float*)(F.ws + WS_PSMALL);
    bf16* GQE = (bf16*)(F.ws + WS_GQE) + id * 8192; bf16* GKT = (bf16*)(F.ws + WS_GKT) + id * 8192; bf16* GAT = (bf16*)(F.ws + WS_GAT) + id * 4096;
    bf16* GVT = (bf16*)(F.ws + WS_GVT) + id * 16384; float* GDL = (float*)(F.ws + WS_GDL) + id * 128;
#pragma unroll
    for (int i = 0; i < 2; ++i) { const int e = tid + 512 * i; lrl[e] = PS[(size_t)(tg0 + (e >> 4)) * PSM + 32 + (e & 15)]; }
#pragma unroll
    for (int i = 0; i < 4; ++i) { const int e = tid + 512 * i, r = e >> 5, c = e & 31; const v4u x = *(const GAS v4u*)(PROJ + (size_t)(tg0 + r) * PN + PC_GV + h * 256 + 8 * c);
        LAS bf16* d = VTl + (8 * c) * PT + r;
        d[0 * PT] = (bf16)(x.x & 0xffffu); d[1 * PT] = (bf16)(x.x >> 16); d[2 * PT] = (bf16)(x.y & 0xffffu); d[3 * PT] = (bf16)(x.y >> 16);
        d[4 * PT] = (bf16)(x.z & 0xffffu); d[5 * PT] = (bf16)(x.z >> 16); d[6 * PT] = (bf16)(x.w & 0xffffu); d[7 * PT] = (bf16)(x.w >> 16); }
    const int d = tid & 127, rg = tid >> 7, r0 = 16 * rg, col = h * 128 + d;
    float w2[16];
#pragma unroll
    for (int r = 0; r < 16; ++r) w2[r] = F.in[I_GL_WA2][(size_t)r * GL_KEY + col];
    const float ba = F.in[I_GL_BA][col];
    float qv[16], kv[16];
#pragma unroll
    for (int i = 0; i < 16; ++i) { const size_t o = (size_t)(tg0 + r0 + i) * PN + h * 128 + d; qv[i] = bf1(PROJ[o + PC_GQ]) * QSCALE; kv[i] = bf1(PROJ[o + PC_GK]); }
    __syncthreads();
    float cs[16]; float run = 0.f;
#pragma unroll
    for (int i = 0; i < 16; ++i) { float x = ba;
#pragma unroll
        for (int r = 0; r < 16; r += 4) { const f32x4 l4 = *(const LAS f32x4*)(lrl + (r0 + i) * 16 + r); x += l4.x * w2[r] + l4.y * w2[r + 1] + l4.z * w2[r + 2] + l4.w * w2[r + 3]; }
        run += logsigmoid_f(x) * (1.f / 16.f); cs[i] = run; }
    tot[rg * 128 + d] = run;
    __syncthreads();
    float off = 0.f, bl = 0.f;
#pragma unroll
    for (int g = 0; g < 4; ++g) { const float tg_ = tot[g * 128 + d]; if (g < rg) off += tg_; bl += tg_; }
    {
        float kd[16];
#pragma unroll
        for (int i = 0; i < 16; ++i) { const float bb = off + cs[i]; QEl[(r0 + i) * PQ + d] = (bf16)f2bf(qv[i] * expf(bb)); KEl[(r0 + i) * PQ + d] = (bf16)f2bf(kv[i] * expf(-bb)); kd[i] = kv[i] * expf(bl - bb); }
        *(GAS v4u*)(GKT + d * 64 + r0) = pack8(kd); *(GAS v4u*)(GKT + d * 64 + r0 + 8) = pack8(kd + 8);
        if (rg == 0) GDL[d] = expf(bl);
    }
    __syncthreads();
    {
        const int rb = wave >> 1;
        f32x4 qk[2] = {{0.f, 0.f, 0.f, 0.f}, {0.f, 0.f, 0.f, 0.f}};
#pragma unroll
        for (int ks = 0; ks < 4; ++ks) {
            const bf16x8 a = *(const LAS bf16x8*)(KEl + (16 * rb + fr) * PQ + 32 * ks + 8 * fq);
#pragma unroll
            for (int c2 = 0; c2 < 2; ++c2) { const int cb = (wave & 1) * 2 + c2; const bf16x8 b2 = *(const LAS bf16x8*)(QEl + (16 * cb + fr) * PQ + 32 * ks + 8 * fq); qk[c2] = MFMA16(a, b2, qk[c2]); }
        }
#pragma unroll
        for (int c2 = 0; c2 < 2; ++c2) { const int cb = (wave & 1) * 2 + c2, i = 16 * cb + fr, j0 = 16 * rb + 4 * fq; float at[4];
#pragma unroll
            for (int r = 0; r < 4; ++r) at[r] = (i >= j0 + r) ? qk[c2][r] : 0.f;
            v2u w; w.x = pk2(at[0], at[1]); w.y = pk2(at[2], at[3]); *(GAS v2u*)(GAT + i * 64 + j0) = w; }
#pragma unroll
        for (int i = 0; i < 2; ++i) { const int e = tid + 512 * i, r = e >> 4, c = e & 15; *(GAS v4u*)(GQE + r * 128 + 8 * c) = *(const LAS v4u*)(QEl + r * PQ + 8 * c); }
#pragma unroll
        for (int i = 0; i < 4; ++i) { const int e = tid + 512 * i, r = e >> 3, c = e & 7; *(GAS v4u*)(GVT + r * 64 + 8 * c) = *(const LAS v4u*)(VTl + r * PT + 8 * c); }
    }
    __syncthreads();
}

constexpr int LS_W = 0, LS_QE = 17408, LS_KDT = 34816, LS_ATT = 53248, LS_VN = 62464, LS_ST0 = 71680, LS_ST1 = 89088, LS_END = 106496;
template <bool DN> __device__ __forceinline__ void scan_task(Frame& F, int bh, int part) {
    constexpr int H = DN ? DN_H : GL_H, DV = DN ? DN_DV : GL_DV;
    const int tid = F.tid, lane = F.lane, wave = F.wave, fr = lane & 15, fq = lane >> 4;
    const int b = bh / H, h = bh % H, dv0 = 64 * part;
    LAS unsigned char* L = F.lds + RING_OFF;
    LAS bf16* Wl = (LAS bf16*)(L + LS_W); LAS bf16* QEl = (LAS bf16*)(L + LS_QE); LAS bf16* KDTl = (LAS bf16*)(L + LS_KDT); LAS bf16* ATTl = (LAS bf16*)(L + LS_ATT);
    LAS bf16* VNt = (LAS bf16*)(L + LS_VN);
    const bf16* gW = (const bf16*)(F.ws + WS_DW) + (size_t)bh * 32 * 8192;
    const bf16* gQE = (const bf16*)(F.ws + (DN ? WS_DQE : WS_GQE)) + (size_t)bh * 32 * 8192;
    const bf16* gKT = (const bf16*)(F.ws + (DN ? WS_DKT : WS_GKT)) + (size_t)bh * 32 * 8192;
    const bf16* gAT = (const bf16*)(F.ws + (DN ? WS_DAT : WS_GAT)) + (size_t)bh * 32 * 4096;
    const float* gU = (const float*)(F.ws + WS_DU) + (size_t)bh * 32 * 8192;
    const bf16* gVT = (const bf16*)(F.ws + WS_GVT) + (size_t)bh * 32 * 16384 + (size_t)dv0 * 64;
    const float* gDL = DN ? (const float*)(F.ws + WS_DDL) + (size_t)bh * 32 : (const float*)(F.ws + WS_GDL) + (size_t)bh * 32 * 128;
    float* gO = (float*)(F.ws + (DN ? WS_ODN : WS_OGLA)) + (size_t)(b * SEQ) * 2048 + h * DV + dv0;
    for (int e = tid; e < 17408 / 4; e += NWAVES * 64) ((LAS unsigned*)(L + LS_ST0))[e] = 0u;
    f32x4 Sacc[4] = {{0.f, 0.f, 0.f, 0.f}, {0.f, 0.f, 0.f, 0.f}, {0.f, 0.f, 0.f, 0.f}, {0.f, 0.f, 0.f, 0.f}};
    const int rw0 = tid >> 4, cw0 = tid & 15;
    const int rk0 = tid >> 3, ck0 = tid & 7;
    const int rb = wave >> 1, cbw = (wave & 1) * 2;
    v4u sW[2], sQ[2], sK[2], sA, sV; f32x4 sDL; float sdl = 0.f; float uN[2][4];
    sW[0] = sW[1] = sQ[0] = sQ[1] = sK[0] = sK[1] = sA = sV = (v4u){0u, 0u, 0u, 0u}; sDL = (f32x4){0.f, 0.f, 0.f, 0.f};
#define SCAN_LOAD(n_) do { const size_t o8 = (size_t)(n_) * 8192, o4 = (size_t)(n_) * 4096; \
        if (DN) { sW[0] = *(const GAS v4u*)(gW + o8 + tid * 8); sW[1] = *(const GAS v4u*)(gW + o8 + 4096 + tid * 8); } \
        sQ[0] = *(const GAS v4u*)(gQE + o8 + tid * 8); sQ[1] = *(const GAS v4u*)(gQE + o8 + 4096 + tid * 8); \
        sK[0] = *(const GAS v4u*)(gKT + o8 + tid * 8); sK[1] = *(const GAS v4u*)(gKT + o8 + 4096 + tid * 8); \
        sA = *(const GAS v4u*)(gAT + o4 + tid * 8); \
        if (DN) { sdl = gDL[(n_)]; _Pragma("unroll") for (int c2 = 0; c2 < 2; ++c2) _Pragma("unroll") for (int r = 0; r < 4; ++r) uN[c2][r] = gU[o8 + (16 * rb + 4 * fq + r) * 128 + dv0 + 16 * (cbw + c2) + fr]; } \
        else { sV = *(const GAS v4u*)(gVT + (size_t)(n_) * 16384 + tid * 8); sDL = *(const GAS f32x4*)(gDL + (n_) * 128 + 16 * wave + 4 * fq); } } while (0)
#define SCAN_STORE() do { \
        if (DN) { *(LAS v4u*)(Wl + rw0 * PQ + 8 * cw0) = sW[0]; *(LAS v4u*)(Wl + (rw0 + 32) * PQ + 8 * cw0) = sW[1]; } \
        *(LAS v4u*)(QEl + rw0 * PQ + 8 * cw0) = sQ[0]; *(LAS v4u*)(QEl + (rw0 + 32) * PQ + 8 * cw0) = sQ[1]; \
        *(LAS v4u*)(KDTl + rk0 * PT + 8 * ck0) = sK[0]; *(LAS v4u*)(KDTl + (rk0 + 64) * PT + 8 * ck0) = sK[1]; \
        *(LAS v4u*)(ATTl + rk0 * PT + 8 * ck0) = sA; \
        if (!DN) *(LAS v4u*)(VNt + rk0 * PT + 8 * ck0) = sV; } while (0)
    SCAN_LOAD(0);
    SCAN_STORE();
    float uC[2][4]; float dlC = sdl; f32x4 dlV = sDL;
#pragma unroll
    for (int c2 = 0; c2 < 2; ++c2)
#pragma unroll
        for (int r = 0; r < 4; ++r) uC[c2][r] = DN ? uN[c2][r] : 0.f;
    __syncthreads();
    for (int n = 0; n < 32; ++n) {
        LAS bf16* Sc = (LAS bf16*)(L + ((n & 1) ? LS_ST1 : LS_ST0)); LAS bf16* Sn = (LAS bf16*)(L + ((n & 1) ? LS_ST0 : LS_ST1));
        if (n + 1 < 32) SCAN_LOAD(n + 1);
        if (DN) {
            f32x4 va[2];
#pragma unroll
            for (int c2 = 0; c2 < 2; ++c2) va[c2] = (f32x4){uC[c2][0], uC[c2][1], uC[c2][2], uC[c2][3]};
#pragma unroll
            for (int ks = 0; ks < 4; ++ks) { const bf16x8 a = *(const LAS bf16x8*)(Wl + (16 * rb + fr) * PQ + 32 * ks + 8 * fq);
#pragma unroll
                for (int c2 = 0; c2 < 2; ++c2) { const bf16x8 bb = *(const LAS bf16x8*)(Sc + (16 * (cbw + c2) + fr) * PQ + 32 * ks + 8 * fq); va[c2] = MFMA16(a, bb, va[c2]); } }
#pragma unroll
            for (int c2 = 0; c2 < 2; ++c2) { v2u w; w.x = pk2(va[c2][0], va[c2][1]); w.y = pk2(va[c2][2], va[c2][3]); *(LAS v2u*)(VNt + (16 * (cbw + c2) + fr) * PT + 16 * rb + 4 * fq) = w; }
            __syncthreads();
        }
        {
            f32x4 oa[2] = {{0.f, 0.f, 0.f, 0.f}, {0.f, 0.f, 0.f, 0.f}};
#pragma unroll
            for (int ks = 0; ks < 4; ++ks) { const bf16x8 a = *(const LAS bf16x8*)(QEl + (16 * rb + fr) * PQ + 32 * ks + 8 * fq);
#pragma unroll
                for (int c2 = 0; c2 < 2; ++c2) { const bf16x8 bb = *(const LAS bf16x8*)(Sc + (16 * (cbw + c2) + fr) * PQ + 32 * ks + 8 * fq); oa[c2] = MFMA16(a, bb, oa[c2]); } }
#pragma unroll
            for (int ks = 0; ks < 2; ++ks) { const bf16x8 a = *(const LAS bf16x8*)(ATTl + (16 * rb + fr) * PT + 32 * ks + 8 * fq);
#pragma unroll
                for (int c2 = 0; c2 < 2; ++c2) { const bf16x8 bb = *(const LAS bf16x8*)(VNt + (16 * (cbw + c2) + fr) * PT + 32 * ks + 8 * fq); oa[c2] = MFMA16(a, bb, oa[c2]); } }
#pragma unroll
            for (int c2 = 0; c2 < 2; ++c2)
#pragma unroll
                for (int r = 0; r < 4; ++r) gO[(size_t)(n * 64 + 16 * rb + 4 * fq + r) * 2048 + 16 * (cbw + c2) + fr] = oa[c2][r];
        }
        {
#pragma unroll
            for (int cb = 0; cb < 4; ++cb) { if (DN) Sacc[cb] *= dlC; else Sacc[cb] *= dlV; }
#pragma unroll
            for (int ks = 0; ks < 2; ++ks) { const bf16x8 a = *(const LAS bf16x8*)(KDTl + (16 * wave + fr) * PT + 32 * ks + 8 * fq);
#pragma unroll
                for (int cb = 0; cb < 4; ++cb) { const bf16x8 bb = *(const LAS bf16x8*)(VNt + (16 * cb + fr) * PT + 32 * ks + 8 * fq); Sacc[cb] = MFMA16(a, bb, Sacc[cb]); } }
#pragma unroll
            for (int cb = 0; cb < 4; ++cb) { v2u w; w.x = pk2(Sacc[cb][0], Sacc[cb][1]); w.y = pk2(Sacc[cb][2], Sacc[cb][3]); *(LAS v2u*)(Sn + (16 * cb + fr) * PQ + 16 * wave + 4 * fq) = w; }
        }
        __syncthreads();
        if (n + 1 < 32) { SCAN_STORE(); dlC = sdl; dlV = sDL;
#pragma unroll
            for (int c2 = 0; c2 < 2; ++c2)
#pragma unroll
                for (int r = 0; r < 4; ++r) uC[c2][r] = DN ? uN[c2][r] : 0.f; }
        __syncthreads();
    }
#undef SCAN_LOAD
#undef SCAN_STORE
}

#ifndef CHUNK_DN
#define CHUNK_DN 1
#endif
#ifndef CHUNK_GLA
#define CHUNK_GLA 1
#endif
__device__ __forceinline__ void p2_prep(Frame& F) {
    const int gw = F.vcu * NWAVES + F.wave, NGW = F.G * NWAVES, lane = F.lane;
    const bf16* PROJ = (const bf16*)(F.ws + WS_PROJ); const float* PS = (const float*)(F.ws + WS_PSMALL);
    float* QF = (float*)(F.ws + WS_QF); float* KF = (float*)(F.ws + WS_KF); float* VF = (float*)(F.ws + WS_VF);
    float* EK = (float*)(F.ws + WS_EK); float* BETA = (float*)(F.ws + WS_BETA); float* GD = (float*)(F.ws + WS_G);
    const float* cw = F.in[I_DN_CONV];
#if !CHUNK_DN
    for (int id = gw; id < M * DN_H; id += NGW) {
        const int tg = id >> 4, h = id & 15, t = tg & (SEQ - 1), d0 = 2 * lane;
        float res[3][2];
#pragma unroll
        for (int p = 0; p < 3; ++p) { const int col = p * 2048 + h * 128 + d0; float y0 = 0.f, y1 = 0.f;
#pragma unroll
            for (int i = 0; i < 4; ++i) { const int tt = t - 3 + i; if (tt >= 0) { const unsigned xw = *(const GAS unsigned*)(PROJ + (size_t)(tg - 3 + i) * PN + PC_QKV + col);
                    const f32x2 w = *(const GAS f32x2*)(cw + (size_t)i * DN_QKV + col); y0 += w.x * bflo(xw); y1 += w.y * bfhi(xw); } }
            res[p][0] = silu_f(y0); res[p][1] = silu_f(y1); }
        const float sq = wave_sum(res[0][0] * res[0][0] + res[0][1] * res[0][1]), sk = wave_sum(res[1][0] * res[1][0] + res[1][1] * res[1][1]);
        const float iq = (1.0f / sqrtf(sq + EPS)) * 0.08838834764831845f, ik = 1.0f / sqrtf(sk + EPS);
        const size_t o = (size_t)tg * DN_KEY + h * 128 + d0;
        *(GAS f32x2*)(QF + o) = (f32x2){res[0][0] * iq, res[0][1] * iq}; *(GAS f32x2*)(KF + o) = (f32x2){res[1][0] * ik, res[1][1] * ik}; *(GAS f32x2*)(VF + o) = (f32x2){res[2][0], res[2][1]};
        if (lane == 0) { BETA[id] = sigmoid_f(PS[(size_t)tg * PSM + h]); GD[id] = -expf(F.in[I_DN_ALOG][h]) * softplus_f(PS[(size_t)tg * PSM + 16 + h] + F.in[I_DN_DTB][h]); }
    }
#else
    for (int ch = F.vcu; ch < BATCH * 32 * DN_H; ch += F.G) dn_prep_chunk(F, ch);
#endif
#if !CHUNK_GLA
    const float* wa2 = F.in[I_GL_WA2]; const float* ba = F.in[I_GL_BA];
    for (int id = gw; id < M * GL_H; id += NGW) {
        const int tg = id >> 3, h = id & 7, c = h * 128 + 2 * lane;
        f32x2 x = *(const GAS f32x2*)(ba + c);
#pragma unroll
        for (int r = 0; r < GL_RANK; ++r) { const float lr = PS[(size_t)tg * PSM + 32 + r]; const f32x2 w = *(const GAS f32x2*)(wa2 + (size_t)r * GL_KEY + c); x.x += lr * w.x; x.y += lr * w.y; }
        *(GAS f32x2*)(EK + (size_t)tg * GL_KEY + c) = (f32x2){expf(logsigmoid_f(x.x) * (1.f / 16.f)), expf(logsigmoid_f(x.y) * (1.f / 16.f))};
    }
#else
    for (int ch = F.vcu; ch < BATCH * 32 * GL_H; ch += F.G) gla_prep_chunk(F, ch);
#endif
}

__device__ __forceinline__ void p3_scan_naive(Frame& F, const int wg) {
    LAS float* sh = (LAS float*)(F.lds + RING_OFF);
    const int tid = F.tid;
    if (wg < 32) {
        const int sub = tid >> 8, tt = tid & 255, e = tt >> 1, half = tt & 1, bh = wg * 2 + sub, b = bh >> 4, h = bh & 15;
        const float* QF = (const float*)(F.ws + WS_QF); const float* KF = (const float*)(F.ws + WS_KF); const float* VF = (const float*)(F.ws + WS_VF);
        const float* BETA = (const float*)(F.ws + WS_BETA); const float* GD = (const float*)(F.ws + WS_G); float* ODN = (float*)(F.ws + WS_ODN);
        float S[64];
#pragma unroll
        for (int d = 0; d < 64; ++d) S[d] = 0.f;
        const float* KQ = (tt < 128) ? KF : QF;
        size_t o = (size_t)(b * SEQ) * DN_KEY + h * 128; int gi = (b * SEQ) * DN_H + h;
        float kqr = KQ[o + (tt & 127)], vr = VF[o + e], be = BETA[gi], gg = GD[gi];
        for (int t = 0; t < SEQ; ++t) {
            LAS float* kq = sh + ((t & 1) * 2 + sub) * 256;
            kq[tt] = kqr; const float v = vr, beta = be, decay = expf(gg); const size_t oc = o;
            if (t + 1 < SEQ) { o += DN_KEY; gi += DN_H; kqr = KQ[o + (tt & 127)]; vr = VF[o + e]; be = BETA[gi]; gg = GD[gi]; }
            __syncthreads();
            const LAS float* kp = kq + 64 * half; const LAS float* qp = kq + 128 + 64 * half;
            float ks0 = 0.f, ks1 = 0.f, ks2 = 0.f, ks3 = 0.f;
#pragma unroll
            for (int d = 0; d < 64; d += 4) { const f32x4 k4 = *(const LAS f32x4*)(kp + d); ks0 += k4.x * S[d]; ks1 += k4.y * S[d + 1]; ks2 += k4.z * S[d + 2]; ks3 += k4.w * S[d + 3]; }
            float ks = (ks0 + ks1) + (ks2 + ks3); ks += __shfl_xor(ks, 1);
            const float delta = beta * (v - decay * ks);
            float o0 = 0.f, o1 = 0.f, o2 = 0.f, o3 = 0.f;
#pragma unroll
            for (int d = 0; d < 64; d += 4) { const f32x4 k4 = *(const LAS f32x4*)(kp + d); const f32x4 q4 = *(const LAS f32x4*)(qp + d);
                S[d] = k4.x * delta + decay * S[d]; S[d + 1] = k4.y * delta + decay * S[d + 1]; S[d + 2] = k4.z * delta + decay * S[d + 2]; S[d + 3] = k4.w * delta + decay * S[d + 3];
                o0 += q4.x * S[d]; o1 += q4.y * S[d + 1]; o2 += q4.z * S[d + 2]; o3 += q4.w * S[d + 3]; }
            float ov = (o0 + o1) + (o2 + o3); ov += __shfl_xor(ov, 1);
            if (half == 0) ODN[oc + e] = ov;
        }
    } else if (wg < 64) {
        const int e = tid >> 1, half = tid & 1, bh = wg - 32, b = bh >> 3, h = bh & 7;
        const bf16* PROJ = (const bf16*)(F.ws + WS_PROJ); const float* EK = (const float*)(F.ws + WS_EK); float* OGLA = (float*)(F.ws + WS_OGLA);
        float S[64];
#pragma unroll
        for (int d = 0; d < 64; ++d) S[d] = 0.f;
        const int ee = tid & 127, role = tid >> 7;
        size_t tg = (size_t)b * SEQ;
        float a0 = (role == 0) ? EK[tg * GL_KEY + h * 128 + ee] : (role == 1) ? bf1(PROJ[tg * PN + PC_GK + h * 128 + ee]) : bf1(PROJ[tg * PN + PC_GQ + h * 128 + ee]) * 0.08838834764831845f;
        float vr = bf1(PROJ[tg * PN + PC_GV + h * 256 + e]);
        for (int t = 0; t < SEQ; ++t) {
            LAS float* buf = sh + (t & 1) * 384;
            if (role < 3) buf[tid] = a0;
            const float v = vr; const size_t tc = tg;
            if (t + 1 < SEQ) { ++tg; a0 = (role == 0) ? EK[tg * GL_KEY + h * 128 + ee] : (role == 1) ? bf1(PROJ[tg * PN + PC_GK + h * 128 + ee]) : bf1(PROJ[tg * PN + PC_GQ + h * 128 + ee]) * 0.08838834764831845f;
                vr = bf1(PROJ[tg * PN + PC_GV + h * 256 + e]); }
            __syncthreads();
            const LAS float* gp = buf + 64 * half;
            float o0 = 0.f, o1 = 0.f, o2 = 0.f, o3 = 0.f;
#pragma unroll
            for (int d = 0; d < 64; d += 4) { const f32x4 g4 = *(const LAS f32x4*)(gp + d); const f32x4 k4 = *(const LAS f32x4*)(gp + 128 + d); const f32x4 q4 = *(const LAS f32x4*)(gp + 256 + d);
                S[d] = g4.x * S[d] + k4.x * v; S[d + 1] = g4.y * S[d + 1] + k4.y * v; S[d + 2] = g4.z * S[d + 2] + k4.z * v; S[d + 3] = g4.w * S[d + 3] + k4.w * v;
                o0 += q4.x * S[d]; o1 += q4.y * S[d + 1]; o2 += q4.z * S[d + 2]; o3 += q4.w * S[d + 3]; }
            float ov = (o0 + o1) + (o2 + o3); ov += __shfl_xor(ov, 1);
            if (half == 0) OGLA[tc * GL_VAL + h * 256 + e] = ov;
        }
    }
}

__device__ __forceinline__ void p4_gated_norm(Frame& F) {
    const int gw = F.vcu * NWAVES + F.wave, NGW = F.G * NWAVES, lane = F.lane;
    const bf16* PROJ = (const bf16*)(F.ws + WS_PROJ); const float* ODN = (const float*)(F.ws + WS_ODN); const float* OGLA = (const float*)(F.ws + WS_OGLA);
    bf16* ONDN = (bf16*)(F.ws + WS_ONDN); bf16* ONGLA = (bf16*)(F.ws + WS_ONGLA);
    for (int id = gw; id < M * DN_H; id += NGW) {
        const int tg = id >> 4, h = id & 15, d0 = 2 * lane; const size_t o = (size_t)tg * DN_VAL + h * 128 + d0;
        const f32x2 v = *(const GAS f32x2*)(ODN + o); const float rstd = 1.0f / sqrtf(wave_sum(v.x * v.x + v.y * v.y) * (1.f / 128.f) + EPS);
        const f32x2 w = *(const GAS f32x2*)(F.in[I_DN_NORM] + d0); const unsigned z = *(const GAS unsigned*)(PROJ + (size_t)tg * PN + PC_Z + h * 128 + d0);
        *(GAS unsigned*)(ONDN + o) = pk2(v.x * rstd * w.x * silu_f(bflo(z)), v.y * rstd * w.y * silu_f(bfhi(z)));
    }
    for (int id = gw; id < M * GL_H; id += NGW) {
        const int tg = id >> 3, h = id & 7, d0 = 4 * lane; const size_t o = (size_t)tg * GL_VAL + h * 256 + d0;
        const f32x4 v = *(const GAS f32x4*)(OGLA + o); const float rstd = 1.0f / sqrtf(wave_sum((v.x * v.x + v.y * v.y) + (v.z * v.z + v.w * v.w)) * (1.f / 256.f) + EPS);
        const f32x4 w = *(const GAS f32x4*)(F.in[I_GL_NORM] + d0); const v2u r = *(const GAS v2u*)(PROJ + (size_t)tg * PN + PC_GR + h * 256 + d0);
        v2u ob; ob.x = pk2(v.x * rstd * w.x * silu_f(bflo(r.x)), v.y * rstd * w.y * silu_f(bfhi(r.x))); ob.y = pk2(v.z * rstd * w.z * silu_f(bflo(r.y)), v.w * rstd * w.w * silu_f(bfhi(r.y)));
        *(GAS v2u*)(ONGLA + o) = ob;
    }
}

__device__ __forceinline__ void p9_convglu(Frame& F) {
    const bf16* GU = (const bf16*)(F.ws + WS_GU); bf16* HID = (bf16*)(F.ws + WS_HID);
    const float* cw = F.in[I_FFN_CW]; const float* cb = F.in[I_FFN_CB];
    const size_t gt = (size_t)F.vcu * (NWAVES * 64) + F.tid, NT = (size_t)F.G * NWAVES * 64;
    constexpr int CG = DFF / 8;
    for (size_t id = gt; id < (size_t)M * CG; id += NT) {
        const int tg = (int)(id / CG), cg = (int)(id % CG), c0 = 8 * cg, j = c0 >> 7, i = c0 & 127, t = tg & (SEQ - 1);
        const bf16* gp = GU + (size_t)tg * NGU + 256 * j + i;
        float y[8];
#pragma unroll
        for (int q = 0; q < 8; ++q) y[q] = cb[c0 + q];
#pragma unroll
        for (int k = 0; k < 3; ++k) { const int dt = k - 2; if (t + dt >= 0) { const v4u g = *(const GAS v4u*)(gp + (ptrdiff_t)dt * NGU);
                const f32x4 w0 = *(const GAS f32x4*)(cw + (size_t)k * DFF + c0), w1 = *(const GAS f32x4*)(cw + (size_t)k * DFF + c0 + 4);
                y[0] += w0.x * bflo(g.x); y[1] += w0.y * bfhi(g.x); y[2] += w0.z * bflo(g.y); y[3] += w0.w * bfhi(g.y);
                y[4] += w1.x * bflo(g.z); y[5] += w1.y * bfhi(g.z); y[6] += w1.z * bflo(g.w); y[7] += w1.w * bfhi(g.w); } }
        const v4u up = *(const GAS v4u*)(gp + 128);
        v4u o; o.x = pk2(silu_f(y[0]) * bflo(up.x), silu_f(y[1]) * bfhi(up.x)); o.y = pk2(silu_f(y[2]) * bflo(up.y), silu_f(y[3]) * bfhi(up.y));
        o.z = pk2(silu_f(y[4]) * bflo(up.z), silu_f(y[5]) * bfhi(up.z)); o.w = pk2(silu_f(y[6]) * bflo(up.w), silu_f(y[7]) * bfhi(up.w));
        *(GAS v4u*)(HID + (size_t)tg * DFF + c0) = o;
    }
}

#ifndef MK_ONE_LAUNCH
#define MK_ONE_LAUNCH 0
#endif
constexpr int N_PHASES = 12;
struct Args { const float* in[19]; float* out; unsigned char* ws; int ph_lo, ph_hi; };
__global__ void __launch_bounds__(NWAVES * 64, 2) mk_fwd(Args args) {
    extern __shared__ __attribute__((aligned(16))) unsigned char lds[];
    Frame F;
    F.lds = (LAS unsigned char*)lds;
    F.MISC = (volatile LAS unsigned*)(F.lds + MISC_OFF);
    F.tid = threadIdx.x; F.lane = F.tid & 63; F.wave = __builtin_amdgcn_readfirstlane(F.tid >> 6);
    F.G = gridDim.x; { const int bx = blockIdx.x; F.vcu = (F.G % 8 == 0) ? (bx % 8) * (F.G / 8) + bx / 8 : bx; }
    F.ws = args.ws; F.ctl = (gu32*)(args.ws + WS_CTL); F.out = args.out;
#pragma unroll
    for (int i = 0; i < 19; ++i) F.in[i] = args.in[i];
    for (int u = F.tid; u < (LDS_BYTES - LDSCTL_OFF) / 4; u += NWAVES * 64) ((LAS unsigned*)(F.lds + LDSCTL_OFF))[u] = 0u;
    __syncthreads();
    XcdBarrier bar; bar.bar = (unsigned*)(F.ctl + CW_BAR); bar.x = 0; bar.st = nullptr;
    if (MK_ONE_LAUNCH) bar = xcd_barrier_post((unsigned*)(F.ctl + CW_BAR), F.MISC + 8);
    const int lo = args.ph_lo, hi = args.ph_hi;
#define IN(k) (lo <= (k) && (k) < hi)
#define SEAM(k) do { if (IN(k) && IN((k) + 1)) xcd_barrier(bar); } while (0)
    bf16* H = (bf16*)(F.ws + WS_H); bf16* PROJ = (bf16*)(F.ws + WS_PROJ);

    if (IN(0)) { p0_prologue(F); } SEAM(0);
    if (IN(1)) {
        p1_skinny(F);
        pg8::Gemm g{H, (const bf16*)(F.ws + WS_WIN), M, PN, D}; pg8::StaticOrder S; S.init(M, PN, F.G, (int)blockIdx.x);
        pg8::Epi<pg8::EPI_BF16> E{PROJ, PN, nullptr, 0, nullptr, 0, nullptr, 0};
        pg8::gemm_phase<pg8::Epi<pg8::EPI_BF16>, pg8::StaticOrder, true, true>(F.lds + RING_OFF, g, S, E);
    } SEAM(1);
    if (IN(2)) { p2_prep(F); } SEAM(2);
    if (IN(3)) {
        for (int task = F.vcu; task < 256; task += F.G) {
            if (task < 128) {
#if CHUNK_DN
                scan_task<true>(F, task >> 1, task & 1);
#else
                if (task < 32) p3_scan_naive(F, task);
#endif
            } else {
#if CHUNK_GLA
                scan_task<false>(F, (task - 128) >> 2, (task - 128) & 3);
#else
                if (task < 160) p3_scan_naive(F, task - 96);
#endif
            }
        }
    } SEAM(3);
    if (IN(4)) { p4_gated_norm(F); } SEAM(4);
    if (IN(5)) {
        { pg8::Gemm g{(const bf16*)(F.ws + WS_ONDN), (const bf16*)(F.ws + WS_WBDN), M, D, DN_VAL}; pg8::StaticOrder S; S.init(M, D, F.G, (int)blockIdx.x);
          pg8::Epi<pg8::EPI_BRA> E{nullptr, 0, (float*)(F.ws + WS_TMP), D, nullptr, 0, PROJ + PC_GATE_DN, PN};
          pg8::gemm_phase<pg8::Epi<pg8::EPI_BRA>, pg8::StaticOrder, true, true>(F.lds + RING_OFF, g, S, E); }
        { pg8::Gemm g{(const bf16*)(F.ws + WS_ONGLA), (const bf16*)(F.ws + WS_WBGLA), M, D, GL_VAL}; pg8::StaticOrder S; S.init(M, D, F.G, (int)blockIdx.x);
          pg8::Epi<pg8::EPI_BRB> E{(bf16*)(F.ws + WS_MERGED), D, (float*)(F.ws + WS_TMP), D, nullptr, 0, PROJ + PC_GATE_GLA, PN};
          pg8::gemm_phase<pg8::Epi<pg8::EPI_BRB>, pg8::StaticOrder, true, true>(F.lds + RING_OFF, g, S, E); }
    } SEAM(5);
    if (IN(6)) {
        pg8::Gemm g{(const bf16*)(F.ws + WS_MERGED), (const bf16*)(F.ws + WS_WOUT), M, D, D}; pg8::StaticOrder S; S.init(M, D, F.G, (int)blockIdx.x);
        pg8::Epi<pg8::EPI_RES> E{nullptr, 0, (float*)(F.ws + WS_X1), D, F.in[I_X], D, nullptr, 0};
        pg8::gemm_phase<pg8::Epi<pg8::EPI_RES>, pg8::StaticOrder, true, true>(F.lds + RING_OFF, g, S, E);
    } SEAM(6);
    if (IN(7)) { const int gw = F.vcu * NWAVES + F.wave, NGW = F.G * NWAVES; const float* X1 = (const float*)(F.ws + WS_X1);
        for (int m = gw; m < M; m += NGW) rms_row(X1 + (size_t)m * D, F.in[I_NORM_FFN], H + (size_t)m * D, nullptr, F.lane); } SEAM(7);
    if (IN(8)) {
        pg8::Gemm g{H, (const bf16*)(F.ws + WS_WFIN), M, NGU, D}; pg8::StaticOrder S; S.init(M, NGU, F.G, (int)blockIdx.x);
        pg8::Epi<pg8::EPI_BF16> E{(bf16*)(F.ws + WS_GU), NGU, nullptr, 0, nullptr, 0, nullptr, 0};
        pg8::gemm_phase<pg8::Epi<pg8::EPI_BF16>, pg8::StaticOrder, true, true>(F.lds + RING_OFF, g, S, E);
    } SEAM(8);
    if (IN(9)) { p9_convglu(F); } SEAM(9);
    if (IN(10)) {
        pg8::Gemm g{(const bf16*)(F.ws + WS_HID), (const bf16*)(F.ws + WS_WFOUT), M, D, DFF}; pg8::StaticOrder S; S.init(M, D, F.G, (int)blockIdx.x);
        pg8::Epi<pg8::EPI_RES> E{nullptr, 0, F.out, D, (const float*)(F.ws + WS_X1), D, nullptr, 0};
        pg8::gemm_phase<pg8::Epi<pg8::EPI_RES>, pg8::StaticOrder, true, true>(F.lds + RING_OFF, g, S, E);
    } SEAM(10);
    if (IN(11)) { const int gw = F.vcu * NWAVES + F.wave, NGW = F.G * NWAVES;
        for (int m = gw; m < M; m += NGW) rms_row(F.out + (size_t)m * D, F.in[I_NORM_FIN], nullptr, F.out + (size_t)m * D, F.lane); }
#undef IN
#undef SEAM
}

extern "C" void kernel_launch(void* const* d_in, const int* in_sizes, int n_in, void* d_out, int out_size, void* d_ws, size_t ws_size, hipStream_t stream) {
    static int grid = 0;
    if (grid == 0) {
        if (n_in != 19 || in_sizes[0] != M * D || out_size != M * D || ws_size < WS_END) { fprintf(stderr, "kernel_launch: unexpected shapes: n_in %d in0 %d out %d ws %zu (need %zu)\n", n_in, n_in > 0 ? in_sizes[0] : -1, out_size, ws_size, (size_t)WS_END); grid = -1; return; }
        int dev = 0, cus = 0, per_cu = 0;
        if (hipGetDevice(&dev) != hipSuccess || hipDeviceGetAttribute(&cus, hipDeviceAttributeMultiprocessorCount, dev) != hipSuccess) { grid = -1; return; }
        if (hipFuncSetAttribute((const void*)mk_fwd, hipFuncAttributeMaxDynamicSharedMemorySize, LDS_BYTES) != hipSuccess) { fprintf(stderr, "kernel_launch: hipFuncSetAttribute failed\n"); grid = -1; return; }
        if (hipOccupancyMaxActiveBlocksPerMultiprocessor(&per_cu, (const void*)mk_fwd, NWAVES * 64, LDS_BYTES) != hipSuccess || per_cu < 1) fprintf(stderr, "kernel_launch: occupancy query says %d\n", per_cu);
        (void)hipGetLastError();
        grid = cus;
    }
    if (grid < 0) return;
    if (hipMemsetAsync((char*)d_ws + WS_CTL, 0, CTL_ZERO_BYTES, stream) != hipSuccess) return;
    Args a{};
    for (int i = 0; i < 19; ++i) a.in[i] = (const float*)d_in[i];
    a.out = (float*)d_out; a.ws = (unsigned char*)d_ws;
#if MK_ONE_LAUNCH
    a.ph_lo = 0; a.ph_hi = N_PHASES;
    hipLaunchKernelGGL(mk_fwd, dim3(grid), dim3(NWAVES * 64), LDS_BYTES, stream, a);
#else
    for (int p = 0; p < N_PHASES; ++p) { a.ph_lo = p; a.ph_hi = p + 1; hipLaunchKernelGGL(mk_fwd, dim3(grid), dim3(NWAVES * 64), LDS_BYTES, stream, a); }
#endif
}
```

```cpp
#define MK_ONE_LAUNCH 1
#include <hip/hip_runtime.h>
#include <cstdio>
#include <cstdint>
namespace pg8 {
#define PG8_LAS __attribute__((address_space(3)))
typedef unsigned short bf16_t;
typedef short bf16x8 __attribute__((ext_vector_type(8)));
typedef float f32x4 __attribute__((ext_vector_type(4)));
typedef unsigned u32x4 __attribute__((ext_vector_type(4)));
constexpr int BM = 256, BK = 64, HALF = 128, HTB = HALF * BK * 2  , STAGE_BYTES = 8 * HTB, NXCD = 8, WGM = 8;

__host__ __device__ __forceinline__ int lds_byte(int r, int c) { const int st = (r >> 4) * 2 + (c >> 5), rr = r & 15, cc = c & 31, ob = rr * 64 + cc * 2; return st * 1024 + (ob ^ (((ob >> 9) & 1) << 5)); }
__host__ __device__ __forceinline__ void stage_rc(int b, int& R, int& C) { const int st = b / 1024, sb = b % 1024, swz = sb ^ (((sb >> 9) & 1) << 5); R = (st >> 1) * 16 + swz / 64; C = (st & 1) * 32 + (swz % 64) / 2; }
__host__ __device__ __forceinline__ int perm32(int rho) { const int n = rho >> 4, i = rho & 15; return 8 * (i >> 2) + 4 * n + (i & 3); }

struct Unit { int pm, pn; };
struct Gemm { const bf16_t* A; const bf16_t* Bt; int M, N, K; };

struct StaticOrder {
    int nM, nN, nwg, G, c;
    __host__ __device__ void init(int M, int N, int G_, int c_) { nM = M / BM; nN = N / BM; nwg = nM * nN; G = G_; c = c_; }
    __host__ __device__ bool next(int i, Unit& u) const {
        const long L = (long)i * G + c; if (L >= nwg) return false;
        int wgid = (int)L; { const int q = nwg / NXCD, r = nwg % NXCD, xcd = wgid % NXCD, off = wgid / NXCD; wgid = (xcd < r ? xcd * (q + 1) : r * (q + 1) + (xcd - r) * q) + off; }
        const int nig = WGM * nN, gid = wgid / nig, fm = gid * WGM, gsz = (nM - fm) < WGM ? (nM - fm) : WGM;
        u.pm = fm + ((wgid % nig) % gsz); u.pn = (wgid % nig) / gsz; return true;
    }
    __device__ __forceinline__ void a_ready(const Unit&) const {}
    __device__ __forceinline__ void done(const Unit&) const {}
};

__device__ __forceinline__ unsigned cvt_pk_bf16(float lo, float hi) { unsigned r; asm volatile("v_cvt_pk_bf16_f32 %0, %1, %2" : "=v"(r) : "v"(lo), "v"(hi)); return r; }
__device__ __forceinline__ float bf_lo(unsigned w) { return __uint_as_float(w << 16); }
__device__ __forceinline__ float bf_hi(unsigned w) { return __uint_as_float(w & 0xffff0000u); }
__device__ __forceinline__ float sigm(float x) { return 1.0f / (1.0f + __expf(-x)); }
enum { EPI_BF16 = 0, EPI_BRA = 1, EPI_BRB = 2, EPI_RES = 3 };
template <int MODE> struct Epi {
    static constexpr bool PERM = true, AFTER_DRAIN = false;
    bf16_t* Ob; int ldo; float* Of; int ldf; const float* R; int ldr; const bf16_t* Gt; int ldg;
    __device__ __forceinline__ void operator()(const f32x4 (&acc)[2][2][4][2], const Unit& u, int wr, int wc, int fr, int fq) const {
        const int row0 = u.pm * BM + wr * 64 + fr, col0 = u.pn * BM + wc * 32 + 8 * fq;
#pragma unroll
        for (int ai = 0; ai < 2; ++ai)
#pragma unroll
            for (int m = 0; m < 4; ++m) { const size_t row = (size_t)(row0 + ai * HALF + m * 16);
#pragma unroll
                for (int bj = 0; bj < 2; ++bj) { const int col = col0 + bj * HALF; f32x4 v0 = acc[ai][bj][m][0], v1 = acc[ai][bj][m][1];
                    if (MODE == EPI_BRA || MODE == EPI_BRB) { const u32x4 g = *(const u32x4*)(Gt + row * ldg + col);
                        v0[0] *= sigm(bf_lo(g.x)); v0[1] *= sigm(bf_hi(g.x)); v0[2] *= sigm(bf_lo(g.y)); v0[3] *= sigm(bf_hi(g.y));
                        v1[0] *= sigm(bf_lo(g.z)); v1[1] *= sigm(bf_hi(g.z)); v1[2] *= sigm(bf_lo(g.w)); v1[3] *= sigm(bf_hi(g.w)); }
                    if (MODE == EPI_BRB) { const float* t = Of + row * ldf + col; v0 += *(const f32x4*)t; v1 += *(const f32x4*)(t + 4); }
                    if (MODE == EPI_RES) { const float* t = R + row * ldr + col; v0 += *(const f32x4*)t; v1 += *(const f32x4*)(t + 4); }
                    if (MODE == EPI_BF16 || MODE == EPI_BRB) { u32x4 w; w.x = cvt_pk_bf16(v0[0], v0[1]); w.y = cvt_pk_bf16(v0[2], v0[3]); w.z = cvt_pk_bf16(v1[0], v1[1]); w.w = cvt_pk_bf16(v1[2], v1[3]);
                        *(u32x4*)(Ob + row * ldo + col) = w; }
                    else { float* o = Of + row * ldf + col; *(f32x4*)o = v0; *(f32x4*)(o + 4) = v1; } }
                asm volatile("" ::: "memory"); }
    }
};

template <class Epi, class Sched, bool ALIGN_EPI = false, bool SP2 = false>
__device__ __forceinline__ void gemm_phase(PG8_LAS unsigned char* lds, const Gemm g, const Sched& S, const Epi& E) {
    const int tid = threadIdx.x, wid = __builtin_amdgcn_readfirstlane(tid >> 6), lane = tid & 63, wr = wid >> 2, wc = wid & 3, fr = lane & 15, fq = lane >> 4;
    const int K = g.K, nt = K / BK;
    unsigned voffA[2], voffB[2];
#pragma unroll
    for (int i = 0; i < 2; ++i) { int R, C; stage_rc(tid * 16 + i * 8192, R, C); const int Rb = Epi::PERM ? ((R & ~31) + perm32(R & 31)) : R;
        voffA[i] = (unsigned)(R * K + C) * 2u; voffB[i] = (unsigned)(Rb * K + C) * 2u; }
    const size_t kstep = (size_t)(BK * 2);
    const size_t hstep = (size_t)HALF * K * 2;
    const size_t tstep = 2 * hstep;
    const unsigned ldsw = (unsigned)wid * 1024u;
    const int aoff = lds_byte(wr * 64 + fr, fq * 8), boff = lds_byte(wc * 32 + fr, fq * 8);
#define PG8_SA(b, h) (((b) * 2 + (h)) * HTB)
#define PG8_SB(b, h) ((4 + (b) * 2 + (h)) * HTB)
#define PG8_STAGE(bufoff, gbase, voff) do { _Pragma("unroll") for (int _i = 0; _i < 2; ++_i) \
        __builtin_amdgcn_global_load_lds((const unsigned*)((const char*)(gbase) + (voff)[_i]), (PG8_LAS unsigned*)(lds + (bufoff) + ldsw + _i * 8192), 16, 0, 0); } while (0)
#define PG8_LDA(dst, b, h) do { _Pragma("unroll") for (int m = 0; m < 4; ++m) _Pragma("unroll") for (int k = 0; k < 2; ++k) dst[m][k] = *(const PG8_LAS bf16x8*)(lds + PG8_SA(b, h) + aoff + m * 2048 + k * 1024); } while (0)
#define PG8_LDB(dst, b, h) do { _Pragma("unroll") for (int n = 0; n < 2; ++n) _Pragma("unroll") for (int k = 0; k < 2; ++k) dst[n][k] = *(const PG8_LAS bf16x8*)(lds + PG8_SB(b, h) + boff + n * 2048 + k * 1024); } while (0)
#define PG8_MMA(ai, bj, At, Bt) do { __builtin_amdgcn_s_setprio(1); _Pragma("unroll") for (int m = 0; m < 4; ++m) _Pragma("unroll") for (int n = 0; n < 2; ++n) _Pragma("unroll") for (int k = 0; k < 2; ++k) \
        acc[ai][bj][m][n] = __builtin_amdgcn_mfma_f32_16x16x32_bf16(Bt[n][k], At[m][k], acc[ai][bj][m][n], 0, 0, 0); __builtin_amdgcn_s_setprio(0); } while (0)
#define PG8_WAIT_V(n) asm volatile("s_waitcnt vmcnt(" #n ")" ::: "memory")
#define PG8_WAIT_L(n) asm volatile("s_waitcnt lgkmcnt(" #n ")" ::: "memory")
#define PG8_BAR __builtin_amdgcn_s_barrier()
#define PG8_SCHED __builtin_amdgcn_sched_barrier(0)
    Unit cur, nxt; int ui = 0;
    if (!S.next(0, cur)) return;
    f32x4 acc[2][2][4][2];
#pragma unroll
    for (int a = 0; a < 2; ++a)
#pragma unroll
        for (int b = 0; b < 2; ++b)
#pragma unroll
            for (int m = 0; m < 4; ++m)
#pragma unroll
                for (int n = 0; n < 2; ++n) acc[a][b][m][n] = (f32x4){0.f, 0.f, 0.f, 0.f};
    bf16x8 At[4][2], B0[2][2], B1[2][2];
    const char* cA = (const char*)g.A + (size_t)cur.pm * tstep; const char* cB = (const char*)g.Bt + (size_t)cur.pn * tstep;
    S.a_ready(cur);
    if constexpr (SP2) {
        PG8_STAGE(PG8_SB(0, 0), cB, voffB); PG8_STAGE(PG8_SB(0, 1), cB + hstep, voffB); PG8_STAGE(PG8_SA(0, 0), cA, voffA); PG8_STAGE(PG8_SA(0, 1), cA + hstep, voffA);
        if (wr == 1) PG8_BAR;
        PG8_WAIT_V(2); PG8_BAR;
        PG8_STAGE(PG8_SB(1, 0), cB + kstep, voffB); PG8_STAGE(PG8_SA(1, 0), cA + kstep, voffA); PG8_STAGE(PG8_SB(1, 1), cB + hstep + kstep, voffB);
        PG8_WAIT_V(6); PG8_BAR;
    } else {
        PG8_STAGE(PG8_SB(0, 0), cB, voffB); PG8_STAGE(PG8_SA(0, 0), cA, voffA); PG8_STAGE(PG8_SB(0, 1), cB + hstep, voffB); PG8_STAGE(PG8_SA(0, 1), cA + hstep, voffA);
        if (wr == 1) PG8_BAR;
        PG8_WAIT_V(4); PG8_BAR;
        PG8_STAGE(PG8_SB(1, 0), cB + kstep, voffB); PG8_STAGE(PG8_SA(1, 0), cA + kstep, voffA); PG8_STAGE(PG8_SB(1, 1), cB + hstep + kstep, voffB);
        PG8_WAIT_V(6); PG8_BAR;
    }
    for (;;) {
        const bool has_next = S.next(ui + 1, nxt);
        const char* nA = has_next ? (const char*)g.A + (size_t)nxt.pm * tstep : cA; const char* nB = has_next ? (const char*)g.Bt + (size_t)nxt.pn * tstep : cB;
        for (int t = 0; t < nt; t += 2) {
            const bool last = (t == nt - 2);
            const char* a1 = cA + (size_t)(t + 1) * kstep;
            const char* a2 = last ? nA : cA + (size_t)(t + 2) * kstep; const char* b2 = last ? nB : cB + (size_t)(t + 2) * kstep;
            const char* a3 = a2 + kstep; const char* b3 = b2 + kstep;
            if (last && has_next) S.a_ready(nxt);
            if constexpr (SP2) {
            PG8_LDB(B0, 0, 0); PG8_LDB(B1, 0, 1); PG8_SCHED; PG8_LDA(At, 0, 0); PG8_STAGE(PG8_SA(1, 1), a1 + hstep, voffA);
            PG8_WAIT_V(8); PG8_WAIT_L(0); PG8_BAR; PG8_MMA(0, 0, At, B0); PG8_MMA(0, 1, At, B1); PG8_BAR; PG8_SCHED;
            PG8_LDA(At, 0, 1); PG8_STAGE(PG8_SB(0, 0), b2, voffB); PG8_STAGE(PG8_SB(0, 1), b2 + hstep, voffB); PG8_STAGE(PG8_SA(0, 0), a2, voffA);
            PG8_WAIT_V(8); PG8_WAIT_L(0); PG8_BAR; PG8_MMA(1, 0, At, B0); PG8_MMA(1, 1, At, B1); PG8_BAR; PG8_SCHED;
            PG8_LDB(B0, 1, 0); PG8_LDB(B1, 1, 1); PG8_SCHED; PG8_LDA(At, 1, 0); PG8_STAGE(PG8_SA(0, 1), a2 + hstep, voffA);
            PG8_WAIT_V(8); PG8_WAIT_L(0); PG8_BAR; PG8_MMA(0, 0, At, B0); PG8_MMA(0, 1, At, B1); PG8_BAR; PG8_SCHED;
            PG8_LDA(At, 1, 1); PG8_STAGE(PG8_SB(1, 0), b3, voffB); PG8_STAGE(PG8_SB(1, 1), b3 + hstep, voffB); PG8_STAGE(PG8_SA(1, 0), a3, voffA);
            PG8_WAIT_V(8); PG8_WAIT_L(0); PG8_BAR; PG8_MMA(1, 0, At, B0); PG8_MMA(1, 1, At, B1); PG8_BAR; PG8_SCHED;
            } else {
            PG8_LDB(B0, 0, 0); PG8_SCHED; PG8_LDA(At, 0, 0); PG8_STAGE(PG8_SA(1, 1), a1 + hstep, voffA);
            PG8_WAIT_L(8); PG8_BAR; PG8_WAIT_L(0); PG8_MMA(0, 0, At, B0); PG8_BAR; PG8_SCHED;
            PG8_LDB(B1, 0, 1); PG8_STAGE(PG8_SB(0, 0), b2, voffB);
            PG8_BAR; PG8_WAIT_L(0); PG8_MMA(0, 1, At, B1); PG8_BAR;
            PG8_LDA(At, 0, 1); PG8_STAGE(PG8_SA(0, 0), a2, voffA);
            PG8_BAR; PG8_WAIT_L(0); PG8_MMA(1, 0, At, B0); PG8_BAR; PG8_SCHED;
            PG8_STAGE(PG8_SB(0, 1), b2 + hstep, voffB);
            PG8_WAIT_V(6); PG8_BAR; PG8_MMA(1, 1, At, B1); PG8_BAR;
            PG8_LDB(B0, 1, 0); PG8_SCHED; PG8_LDA(At, 1, 0); PG8_STAGE(PG8_SA(0, 1), a2 + hstep, voffA);
            PG8_WAIT_L(8); PG8_BAR; PG8_WAIT_L(0); PG8_MMA(0, 0, At, B0); PG8_BAR; PG8_SCHED;
            PG8_LDB(B1, 1, 1); PG8_STAGE(PG8_SB(1, 0), b3, voffB);
            PG8_BAR; PG8_WAIT_L(0); PG8_MMA(0, 1, At, B1); PG8_BAR;
            PG8_LDA(At, 1, 1); PG8_STAGE(PG8_SA(1, 0), a3, voffA);
            PG8_BAR; PG8_WAIT_L(0); PG8_MMA(1, 0, At, B0); PG8_BAR; PG8_SCHED;
            PG8_STAGE(PG8_SB(1, 1), b3 + hstep, voffB);
            PG8_WAIT_V(6); PG8_BAR; PG8_MMA(1, 1, At, B1); PG8_BAR;
            }
        }
        if constexpr (ALIGN_EPI) { if (wr == 0) PG8_BAR; }
        if constexpr (!Epi::AFTER_DRAIN) { E(acc, cur, wr, wc, fr, fq); S.done(cur); }
        if (!has_next) break;
#pragma unroll
        for (int a = 0; a < 2; ++a)
#pragma unroll
            for (int b = 0; b < 2; ++b)
#pragma unroll
                for (int m = 0; m < 4; ++m)
#pragma unroll
                    for (int n = 0; n < 2; ++n) acc[a][b][m][n] = (f32x4){0.f, 0.f, 0.f, 0.f};
        cur = nxt; cA = nA; cB = nB; ++ui;
        if constexpr (ALIGN_EPI) { if (wr == 1) PG8_BAR; }
    }
    PG8_WAIT_V(0);
    if constexpr (!ALIGN_EPI) { if (wr == 0) PG8_BAR; }
    PG8_BAR;
    if constexpr (Epi::AFTER_DRAIN) { E.fused(acc, cur, wr, wc, fr, fq, lds, wid, lane); S.done(cur); }
#undef PG8_SA
#undef PG8_SB
#undef PG8_STAGE
#undef PG8_LDA
#undef PG8_LDB
#undef PG8_MMA
#undef PG8_WAIT_V
#undef PG8_WAIT_L
#undef PG8_BAR
#undef PG8_SCHED
}
}

constexpr int NWAVES = 8;
constexpr int BATCH = 4, SEQ = 2048, D = 4096, M = BATCH * SEQ;
constexpr int DN_H = 16, DN_DK = 128, DN_DV = 128, DN_KEY = 2048, DN_VAL = 2048, DN_QKV = 6144;
constexpr int GL_H = 8, GL_DK = 128, GL_DV = 256, GL_KEY = 1024, GL_VAL = 2048, GL_RANK = 16;
constexpr int DFF = 11008, IN_COLS = 22576;
constexpr float EPS = 1e-6f;
constexpr int PN = 22528;
constexpr int PC_QKV = 0, PC_Z = 6144, PC_GQ = 8192, PC_GK = 9216, PC_GV = 10240, PC_GR = 12288, PC_GATE_DN = 14336, PC_GATE_GLA = 18432;
constexpr int PSM = 64;
constexpr int NGU = 2 * DFF;

constexpr size_t MiB = 1u << 20;
constexpr size_t WS_CTL = 0, CTL_ZERO_BYTES = 1 * MiB;
constexpr size_t WS_WIN = 1 * MiB, WS_WSM = 177 * MiB, WS_WBDN = 178 * MiB, WS_WBGLA = 194 * MiB, WS_WOUT = 210 * MiB, WS_WFIN = 242 * MiB, WS_WFOUT = 414 * MiB;
constexpr size_t WS_H = 500 * MiB, WS_PROJ = 564 * MiB, WS_PSMALL = 916 * MiB;
constexpr size_t WS_DW = 918 * MiB, WS_DQE = 950 * MiB, WS_DKT = 982 * MiB, WS_DAT = 1014 * MiB, WS_DU = 1030 * MiB, WS_DDL = 1094 * MiB;
constexpr size_t WS_GQE = 1096 * MiB, WS_GKT = 1112 * MiB, WS_GAT = 1128 * MiB, WS_GVT = 1136 * MiB, WS_GDL = 1168 * MiB;
constexpr size_t WS_EK = 1170 * MiB;
constexpr size_t WS_QF = 918 * MiB, WS_KF = 982 * MiB, WS_VF = 1046 * MiB, WS_BETA = 1094 * MiB, WS_G = WS_BETA + 512 * 1024;
constexpr size_t WS_ODN = 1208 * MiB, WS_OGLA = 1272 * MiB, WS_ONDN = 1336 * MiB, WS_ONGLA = 1368 * MiB, WS_END = 1400 * MiB;
constexpr size_t WS_TMP = 918 * MiB, WS_MERGED = 1046 * MiB, WS_X1 = 1110 * MiB, WS_GU = WS_PROJ, WS_HID = WS_WIN;
static_assert(WS_WIN + (size_t)PN * D * 2 <= WS_WSM && WS_WFIN + (size_t)NGU * D * 2 <= WS_WFOUT && WS_WFOUT + (size_t)D * DFF * 2 <= WS_H, "ws map (weights)");
static_assert(WS_PROJ + (size_t)M * PN * 2 <= WS_PSMALL && WS_GU + (size_t)M * NGU * 2 <= WS_PSMALL && WS_HID + (size_t)M * DFF * 2 <= WS_WSM, "ws map (activations)");
static_assert(WS_X1 + (size_t)M * D * 4 <= WS_ONDN, "ws map (x1)");
constexpr int CW_BAR = 4096;

constexpr int RING_OFF = 0, RING_BYTES = 131072;
constexpr int LDSCTL_OFF = RING_BYTES, MISC_OFF = LDSCTL_OFF + 320;
constexpr int LDS_BYTES = 147456;

#define GAS __attribute__((address_space(1)))
#define LAS __attribute__((address_space(3)))
typedef unsigned short bf16;
typedef unsigned v4u __attribute__((ext_vector_type(4)));
typedef unsigned v2u __attribute__((ext_vector_type(2)));
typedef float f32x4 __attribute__((ext_vector_type(4)));
typedef float f32x2 __attribute__((ext_vector_type(2)));
typedef short bf16x8 __attribute__((ext_vector_type(8)));
typedef GAS unsigned gu32;
#define RLX_AGENT __ATOMIC_RELAXED, __HIP_MEMORY_SCOPE_AGENT
#define LDS_WAIT() asm volatile("s_waitcnt lgkmcnt(0)" ::: "memory")
#define VM_WAIT() asm volatile("s_waitcnt vmcnt(0)" ::: "memory")
__device__ __forceinline__ unsigned f2bf(float f) { unsigned u = __builtin_bit_cast(unsigned, f); return (u + 0x7fffu + ((u >> 16) & 1u)) >> 16; }
__device__ __forceinline__ unsigned pk2(float lo, float hi) { return f2bf(lo) | (f2bf(hi) << 16); }
__device__ __forceinline__ float bflo(unsigned w) { return __uint_as_float(w << 16); }
__device__ __forceinline__ float bfhi(unsigned w) { return __uint_as_float(w & 0xffff0000u); }
__device__ __forceinline__ float bf1(bf16 b) { return __uint_as_float((unsigned)b << 16); }
__device__ __forceinline__ float sigmoid_f(float x) { return 1.0f / (1.0f + expf(-x)); }
__device__ __forceinline__ float silu_f(float x) { return x / (1.0f + expf(-x)); }
__device__ __forceinline__ float softplus_f(float x) { return fmaxf(x, 0.f) + log1pf(expf(-fabsf(x))); }
__device__ __forceinline__ float logsigmoid_f(float x) { return fminf(x, 0.f) - log1pf(expf(-fabsf(x))); }
__device__ __forceinline__ float wave_sum(float v) {
#pragma unroll
    for (int o = 1; o < 64; o <<= 1) v += __shfl_xor(v, o);
    return v;
}

#define XB_TMO      128
#define XB_XCNT(j)  (256  + 64 * (j))
#define XB_XSUB(j)  (1280 + 64 * (j))
#define XB_XGEN(j)  (2304 + 64 * (j))
#define XB_TOP      3328
#define XB_TOPGEN   3392
#define XCD_BAR_WORDS 3456
#define XB_SPIN_CAP (1u << 18)

__device__ __forceinline__ unsigned xb_ld(unsigned* p)              { return __hip_atomic_load(p, __ATOMIC_RELAXED, __HIP_MEMORY_SCOPE_AGENT); }
__device__ __forceinline__ unsigned xb_add(unsigned* p, unsigned v) { return __hip_atomic_fetch_add(p, v, __ATOMIC_RELAXED, __HIP_MEMORY_SCOPE_AGENT); }
__device__ __forceinline__ unsigned xb_xcc_id() { return (unsigned)__builtin_amdgcn_s_getreg((3 << 11) | 20) & 0xFu; }
#define XB_SPIN(cond, bar) do { unsigned _sp = 0; while (cond) { __builtin_amdgcn_s_sleep(1); \
    if ((++_sp & 255u) == 0u) { if (xb_ld(&(bar)[XB_TMO])) break; if (_sp > XB_SPIN_CAP) { atomicAdd(&(bar)[XB_TMO], 1u); break; } } } } while (0)

struct XcdBarrier {
    unsigned* bar; unsigned x;
    volatile LAS unsigned* st;
};

__device__ __forceinline__ XcdBarrier xcd_barrier_post(unsigned* bar, volatile LAS unsigned* st) {
    XcdBarrier b; b.bar = bar; b.x = xb_xcc_id(); b.st = st;
    if (threadIdx.x == 0) (void)xb_add(&bar[XB_XCNT(b.x)], 1u);
    return b;
}
__device__ __forceinline__ void xcd_barrier_complete(unsigned* bar, unsigned x, unsigned& nloc, unsigned& nx) {
    const unsigned G = gridDim.x * gridDim.y * gridDim.z;
    unsigned sum, cnt, mine, sp = 0u;
    for (;;) {
        sum = 0u; cnt = 0u; mine = 0u;
#pragma unroll
        for (unsigned j = 0; j < 16; ++j) { const unsigned c = xb_ld(&bar[XB_XCNT(j)]); sum += c; cnt += (c > 0u) ? 1u : 0u; mine = (j == x) ? c : mine; }
        if (sum == G) break;
        __builtin_amdgcn_s_sleep(1);
        if ((++sp & 255u) == 0u) { if (xb_ld(&bar[XB_TMO])) break; if (sp > XB_SPIN_CAP) { atomicAdd(&bar[XB_TMO], 1u); break; } }
    }
    nloc = mine > 0u ? mine : 1u; nx = cnt > 0u ? cnt : 1u;
}

__device__ __forceinline__ void xcd_barrier(const XcdBarrier& b) {
    asm volatile("s_waitcnt vmcnt(0)" ::: "memory");
    __syncthreads();
    if (threadIdx.x == 0) {
        unsigned* bar = b.bar;
        __builtin_amdgcn_s_waitcnt(0);
        unsigned nloc = b.st[0], nx = b.st[1];
        if (nloc == 0u) { xcd_barrier_complete(bar, b.x, nloc, nx); b.st[0] = nloc; b.st[1] = nx; }
        const unsigned old = xb_add(&bar[XB_XSUB(b.x)], 1u);
        const unsigned gen = old / nloc;
        if (old + 1u == (gen + 1u) * nloc) {
            __builtin_amdgcn_fence(__ATOMIC_RELEASE, "agent");
            asm volatile("s_waitcnt vmcnt(0)" ::: "memory");
            const unsigned og = xb_add(&bar[XB_TOP], 1u);
            const unsigned tg = og / nx;
            if (og + 1u == (tg + 1u) * nx) xb_add(&bar[XB_TOPGEN], 1u);
            else XB_SPIN(xb_ld(&bar[XB_TOPGEN]) == tg, bar);
            __builtin_amdgcn_fence(__ATOMIC_ACQUIRE, "agent");
            xb_add(&bar[XB_XGEN(b.x)], 1u);
            asm volatile("s_waitcnt vmcnt(0)" ::: "memory");
        } else {
            XB_SPIN(xb_ld(&bar[XB_XGEN(b.x)]) == gen, bar);
            __builtin_amdgcn_fence(__ATOMIC_ACQUIRE, "agent");
            asm volatile("s_waitcnt vmcnt(0)" ::: "memory");
        }
    }
    __syncthreads();
}

struct Frame {
    LAS unsigned char* lds;
    volatile LAS unsigned* MISC;
    gu32* ctl;
    int tid, lane, wave;
    int vcu, G;
    unsigned char* ws;
    const float* in[19];
    float* out;
};
enum { I_X = 0, I_NORM_MIX, I_W_IN, I_DN_CONV, I_DN_ALOG, I_DN_DTB, I_DN_NORM, I_GL_WA2, I_GL_BA, I_GL_NORM, I_W_BDN, I_W_BGLA, I_W_OUT, I_NORM_FFN, I_W_FIN, I_FFN_CW, I_FFN_CB, I_W_FOUT, I_NORM_FIN };

__device__ __forceinline__ void transpose_item(const float* W, size_t ldw, int k0, int sn0, bf16* WT, size_t ldk, int dn0, LAS float* scr, int lane) {
#pragma unroll 8
    for (int i = 0; i < 32; ++i) { const int kk = 2 * i + (lane >> 5); scr[kk * 33 + (lane & 31)] = W[(size_t)(k0 + kk) * ldw + sn0 + (lane & 31)]; }
    LDS_WAIT(); asm volatile("" ::: "memory");
    const int c = lane & 7;
#pragma unroll
    for (int j = 0; j < 4; ++j) { const int n = (lane >> 3) + 8 * j; const LAS float* s = scr + (8 * c) * 33 + n;
        v4u o; o.x = pk2(s[0 * 33], s[1 * 33]); o.y = pk2(s[2 * 33], s[3 * 33]); o.z = pk2(s[4 * 33], s[5 * 33]); o.w = pk2(s[6 * 33], s[7 * 33]);
        *(GAS v4u*)(WT + (size_t)(dn0 + n) * ldk + k0 + 8 * c) = o; }
    LDS_WAIT(); asm volatile("" ::: "memory");
}
__device__ __forceinline__ void rms_row(const float* xrow, const float* w, bf16* obf, float* of32, int lane) {
    const GAS f32x4* xr = (const GAS f32x4*)xrow + lane;
    f32x4 v[16]; float s = 0.f;
#pragma unroll
    for (int j = 0; j < 16; ++j) { v[j] = xr[64 * j]; s += (v[j].x * v[j].x + v[j].y * v[j].y) + (v[j].z * v[j].z + v[j].w * v[j].w); }
    const float rstd = 1.0f / sqrtf(wave_sum(s) * (1.f / D) + EPS);
    const GAS f32x4* wr = (const GAS f32x4*)w + lane;
    if (obf) { GAS v2u* o8 = (GAS v2u*)obf + lane;
#pragma unroll
        for (int j = 0; j < 16; ++j) { const f32x4 g = wr[64 * j]; v2u o; o.x = pk2(v[j].x * rstd * g.x, v[j].y * rstd * g.y); o.y = pk2(v[j].z * rstd * g.z, v[j].w * rstd * g.w); o8[64 * j] = o; } }
    else { GAS f32x4* o = (GAS f32x4*)of32 + lane;
#pragma unroll
        for (int j = 0; j < 16; ++j) { const f32x4 g = wr[64 * j]; o[64 * j] = (f32x4){v[j].x * rstd * g.x, v[j].y * rstd * g.y, v[j].z * rstd * g.z, v[j].w * rstd * g.w}; } }
}

__device__ __forceinline__ void p0_prologue(Frame& F) {
    LAS float* scr = (LAS float*)(F.lds + RING_OFF + F.wave * 16384);
    const int gw = F.vcu * NWAVES + F.wave, NGW = F.G * NWAVES;
    bf16* WIN = (bf16*)(F.ws + WS_WIN); bf16* WSM = (bf16*)(F.ws + WS_WSM); bf16* WBDN = (bf16*)(F.ws + WS_WBDN); bf16* WBGLA = (bf16*)(F.ws + WS_WBGLA);
    bf16* WOUT = (bf16*)(F.ws + WS_WOUT); bf16* WFIN = (bf16*)(F.ws + WS_WFIN); bf16* WFOUT = (bf16*)(F.ws + WS_WFOUT);
    constexpr int NB_IN = PN / 32, I_IN = (D / 64) * NB_IN;
    constexpr int I_SM = (D / 64) * 2;
    constexpr int I_BR = (2048 / 64) * (D / 32);
    constexpr int I_OUT = (D / 64) * (D / 32);
    constexpr int NB_FI = NGU / 32, I_FI = (D / 64) * NB_FI;
    constexpr int I_FO = (DFF / 64) * (D / 32);
    constexpr int NITEMS = I_IN + I_SM + 2 * I_BR + I_OUT + I_FI + I_FO;
    for (int it = gw; it < NITEMS; it += NGW) {
        int r = it;
        if (r < I_IN) { const int kb = r / NB_IN, nb = r % NB_IN, n0 = 32 * nb; const int sn0 = n0 + (n0 >= PC_GATE_DN ? 48 : (n0 >= PC_GQ ? 32 : 0));
            transpose_item(F.in[I_W_IN], IN_COLS, 64 * kb, sn0, WIN, D, n0, scr, F.lane); continue; } r -= I_IN;
        if (r < I_SM) { const int kb = r >> 1, nb = r & 1; transpose_item(F.in[I_W_IN], IN_COLS, 64 * kb, nb ? 14368 : 8192, WSM, D, 32 * nb, scr, F.lane); continue; } r -= I_SM;
        if (r < I_BR) { const int kb = r / (D / 32), nb = r % (D / 32); transpose_item(F.in[I_W_BDN], D, 64 * kb, 32 * nb, WBDN, 2048, 32 * nb, scr, F.lane); continue; } r -= I_BR;
        if (r < I_BR) { const int kb = r / (D / 32), nb = r % (D / 32); transpose_item(F.in[I_W_BGLA], D, 64 * kb, 32 * nb, WBGLA, 2048, 32 * nb, scr, F.lane); continue; } r -= I_BR;
        if (r < I_OUT) { const int kb = r / (D / 32), nb = r % (D / 32); transpose_item(F.in[I_W_OUT], D, 64 * kb, 32 * nb, WOUT, D, 32 * nb, scr, F.lane); continue; } r -= I_OUT;
        if (r < I_FI) { const int kb = r / NB_FI, nb = r % NB_FI, n0 = 32 * nb, j = n0 >> 8, i = n0 & 255; const int sn0 = (i < 128) ? (128 * j + i) : (DFF + 128 * j + (i - 128));
            transpose_item(F.in[I_W_FIN], NGU, 64 * kb, sn0, WFIN, D, n0, scr, F.lane); continue; } r -= I_FI;
        { const int kb = r / (D / 32), nb = r % (D / 32); transpose_item(F.in[I_W_FOUT], D, 64 * kb, 32 * nb, WFOUT, DFF, 32 * nb, scr, F.lane); }
    }
    bf16* H = (bf16*)(F.ws + WS_H);
    for (int m = gw; m < M; m += NGW) rms_row(F.in[I_X] + (size_t)m * D, F.in[I_NORM_MIX], H + (size_t)m * D, nullptr, F.lane);
}

__device__ __forceinline__ void p1_skinny(Frame& F) {
    const bf16* H = (const bf16*)(F.ws + WS_H); const bf16* WSM = (const bf16*)(F.ws + WS_WSM); float* PS = (float*)(F.ws + WS_PSMALL);
    const int lane = F.lane, fr = lane & 15, fq = lane >> 4;
    for (int t = (int)blockIdx.x + F.G * F.wave; t < M / 16; t += F.G * NWAVES) {
        const int row0 = 16 * t;
        const bf16* ap = H + (size_t)(row0 + fr) * D + 8 * fq; const bf16* bp = WSM + (size_t)fr * D + 8 * fq;
        f32x4 acc[4] = {{0.f, 0.f, 0.f, 0.f}, {0.f, 0.f, 0.f, 0.f}, {0.f, 0.f, 0.f, 0.f}, {0.f, 0.f, 0.f, 0.f}};
#pragma unroll 4
        for (int kk = 0; kk < D / 32; ++kk) {
            const bf16x8 a = *(const GAS bf16x8*)(ap + kk * 32);
#pragma unroll
            for (int cb = 0; cb < 4; ++cb) { const bf16x8 b = *(const GAS bf16x8*)(bp + (size_t)cb * 16 * D + kk * 32); acc[cb] = __builtin_amdgcn_mfma_f32_16x16x32_bf16(a, b, acc[cb], 0, 0, 0); }
        }
#pragma unroll
        for (int cb = 0; cb < 4; ++cb)
#pragma unroll
            for (int r = 0; r < 4; ++r) PS[(size_t)(row0 + 4 * fq + r) * PSM + cb * 16 + fr] = acc[cb][r];
    }
}


constexpr int PQ = 136, PT = 72;
constexpr float QSCALE = 0.08838834764831845f;
__device__ __forceinline__ float silu_fast(float x) { return x / (1.0f + __expf(-x)); }
__device__ __forceinline__ v4u pack8(const float* y) { v4u o; o.x = pk2(y[0], y[1]); o.y = pk2(y[2], y[3]); o.z = pk2(y[4], y[5]); o.w = pk2(y[6], y[7]); return o; }
#define MFMA16(a, b, c) __builtin_amdgcn_mfma_f32_16x16x32_bf16((a), (b), (c), 0, 0, 0)

__device__ __forceinline__ void dn_conv16(const bf16* P, const float* cw, int tg, int t, int col, float (&y)[16]) {
#pragma unroll
    for (int c = 0; c < 16; ++c) y[c] = 0.f;
#pragma unroll
    for (int i = 0; i < 4; ++i) {
        const bool ok = (t - 3 + i >= 0); const float m = ok ? 1.f : 0.f;
        const bf16* src = P + (size_t)(ok ? tg - 3 + i : tg) * PN + PC_QKV + col;
        const v4u x0 = *(const GAS v4u*)src, x1 = *(const GAS v4u*)(src + 8);
        const float* w = cw + (size_t)i * DN_QKV + col;
        const f32x4 w0 = *(const GAS f32x4*)w * m, w1 = *(const GAS f32x4*)(w + 4) * m, w2 = *(const GAS f32x4*)(w + 8) * m, w3 = *(const GAS f32x4*)(w + 12) * m;
        y[0] += w0.x * bflo(x0.x); y[1] += w0.y * bfhi(x0.x); y[2] += w0.z * bflo(x0.y); y[3] += w0.w * bfhi(x0.y);
        y[4] += w1.x * bflo(x0.z); y[5] += w1.y * bfhi(x0.z); y[6] += w1.z * bflo(x0.w); y[7] += w1.w * bfhi(x0.w);
        y[8] += w2.x * bflo(x1.x); y[9] += w2.y * bfhi(x1.x); y[10] += w2.z * bflo(x1.y); y[11] += w2.w * bfhi(x1.y);
        y[12] += w3.x * bflo(x1.z); y[13] += w3.y * bfhi(x1.z); y[14] += w3.z * bflo(x1.w); y[15] += w3.w * bfhi(x1.w);
    }
#pragma unroll
    for (int c = 0; c < 16; ++c) y[c] = silu_fast(y[c]);
}

constexpr int LP_KN = 0, LP_QN = 17408, LP_KB = 34816, LP_KDT = 52224, LP_RHS = 0, LP_A = 70656, LP_BV = 87040, LP_BETA = 87296;
__device__ __forceinline__ void dn_prep_chunk(Frame& F, int ch) {
    const int tid = F.tid, lane = F.lane, wave = F.wave, fr = lane & 15, fq = lane >> 4;
    const int h = ch & 15, bn = ch >> 4, n = bn & 31, b = bn >> 5, tg0 = b * SEQ + n * 64;
    const size_t id = (size_t)((b * DN_H + h) * 32 + n);
    LAS unsigned char* L = F.lds + RING_OFF;
    LAS bf16* Kn = (LAS bf16*)(L + LP_KN); LAS bf16* Qn = (LAS bf16*)(L + LP_QN); LAS bf16* KB = (LAS bf16*)(L + LP_KB); LAS bf16* KDTl = (LAS bf16*)(L + LP_KDT);
    LAS float* RHS = (LAS float*)(L + LP_RHS); LAS float* Al = (LAS float*)(L + LP_A); LAS float* bv = (LAS float*)(L + LP_BV); LAS float* betav = (LAS float*)(L + LP_BETA);
    const bf16* PROJ = (const bf16*)(F.ws + WS_PROJ); const float* PS = (const float*)(F.ws + WS_PSMALL);
    bf16* DW = (bf16*)(F.ws + WS_DW) + id * 8192; bf16* DQE = (bf16*)(F.ws + WS_DQE) + id * 8192; bf16* DKT = (bf16*)(F.ws + WS_DKT) + id * 8192;
    bf16* DAT = (bf16*)(F.ws + WS_DAT) + id * 4096; float* DU = (float*)(F.ws + WS_DU) + id * 8192; float* DDL = (float*)(F.ws + WS_DDL);
    if (tid < 64) {
        const int tg = tg0 + tid;
        float g = -expf(F.in[I_DN_ALOG][h]) * softplus_f(PS[(size_t)tg * PSM + 16 + h] + F.in[I_DN_DTB][h]);
#pragma unroll
        for (int o = 1; o < 64; o <<= 1) { const float tt = __shfl_up(g, o); if (lane >= o) g += tt; }
        bv[tid] = g; betav[tid] = sigmoid_f(PS[(size_t)tg * PSM + h]);
    }
    const int row = tid >> 3, cg = tid & 7, t = n * 64 + row, tg = tg0 + row, c0 = 16 * cg;
    float q[16], k[16], v[16];
    dn_conv16(PROJ, F.in[I_DN_CONV], tg, t, h * 128 + c0, q); asm volatile("" ::: "memory");
    dn_conv16(PROJ, F.in[I_DN_CONV], tg, t, 2048 + h * 128 + c0, k); asm volatile("" ::: "memory");
    dn_conv16(PROJ, F.in[I_DN_CONV], tg, t, 4096 + h * 128 + c0, v);
    float sq = 0.f, sk = 0.f;
#pragma unroll
    for (int c = 0; c < 16; ++c) { sq += q[c] * q[c]; sk += k[c] * k[c]; }
    sq += __shfl_xor(sq, 1); sq += __shfl_xor(sq, 2); sq += __shfl_xor(sq, 4);
    sk += __shfl_xor(sk, 1); sk += __shfl_xor(sk, 2); sk += __shfl_xor(sk, 4);
    const float iq = QSCALE / sqrtf(sq + EPS), ik = 1.0f / sqrtf(sk + EPS);
#pragma unroll
    for (int c = 0; c < 16; ++c) { q[c] *= iq; k[c] *= ik; }
    __syncthreads();
    const float bt = bv[row], bl = bv[63], beta = betav[row], eb = __expf(bt), ekd = __expf(bl - bt);
    {
        float tmp[16];
        *(LAS v4u*)(Kn + row * PQ + c0) = pack8(k); *(LAS v4u*)(Kn + row * PQ + c0 + 8) = pack8(k + 8);
        *(LAS v4u*)(Qn + row * PQ + c0) = pack8(q); *(LAS v4u*)(Qn + row * PQ + c0 + 8) = pack8(q + 8);
#pragma unroll
        for (int c = 0; c < 16; ++c) tmp[c] = k[c] * beta;
        *(LAS v4u*)(KB + row * PQ + c0) = pack8(tmp); *(LAS v4u*)(KB + row * PQ + c0 + 8) = pack8(tmp + 8);
#pragma unroll
        for (int c = 0; c < 16; ++c) KDTl[(c0 + c) * PT + row] = (bf16)f2bf(k[c] * ekd);
#pragma unroll
        for (int c = 0; c < 16; ++c) tmp[c] = q[c] * eb;
        *(GAS v4u*)(DQE + row * 128 + c0) = pack8(tmp); *(GAS v4u*)(DQE + row * 128 + c0 + 8) = pack8(tmp + 8);
        if (tid == 0) DDL[id] = expf(bl);
    }
    __syncthreads();
    {
        const int rb = wave >> 1;
        f32x4 kk[2] = {{0.f, 0.f, 0.f, 0.f}, {0.f, 0.f, 0.f, 0.f}}, qk[2] = {{0.f, 0.f, 0.f, 0.f}, {0.f, 0.f, 0.f, 0.f}};
#pragma unroll
        for (int ks = 0; ks < 4; ++ks) {
            const bf16x8 a = *(const LAS bf16x8*)(Kn + (16 * rb + fr) * PQ + 32 * ks + 8 * fq);
#pragma unroll
            for (int c2 = 0; c2 < 2; ++c2) { const int cb = (wave & 1) * 2 + c2;
                const bf16x8 b1 = *(const LAS bf16x8*)(KB + (16 * cb + fr) * PQ + 32 * ks + 8 * fq);
                const bf16x8 b2 = *(const LAS bf16x8*)(Qn + (16 * cb + fr) * PQ + 32 * ks + 8 * fq);
                kk[c2] = MFMA16(a, b1, kk[c2]); qk[c2] = MFMA16(a, b2, qk[c2]); }
        }
#pragma unroll
        for (int c2 = 0; c2 < 2; ++c2) { const int cb = (wave & 1) * 2 + c2, i = 16 * cb + fr, j0 = 16 * rb + 4 * fq; const float bi = bv[i];
            f32x4 av; float at[4];
#pragma unroll
            for (int r = 0; r < 4; ++r) { const int j = j0 + r; const float dec = (i >= j) ? __expf(bi - bv[j]) : 0.f; av[r] = (i > j) ? kk[c2][r] * dec : 0.f; at[r] = (i >= j) ? qk[c2][r] * dec : 0.f; }
            *(LAS f32x4*)(Al + i * 64 + j0) = av;
            v2u w; w.x = pk2(at[0], at[1]); w.y = pk2(at[2], at[3]); *(GAS v2u*)(DAT + i * 64 + j0) = w; }
#pragma unroll
        for (int i = 0; i < 2; ++i) { const int id2 = tid + 512 * i, r = id2 >> 3, c = id2 & 7; *(GAS v4u*)(DKT + r * 64 + 8 * c) = *(const LAS v4u*)(KDTl + r * PT + 8 * c); }
    }
    __syncthreads();
    {
#pragma unroll
        for (int c = 0; c < 16; c += 4) {
            *(LAS f32x4*)(RHS + row * 256 + c0 + c) = (f32x4){k[c] * beta * eb, k[c + 1] * beta * eb, k[c + 2] * beta * eb, k[c + 3] * beta * eb};
            *(LAS f32x4*)(RHS + row * 256 + 128 + c0 + c) = (f32x4){v[c] * beta, v[c + 1] * beta, v[c + 2] * beta, v[c + 3] * beta}; }
    }
    __syncthreads();
    if (wave < 4) {
        const int c = 64 * wave + lane;
        float X[64];
#pragma unroll
        for (int i = 0; i < 64; ++i) {
            float x0 = RHS[i * 256 + c], x1 = 0.f, x2 = 0.f, x3 = 0.f;
#pragma unroll
            for (int j4 = 0; j4 < i; j4 += 4) {
                const f32x4 a = *(const LAS f32x4*)(Al + i * 64 + j4);
                x0 -= a.x * X[j4];
                if (j4 + 1 < i) x1 -= a.y * X[j4 + 1];
                if (j4 + 2 < i) x2 -= a.z * X[j4 + 2];
                if (j4 + 3 < i) x3 -= a.w * X[j4 + 3];
            }
            X[i] = (x0 + x1) + (x2 + x3);
            asm volatile("" ::: "memory");
        }
        if (wave < 2) {
#pragma unroll
            for (int i = 0; i < 64; ++i) DW[i * 128 + c] = (bf16)f2bf(-X[i]);
        } else {
#pragma unroll
            for (int i = 0; i < 64; ++i) DU[i * 128 + (c - 128)] = X[i];
        }
    }
    __syncthreads();
}

constexpr int LG_QE = 0, LG_KE = 17408, LG_VT = 34816, LG_LR = 71680, LG_TOT = 75776;
__device__ __forceinline__ void gla_prep_chunk(Frame& F, int ch) {
    const int tid = F.tid, lane = F.lane, wave = F.wave, fr = lane & 15, fq = lane >> 4;
    const int h = ch & 7, bn = ch >> 3, n = bn & 31, b = bn >> 5, tg0 = b * SEQ + n * 64;
    const size_t id = (size_t)((b * GL_H + h) * 32 + n);
    LAS unsigned char* L = F.lds + RING_OFF;
    LAS bf16* QEl = (LAS bf16*)(L + LG_QE); LAS bf16* KEl = (LAS bf16*)(L + LG_KE); LAS bf16* VTl = (LAS bf16*)(L + LG_VT);
    LAS float* lrl = (LAS float*)(L + LG_LR); LAS float* tot = (LAS float*)(L + LG_TOT);
    const bf16* PROJ = (const bf16*)(F.ws + WS_PROJ); const float* PS = (const float*)(F.ws + WS_PSMALL);
    bf16* GQE = (bf16*)(F.ws + WS_GQE) + id * 8192; bf16* GKT = (bf16*)(F.ws + WS_GKT) + id * 8192; bf16* GAT = (bf16*)(F.ws + WS_GAT) + id * 4096;
    bf16* GVT = (bf16*)(F.ws + WS_GVT) + id * 16384; float* GDL = (float*)(F.ws + WS_GDL) + id * 128;
#pragma unroll
    for (int i = 0; i < 2; ++i) { const int e = tid + 512 * i; lrl[e] = PS[(size_t)(tg0 + (e >> 4)) * PSM + 32 + (e & 15)]; }
#pragma unroll
    for (int i = 0; i < 4; ++i) { const int e = tid + 512 * i, r = e >> 5, c = e & 31; const v4u x = *(const GAS v4u*)(PROJ + (size_t)(tg0 + r) * PN + PC_GV + h * 256 + 8 * c);
        LAS bf16* d = VTl + (8 * c) * PT + r;
        d[0 * PT] = (bf16)(x.x & 0xffffu); d[1 * PT] = (bf16)(x.x >> 16); d[2 * PT] = (bf16)(x.y & 0xffffu); d[3 * PT] = (bf16)(x.y >> 16);
        d[4 * PT] = (bf16)(x.z & 0xffffu); d[5 * PT] = (bf16)(x.z >> 16); d[6 * PT] = (bf16)(x.w & 0xffffu); d[7 * PT] = (bf16)(x.w >> 16); }
    const int d = tid & 127, rg = tid >> 7, r0 = 16 * rg, col = h * 128 + d;
    float w2[16];
#pragma unroll
    for (int r = 0; r < 16; ++r) w2[r] = F.in[I_GL_WA2][(size_t)r * GL_KEY + col];
    const float ba = F.in[I_GL_BA][col];
    float qv[16], kv[16];
#pragma unroll
    for (int i = 0; i < 16; ++i) { const size_t o = (size_t)(tg0 + r0 + i) * PN + h * 128 + d; qv[i] = bf1(PROJ[o + PC_GQ]) * QSCALE; kv[i] = bf1(PROJ[o + PC_GK]); }
    __syncthreads();
    float cs[16]; float run = 0.f;
#pragma unroll
    for (int i = 0; i < 16; ++i) { float x = ba;
#pragma unroll
        for (int r = 0; r < 16; r += 4) { const f32x4 l4 = *(const LAS f32x4*)(lrl + (r0 + i) * 16 + r); x += l4.x * w2[r] + l4.y * w2[r + 1] + l4.z * w2[r + 2] + l4.w * w2[r + 3]; }
        run += (fminf(x, 0.f) - __logf(1.0f + __expf(-fabsf(x)))) * (1.f / 16.f); cs[i] = run; }
    tot[rg * 128 + d] = run;
    __syncthreads();
    float off = 0.f, bl = 0.f;
#pragma unroll
    for (int g = 0; g < 4; ++g) { const float tg_ = tot[g * 128 + d]; if (g < rg) off += tg_; bl += tg_; }
    {
        float kd[16];
#pragma unroll
        for (int i = 0; i < 16; ++i) { const float bb = off + cs[i]; QEl[(r0 + i) * PQ + d] = (bf16)f2bf(qv[i] * __expf(bb)); KEl[(r0 + i) * PQ + d] = (bf16)f2bf(kv[i] * __expf(-bb)); kd[i] = kv[i] * __expf(bl - bb); }
        *(GAS v4u*)(GKT + d * 64 + r0) = pack8(kd); *(GAS v4u*)(GKT + d * 64 + r0 + 8) = pack8(kd + 8);
        if (rg == 0) GDL[d] = expf(bl);
    }
    __syncthreads();
    {
        const int rb = wave >> 1;
        f32x4 qk[2] = {{0.f, 0.f, 0.f, 0.f}, {0.f, 0.f, 0.f, 0.f}};
#pragma unroll
        for (int ks = 0; ks < 4; ++ks) {
            const bf16x8 a = *(const LAS bf16x8*)(KEl + (16 * rb + fr) * PQ + 32 * ks + 8 * fq);
#pragma unroll
            for (int c2 = 0; c2 < 2; ++c2) { const int cb = (wave & 1) * 2 + c2; const bf16x8 b2 = *(const LAS bf16x8*)(QEl + (16 * cb + fr) * PQ + 32 * ks + 8 * fq); qk[c2] = MFMA16(a, b2, qk[c2]); }
        }
#pragma unroll
        for (int c2 = 0; c2 < 2; ++c2) { const int cb = (wave & 1) * 2 + c2, i = 16 * cb + fr, j0 = 16 * rb + 4 * fq; float at[4];
#pragma unroll
            for (int r = 0; r < 4; ++r) at[r] = (i >= j0 + r) ? qk[c2][r] : 0.f;
            v2u w; w.x = pk2(at[0], at[1]); w.y = pk2(at[2], at[3]); *(GAS v2u*)(GAT + i * 64 + j0) = w; }
#pragma unroll
        for (int i = 0; i < 2; ++i) { const int e = tid + 512 * i, r = e >> 4, c = e & 15; *(GAS v4u*)(GQE + r * 128 + 8 * c) = *(const LAS v4u*)(QEl + r * PQ + 8 * c); }
#pragma unroll
        for (int i = 0; i < 4; ++i) { const int e = tid + 512 * i, r = e >> 3, c = e & 7; *(GAS v4u*)(GVT + r * 64 + 8 * c) = *(const LAS v4u*)(VTl + r * PT + 8 * c); }
    }
    __syncthreads();
}

constexpr int LS_W = 0, LS_QE = 17408, LS_KDT = 34816, LS_ATT = 53248, LS_VN = 62464, LS_ST0 = 71680, LS_ST1 = 89088, LS_END = 106496;
template <bool DN> __device__ __forceinline__ void scan_task(Frame& F, int bh, int part) {
    constexpr int H = DN ? DN_H : GL_H, DV = DN ? DN_DV : GL_DV;
    const int tid = F.tid, lane = F.lane, wave = F.wave, fr = lane & 15, fq = lane >> 4;
    const int b = bh / H, h = bh % H, dv0 = 64 * part;
    LAS unsigned char* L = F.lds + RING_OFF;
    LAS bf16* Wl = (LAS bf16*)(L + LS_W); LAS bf16* QEl = (LAS bf16*)(L + LS_QE); LAS bf16* KDTl = (LAS bf16*)(L + LS_KDT); LAS bf16* ATTl = (LAS bf16*)(L + LS_ATT);
    LAS bf16* VNt = (LAS bf16*)(L + LS_VN);
    const bf16* gW = (const bf16*)(F.ws + WS_DW) + (size_t)bh * 32 * 8192;
    const bf16* gQE = (const bf16*)(F.ws + (DN ? WS_DQE : WS_GQE)) + (size_t)bh * 32 * 8192;
    const bf16* gKT = (const bf16*)(F.ws + (DN ? WS_DKT : WS_GKT)) + (size_t)bh * 32 * 8192;
    const bf16* gAT = (const bf16*)(F.ws + (DN ? WS_DAT : WS_GAT)) + (size_t)bh * 32 * 4096;
    const float* gU = (const float*)(F.ws + WS_DU) + (size_t)bh * 32 * 8192;
    const bf16* gVT = (const bf16*)(F.ws + WS_GVT) + (size_t)bh * 32 * 16384 + (size_t)dv0 * 64;
    const float* gDL = DN ? (const float*)(F.ws + WS_DDL) + (size_t)bh * 32 : (const float*)(F.ws + WS_GDL) + (size_t)bh * 32 * 128;
    float* gO = (float*)(F.ws + (DN ? WS_ODN : WS_OGLA)) + (size_t)(b * SEQ) * 2048 + h * DV + dv0;
    for (int e = tid; e < 17408 / 4; e += NWAVES * 64) ((LAS unsigned*)(L + LS_ST0))[e] = 0u;
    f32x4 Sacc[4] = {{0.f, 0.f, 0.f, 0.f}, {0.f, 0.f, 0.f, 0.f}, {0.f, 0.f, 0.f, 0.f}, {0.f, 0.f, 0.f, 0.f}};
    const int rw0 = tid >> 4, cw0 = tid & 15;
    const int rk0 = tid >> 3, ck0 = tid & 7;
    const int rb = wave >> 1, cbw = (wave & 1) * 2;
    v4u sW[2], sQ[2], sK[2], sA, sV; f32x4 sDL; float sdl = 0.f; float uN[2][4];
    sW[0] = sW[1] = sQ[0] = sQ[1] = sK[0] = sK[1] = sA = sV = (v4u){0u, 0u, 0u, 0u}; sDL = (f32x4){0.f, 0.f, 0.f, 0.f};
#define SCAN_LOAD(n_) do { const size_t o8 = (size_t)(n_) * 8192, o4 = (size_t)(n_) * 4096; \
        if (DN) { sW[0] = *(const GAS v4u*)(gW + o8 + tid * 8); sW[1] = *(const GAS v4u*)(gW + o8 + 4096 + tid * 8); } \
        sQ[0] = *(const GAS v4u*)(gQE + o8 + tid * 8); sQ[1] = *(const GAS v4u*)(gQE + o8 + 4096 + tid * 8); \
        sK[0] = *(const GAS v4u*)(gKT + o8 + tid * 8); sK[1] = *(const GAS v4u*)(gKT + o8 + 4096 + tid * 8); \
        sA = *(const GAS v4u*)(gAT + o4 + tid * 8); \
        if (DN) { sdl = gDL[(n_)]; _Pragma("unroll") for (int c2 = 0; c2 < 2; ++c2) _Pragma("unroll") for (int r = 0; r < 4; ++r) uN[c2][r] = gU[o8 + (16 * rb + 4 * fq + r) * 128 + dv0 + 16 * (cbw + c2) + fr]; } \
        else { sV = *(const GAS v4u*)(gVT + (size_t)(n_) * 16384 + tid * 8); sDL = *(const GAS f32x4*)(gDL + (n_) * 128 + 16 * wave + 4 * fq); } } while (0)
#define SCAN_STORE() do { \
        if (DN) { *(LAS v4u*)(Wl + rw0 * PQ + 8 * cw0) = sW[0]; *(LAS v4u*)(Wl + (rw0 + 32) * PQ + 8 * cw0) = sW[1]; } \
        *(LAS v4u*)(QEl + rw0 * PQ + 8 * cw0) = sQ[0]; *(LAS v4u*)(QEl + (rw0 + 32) * PQ + 8 * cw0) = sQ[1]; \
        *(LAS v4u*)(KDTl + rk0 * PT + 8 * ck0) = sK[0]; *(LAS v4u*)(KDTl + (rk0 + 64) * PT + 8 * ck0) = sK[1]; \
        *(LAS v4u*)(ATTl + rk0 * PT + 8 * ck0) = sA; \
        if (!DN) *(LAS v4u*)(VNt + rk0 * PT + 8 * ck0) = sV; } while (0)
    SCAN_LOAD(0);
    SCAN_STORE();
    float uC[2][4]; float dlC = sdl; f32x4 dlV = sDL;
#pragma unroll
    for (int c2 = 0; c2 < 2; ++c2)
#pragma unroll
        for (int r = 0; r < 4; ++r) uC[c2][r] = DN ? uN[c2][r] : 0.f;
    __syncthreads();
    for (int n = 0; n < 32; ++n) {
        LAS bf16* Sc = (LAS bf16*)(L + ((n & 1) ? LS_ST1 : LS_ST0)); LAS bf16* Sn = (LAS bf16*)(L + ((n & 1) ? LS_ST0 : LS_ST1));
        if (n + 1 < 32) SCAN_LOAD(n + 1);
        if (DN) {
            f32x4 va[2];
#pragma unroll
            for (int c2 = 0; c2 < 2; ++c2) va[c2] = (f32x4){uC[c2][0], uC[c2][1], uC[c2][2], uC[c2][3]};
#pragma unroll
            for (int ks = 0; ks < 4; ++ks) { const bf16x8 a = *(const LAS bf16x8*)(Wl + (16 * rb + fr) * PQ + 32 * ks + 8 * fq);
#pragma unroll
                for (int c2 = 0; c2 < 2; ++c2) { const bf16x8 bb = *(const LAS bf16x8*)(Sc + (16 * (cbw + c2) + fr) * PQ + 32 * ks + 8 * fq); va[c2] = MFMA16(a, bb, va[c2]); } }
#pragma unroll
            for (int c2 = 0; c2 < 2; ++c2) { v2u w; w.x = pk2(va[c2][0], va[c2][1]); w.y = pk2(va[c2][2], va[c2][3]); *(LAS v2u*)(VNt + (16 * (cbw + c2) + fr) * PT + 16 * rb + 4 * fq) = w; }
            __syncthreads();
        }
        {
            f32x4 oa[2] = {{0.f, 0.f, 0.f, 0.f}, {0.f, 0.f, 0.f, 0.f}};
#pragma unroll
            for (int ks = 0; ks < 4; ++ks) { const bf16x8 a = *(const LAS bf16x8*)(QEl + (16 * rb + fr) * PQ + 32 * ks + 8 * fq);
#pragma unroll
                for (int c2 = 0; c2 < 2; ++c2) { const bf16x8 bb = *(const LAS bf16x8*)(Sc + (16 * (cbw + c2) + fr) * PQ + 32 * ks + 8 * fq); oa[c2] = MFMA16(a, bb, oa[c2]); } }
#pragma unroll
            for (int ks = 0; ks < 2; ++ks) { const bf16x8 a = *(const LAS bf16x8*)(ATTl + (16 * rb + fr) * PT + 32 * ks + 8 * fq);
#pragma unroll
                for (int c2 = 0; c2 < 2; ++c2) { const bf16x8 bb = *(const LAS bf16x8*)(VNt + (16 * (cbw + c2) + fr) * PT + 32 * ks + 8 * fq); oa[c2] = MFMA16(a, bb, oa[c2]); } }
#pragma unroll
            for (int c2 = 0; c2 < 2; ++c2)
#pragma unroll
                for (int r = 0; r < 4; ++r) gO[(size_t)(n * 64 + 16 * rb + 4 * fq + r) * 2048 + 16 * (cbw + c2) + fr] = oa[c2][r];
        }
        {
#pragma unroll
            for (int cb = 0; cb < 4; ++cb) { if (DN) Sacc[cb] *= dlC; else Sacc[cb] *= dlV; }
#pragma unroll
            for (int ks = 0; ks < 2; ++ks) { const bf16x8 a = *(const LAS bf16x8*)(KDTl + (16 * wave + fr) * PT + 32 * ks + 8 * fq);
#pragma unroll
                for (int cb = 0; cb < 4; ++cb) { const bf16x8 bb = *(const LAS bf16x8*)(VNt + (16 * cb + fr) * PT + 32 * ks + 8 * fq); Sacc[cb] = MFMA16(a, bb, Sacc[cb]); } }
#pragma unroll
            for (int cb = 0; cb < 4; ++cb) { v2u w; w.x = pk2(Sacc[cb][0], Sacc[cb][1]); w.y = pk2(Sacc[cb][2], Sacc[cb][3]); *(LAS v2u*)(Sn + (16 * cb + fr) * PQ + 16 * wave + 4 * fq) = w; }
        }
        __syncthreads();
        if (n + 1 < 32) { SCAN_STORE(); dlC = sdl; dlV = sDL;
#pragma unroll
            for (int c2 = 0; c2 < 2; ++c2)
#pragma unroll
                for (int r = 0; r < 4; ++r) uC[c2][r] = DN ? uN[c2][r] : 0.f; }
        __syncthreads();
    }
#undef SCAN_LOAD
#undef SCAN_STORE
}

#ifndef CHUNK_DN
#define CHUNK_DN 1
#endif
#ifndef CHUNK_GLA
#define CHUNK_GLA 1
#endif
__device__ __forceinline__ void p2_prep(Frame& F) {
    const int gw = F.vcu * NWAVES + F.wave, NGW = F.G * NWAVES, lane = F.lane;
    const bf16* PROJ = (const bf16*)(F.ws + WS_PROJ); const float* PS = (const float*)(F.ws + WS_PSMALL);
    float* QF = (float*)(F.ws + WS_QF); float* KF = (float*)(F.ws + WS_KF); float* VF = (float*)(F.ws + WS_VF);
    float* EK = (float*)(F.ws + WS_EK); float* BETA = (float*)(F.ws + WS_BETA); float* GD = (float*)(F.ws + WS_G);
    const float* cw = F.in[I_DN_CONV];
#if !CHUNK_DN
    for (int id = gw; id < M * DN_H; id += NGW) {
        const int tg = id >> 4, h = id & 15, t = tg & (SEQ - 1), d0 = 2 * lane;
        float res[3][2];
#pragma unroll
        for (int p = 0; p < 3; ++p) { const int col = p * 2048 + h * 128 + d0; float y0 = 0.f, y1 = 0.f;
#pragma unroll
            for (int i = 0; i < 4; ++i) { const int tt = t - 3 + i; if (tt >= 0) { const unsigned xw = *(const GAS unsigned*)(PROJ + (size_t)(tg - 3 + i) * PN + PC_QKV + col);
                    const f32x2 w = *(const GAS f32x2*)(cw + (size_t)i * DN_QKV + col); y0 += w.x * bflo(xw); y1 += w.y * bfhi(xw); } }
            res[p][0] = silu_f(y0); res[p][1] = silu_f(y1); }
        const float sq = wave_sum(res[0][0] * res[0][0] + res[0][1] * res[0][1]), sk = wave_sum(res[1][0] * res[1][0] + res[1][1] * res[1][1]);
        const float iq = (1.0f / sqrtf(sq + EPS)) * 0.08838834764831845f, ik = 1.0f / sqrtf(sk + EPS);
        const size_t o = (size_t)tg * DN_KEY + h * 128 + d0;
        *(GAS f32x2*)(QF + o) = (f32x2){res[0][0] * iq, res[0][1] * iq}; *(GAS f32x2*)(KF + o) = (f32x2){res[1][0] * ik, res[1][1] * ik}; *(GAS f32x2*)(VF + o) = (f32x2){res[2][0], res[2][1]};
        if (lane == 0) { BETA[id] = sigmoid_f(PS[(size_t)tg * PSM + h]); GD[id] = -expf(F.in[I_DN_ALOG][h]) * softplus_f(PS[(size_t)tg * PSM + 16 + h] + F.in[I_DN_DTB][h]); }
    }
#else
    for (int ch = F.vcu; ch < BATCH * 32 * DN_H; ch += F.G) dn_prep_chunk(F, ch);
#endif
#if !CHUNK_GLA
    const float* wa2 = F.in[I_GL_WA2]; const float* ba = F.in[I_GL_BA];
    for (int id = gw; id < M * GL_H; id += NGW) {
        const int tg = id >> 3, h = id & 7, c = h * 128 + 2 * lane;
        f32x2 x = *(const GAS f32x2*)(ba + c);
#pragma unroll
        for (int r = 0; r < GL_RANK; ++r) { const float lr = PS[(size_t)tg * PSM + 32 + r]; const f32x2 w = *(const GAS f32x2*)(wa2 + (size_t)r * GL_KEY + c); x.x += lr * w.x; x.y += lr * w.y; }
        *(GAS f32x2*)(EK + (size_t)tg * GL_KEY + c) = (f32x2){expf(logsigmoid_f(x.x) * (1.f / 16.f)), expf(logsigmoid_f(x.y) * (1.f / 16.f))};
    }
#else
    for (int ch = F.vcu; ch < BATCH * 32 * GL_H; ch += F.G) gla_prep_chunk(F, ch);
#endif
}

__device__ __forceinline__ void p3_scan_naive(Frame& F, const int wg) {
    LAS float* sh = (LAS float*)(F.lds + RING_OFF);
    const int tid = F.tid;
    if (wg < 32) {
        const int sub = tid >> 8, tt = tid & 255, e = tt >> 1, half = tt & 1, bh = wg * 2 + sub, b = bh >> 4, h = bh & 15;
        const float* QF = (const float*)(F.ws + WS_QF); const float* KF = (const float*)(F.ws + WS_KF); const float* VF = (const float*)(F.ws + WS_VF);
        const float* BETA = (const float*)(F.ws + WS_BETA); const float* GD = (const float*)(F.ws + WS_G); float* ODN = (float*)(F.ws + WS_ODN);
        float S[64];
#pragma unroll
        for (int d = 0; d < 64; ++d) S[d] = 0.f;
        const float* KQ = (tt < 128) ? KF : QF;
        size_t o = (size_t)(b * SEQ) * DN_KEY + h * 128; int gi = (b * SEQ) * DN_H + h;
        float kqr = KQ[o + (tt & 127)], vr = VF[o + e], be = BETA[gi], gg = GD[gi];
        for (int t = 0; t < SEQ; ++t) {
            LAS float* kq = sh + ((t & 1) * 2 + sub) * 256;
            kq[tt] = kqr; const float v = vr, beta = be, decay = expf(gg); const size_t oc = o;
            if (t + 1 < SEQ) { o += DN_KEY; gi += DN_H; kqr = KQ[o + (tt & 127)]; vr = VF[o + e]; be = BETA[gi]; gg = GD[gi]; }
            __syncthreads();
            const LAS float* kp = kq + 64 * half; const LAS float* qp = kq + 128 + 64 * half;
            float ks0 = 0.f, ks1 = 0.f, ks2 = 0.f, ks3 = 0.f;
#pragma unroll
            for (int d = 0; d < 64; d += 4) { const f32x4 k4 = *(const LAS f32x4*)(kp + d); ks0 += k4.x * S[d]; ks1 += k4.y * S[d + 1]; ks2 += k4.z * S[d + 2]; ks3 += k4.w * S[d + 3]; }
            float ks = (ks0 + ks1) + (ks2 + ks3); ks += __shfl_xor(ks, 1);
            const float delta = beta * (v - decay * ks);
            float o0 = 0.f, o1 = 0.f, o2 = 0.f, o3 = 0.f;
#pragma unroll
            for (int d = 0; d < 64; d += 4) { const f32x4 k4 = *(const LAS f32x4*)(kp + d); const f32x4 q4 = *(const LAS f32x4*)(qp + d);
                S[d] = k4.x * delta + decay * S[d]; S[d + 1] = k4.y * delta + decay * S[d + 1]; S[d + 2] = k4.z * delta + decay * S[d + 2]; S[d + 3] = k4.w * delta + decay * S[d + 3];
                o0 += q4.x * S[d]; o1 += q4.y * S[d + 1]; o2 += q4.z * S[d + 2]; o3 += q4.w * S[d + 3]; }
            float ov = (o0 + o1) + (o2 + o3); ov += __shfl_xor(ov, 1);
            if (half == 0) ODN[oc + e] = ov;
        }
    } else if (wg < 64) {
        const int e = tid >> 1, half = tid & 1, bh = wg - 32, b = bh >> 3, h = bh & 7;
        const bf16* PROJ = (const bf16*)(F.ws + WS_PROJ); const float* EK = (const float*)(F.ws + WS_EK); float* OGLA = (float*)(F.ws + WS_OGLA);
        float S[64];
#pragma unroll
        for (int d = 0; d < 64; ++d) S[d] = 0.f;
        const int ee = tid & 127, role = tid >> 7;
        size_t tg = (size_t)b * SEQ;
        float a0 = (role == 0) ? EK[tg * GL_KEY + h * 128 + ee] : (role == 1) ? bf1(PROJ[tg * PN + PC_GK + h * 128 + ee]) : bf1(PROJ[tg * PN + PC_GQ + h * 128 + ee]) * 0.08838834764831845f;
        float vr = bf1(PROJ[tg * PN + PC_GV + h * 256 + e]);
        for (int t = 0; t < SEQ; ++t) {
            LAS float* buf = sh + (t & 1) * 384;
            if (role < 3) buf[tid] = a0;
            const float v = vr; const size_t tc = tg;
            if (t + 1 < SEQ) { ++tg; a0 = (role == 0) ? EK[tg * GL_KEY + h * 128 + ee] : (role == 1) ? bf1(PROJ[tg * PN + PC_GK + h * 128 + ee]) : bf1(PROJ[tg * PN + PC_GQ + h * 128 + ee]) * 0.08838834764831845f;
                vr = bf1(PROJ[tg * PN + PC_GV + h * 256 + e]); }
            __syncthreads();
            const LAS float* gp = buf + 64 * half;
            float o0 = 0.f, o1 = 0.f, o2 = 0.f, o3 = 0.f;
#pragma unroll
            for (int d = 0; d < 64; d += 4) { const f32x4 g4 = *(const LAS f32x4*)(gp + d); const f32x4 k4 = *(const LAS f32x4*)(gp + 128 + d); const f32x4 q4 = *(const LAS f32x4*)(gp + 256 + d);
                S[d] = g4.x * S[d] + k4.x * v; S[d + 1] = g4.y * S[d + 1] + k4.y * v; S[d + 2] = g4.z * S[d + 2] + k4.z * v; S[d + 3] = g4.w * S[d + 3] + k4.w * v;
                o0 += q4.x * S[d]; o1 += q4.y * S[d + 1]; o2 += q4.z * S[d + 2]; o3 += q4.w * S[d + 3]; }
            float ov = (o0 + o1) + (o2 + o3); ov += __shfl_xor(ov, 1);
            if (half == 0) OGLA[tc * GL_VAL + h * 256 + e] = ov;
        }
    }
}

__device__ __forceinline__ void p4_gated_norm(Frame& F) {
    const int gw = F.vcu * NWAVES + F.wave, NGW = F.G * NWAVES, lane = F.lane;
    const bf16* PROJ = (const bf16*)(F.ws + WS_PROJ); const float* ODN = (const float*)(F.ws + WS_ODN); const float* OGLA = (const float*)(F.ws + WS_OGLA);
    bf16* ONDN = (bf16*)(F.ws + WS_ONDN); bf16* ONGLA = (bf16*)(F.ws + WS_ONGLA);
    const f32x2 wd = *(const GAS f32x2*)(F.in[I_DN_NORM] + 2 * lane); const f32x4 wg = *(const GAS f32x4*)(F.in[I_GL_NORM] + 4 * lane);
    for (int tg = gw; tg < M; tg += NGW) {
        f32x2 v[16]; unsigned z[16]; f32x4 u[8]; v2u r[8];
#pragma unroll
        for (int h = 0; h < 16; ++h) { v[h] = *(const GAS f32x2*)(ODN + (size_t)tg * DN_VAL + h * 128 + 2 * lane); z[h] = *(const GAS unsigned*)(PROJ + (size_t)tg * PN + PC_Z + h * 128 + 2 * lane); }
#pragma unroll
        for (int h = 0; h < 8; ++h) { u[h] = *(const GAS f32x4*)(OGLA + (size_t)tg * GL_VAL + h * 256 + 4 * lane); r[h] = *(const GAS v2u*)(PROJ + (size_t)tg * PN + PC_GR + h * 256 + 4 * lane); }
#pragma unroll
        for (int h = 0; h < 16; ++h) { const float rstd = 1.0f / sqrtf(wave_sum(v[h].x * v[h].x + v[h].y * v[h].y) * (1.f / 128.f) + EPS);
            *(GAS unsigned*)(ONDN + (size_t)tg * DN_VAL + h * 128 + 2 * lane) = pk2(v[h].x * rstd * wd.x * silu_fast(bflo(z[h])), v[h].y * rstd * wd.y * silu_fast(bfhi(z[h]))); }
#pragma unroll
        for (int h = 0; h < 8; ++h) { const float rstd = 1.0f / sqrtf(wave_sum((u[h].x * u[h].x + u[h].y * u[h].y) + (u[h].z * u[h].z + u[h].w * u[h].w)) * (1.f / 256.f) + EPS);
            v2u ob; ob.x = pk2(u[h].x * rstd * wg.x * silu_fast(bflo(r[h].x)), u[h].y * rstd * wg.y * silu_fast(bfhi(r[h].x))); ob.y = pk2(u[h].z * rstd * wg.z * silu_fast(bflo(r[h].y)), u[h].w * rstd * wg.w * silu_fast(bfhi(r[h].y)));
            *(GAS v2u*)(ONGLA + (size_t)tg * GL_VAL + h * 256 + 4 * lane) = ob; }
    }
}

__device__ __forceinline__ void p9_convglu(Frame& F) {
    const bf16* GU = (const bf16*)(F.ws + WS_GU); bf16* HID = (bf16*)(F.ws + WS_HID);
    const float* cw = F.in[I_FFN_CW]; const float* cb = F.in[I_FFN_CB];
    const size_t gt = (size_t)F.vcu * (NWAVES * 64) + F.tid, NT = (size_t)F.G * NWAVES * 64;
    constexpr int CG = DFF / 8;
    for (size_t id = gt; id < (size_t)(M / 4) * CG; id += NT) {
        const int strip = (int)(id / CG), cg = (int)(id % CG), c0 = 8 * cg, j = c0 >> 7, i = c0 & 127, tg0 = 4 * strip;
        const bool head = (tg0 & (SEQ - 1)) == 0;
        const bf16* gp = GU + (size_t)tg0 * NGU + 256 * j + i;
        v4u g[6], up[4];
#pragma unroll
        for (int k = 0; k < 6; ++k) g[k] = *(const GAS v4u*)(gp + (ptrdiff_t)((head && k < 2) ? 0 : k - 2) * NGU);
#pragma unroll
        for (int k = 0; k < 4; ++k) up[k] = *(const GAS v4u*)(gp + (size_t)k * NGU + 128);
        f32x4 w[3][2]; f32x4 bb[2];
#pragma unroll
        for (int k = 0; k < 3; ++k) { w[k][0] = *(const GAS f32x4*)(cw + (size_t)k * DFF + c0); w[k][1] = *(const GAS f32x4*)(cw + (size_t)k * DFF + c0 + 4); }
        bb[0] = *(const GAS f32x4*)(cb + c0); bb[1] = *(const GAS f32x4*)(cb + c0 + 4);
        if (head) { g[0] = (v4u){0u, 0u, 0u, 0u}; g[1] = (v4u){0u, 0u, 0u, 0u}; }
#pragma unroll
        for (int r = 0; r < 4; ++r) {
            float y[8];
#pragma unroll
            for (int q = 0; q < 8; ++q) y[q] = bb[q >> 2][q & 3];
#pragma unroll
            for (int k = 0; k < 3; ++k) { const v4u x = g[r + k];
                y[0] += w[k][0].x * bflo(x.x); y[1] += w[k][0].y * bfhi(x.x); y[2] += w[k][0].z * bflo(x.y); y[3] += w[k][0].w * bfhi(x.y);
                y[4] += w[k][1].x * bflo(x.z); y[5] += w[k][1].y * bfhi(x.z); y[6] += w[k][1].z * bflo(x.w); y[7] += w[k][1].w * bfhi(x.w); }
            const v4u u = up[r];
            v4u o; o.x = pk2(silu_fast(y[0]) * bflo(u.x), silu_fast(y[1]) * bfhi(u.x)); o.y = pk2(silu_fast(y[2]) * bflo(u.y), silu_fast(y[3]) * bfhi(u.y));
            o.z = pk2(silu_fast(y[4]) * bflo(u.z), silu_fast(y[5]) * bfhi(u.z)); o.w = pk2(silu_fast(y[6]) * bflo(u.w), silu_fast(y[7]) * bfhi(u.w));
            *(GAS v4u*)(HID + (size_t)(tg0 + r) * DFF + c0) = o;
        }
    }
}

#ifndef MK_ONE_LAUNCH
#define MK_ONE_LAUNCH 0
#endif
constexpr int N_PHASES = 12;
struct Args { const float* in[19]; float* out; unsigned char* ws; int ph_lo, ph_hi; };
__global__ void __launch_bounds__(NWAVES * 64, 2) mk_fwd(Args args) {
    extern __shared__ __attribute__((aligned(16))) unsigned char lds[];
    Frame F;
    F.lds = (LAS unsigned char*)lds;
    F.MISC = (volatile LAS unsigned*)(F.lds + MISC_OFF);
    F.tid = threadIdx.x; F.lane = F.tid & 63; F.wave = __builtin_amdgcn_readfirstlane(F.tid >> 6);
    F.G = gridDim.x; { const int bx = blockIdx.x; F.vcu = (F.G % 8 == 0) ? (bx % 8) * (F.G / 8) + bx / 8 : bx; }
    F.ws = args.ws; F.ctl = (gu32*)(args.ws + WS_CTL); F.out = args.out;
#pragma unroll
    for (int i = 0; i < 19; ++i) F.in[i] = args.in[i];
    for (int u = F.tid; u < (LDS_BYTES - LDSCTL_OFF) / 4; u += NWAVES * 64) ((LAS unsigned*)(F.lds + LDSCTL_OFF))[u] = 0u;
    __syncthreads();
    XcdBarrier bar; bar.bar = (unsigned*)(F.ctl + CW_BAR); bar.x = 0; bar.st = nullptr;
    if (MK_ONE_LAUNCH) bar = xcd_barrier_post((unsigned*)(F.ctl + CW_BAR), F.MISC + 8);
    const int lo = args.ph_lo, hi = args.ph_hi;
#define IN(k) (lo <= (k) && (k) < hi)
#define SEAM(k) do { if (IN(k) && IN((k) + 1)) xcd_barrier(bar); } while (0)
    bf16* H = (bf16*)(F.ws + WS_H); bf16* PROJ = (bf16*)(F.ws + WS_PROJ);

#ifndef PROBE_MASK
#define PROBE_MASK 0
#endif
#define RUN_PHASE(k, ...) do { if (IN(k)) { __VA_ARGS__ } if ((PROBE_MASK >> (k)) & 1) { if (IN(k)) { __VA_ARGS__ } } } while (0)
    RUN_PHASE(0, p0_prologue(F);); SEAM(0);
    RUN_PHASE(1,
        p1_skinny(F);
        pg8::Gemm g{H, (const bf16*)(F.ws + WS_WIN), M, PN, D}; pg8::StaticOrder S; S.init(M, PN, F.G, (int)blockIdx.x);
        pg8::Epi<pg8::EPI_BF16> E{PROJ, PN, nullptr, 0, nullptr, 0, nullptr, 0};
        pg8::gemm_phase<pg8::Epi<pg8::EPI_BF16>, pg8::StaticOrder, true, true>(F.lds + RING_OFF, g, S, E);
    ); SEAM(1);
    RUN_PHASE(2, p2_prep(F);); SEAM(2);
    RUN_PHASE(3,
        for (int task = F.vcu; task < 256; task += F.G) {
            if (task < 128) {
#if CHUNK_DN
                scan_task<true>(F, task >> 1, task & 1);
#else
                if (task < 32) p3_scan_naive(F, task);
#endif
            } else {
#if CHUNK_GLA
                scan_task<false>(F, (task - 128) >> 2, (task - 128) & 3);
#else
                if (task < 160) p3_scan_naive(F, task - 96);
#endif
            }
        }
    ); SEAM(3);
    RUN_PHASE(4, p4_gated_norm(F);); SEAM(4);
    RUN_PHASE(5,
        { pg8::Gemm g{(const bf16*)(F.ws + WS_ONDN), (const bf16*)(F.ws + WS_WBDN), M, D, DN_VAL}; pg8::StaticOrder S; S.init(M, D, F.G, (int)blockIdx.x);
          pg8::Epi<pg8::EPI_BRA> E{nullptr, 0, (float*)(F.ws + WS_TMP), D, nullptr, 0, PROJ + PC_GATE_DN, PN};
          pg8::gemm_phase<pg8::Epi<pg8::EPI_BRA>, pg8::StaticOrder, true, true>(F.lds + RING_OFF, g, S, E); }
        { pg8::Gemm g{(const bf16*)(F.ws + WS_ONGLA), (const bf16*)(F.ws + WS_WBGLA), M, D, GL_VAL}; pg8::StaticOrder S; S.init(M, D, F.G, (int)blockIdx.x);
          pg8::Epi<pg8::EPI_BRB> E{(bf16*)(F.ws + WS_MERGED), D, (float*)(F.ws + WS_TMP), D, nullptr, 0, PROJ + PC_GATE_GLA, PN};
          pg8::gemm_phase<pg8::Epi<pg8::EPI_BRB>, pg8::StaticOrder, true, true>(F.lds + RING_OFF, g, S, E); }
    ); SEAM(5);
    RUN_PHASE(6,
        pg8::Gemm g{(const bf16*)(F.ws + WS_MERGED), (const bf16*)(F.ws + WS_WOUT), M, D, D}; pg8::StaticOrder S; S.init(M, D, F.G, (int)blockIdx.x);
        pg8::Epi<pg8::EPI_RES> E{nullptr, 0, (float*)(F.ws + WS_X1), D, F.in[I_X], D, nullptr, 0};
        pg8::gemm_phase<pg8::Epi<pg8::EPI_RES>, pg8::StaticOrder, true, true>(F.lds + RING_OFF, g, S, E);
    ); SEAM(6);
    RUN_PHASE(7, { const int gw = F.vcu * NWAVES + F.wave; const int NGW = F.G * NWAVES; const float* X1 = (const float*)(F.ws + WS_X1);
        for (int m = gw; m < M; m += NGW) rms_row(X1 + (size_t)m * D, F.in[I_NORM_FFN], H + (size_t)m * D, nullptr, F.lane); }); SEAM(7);
    RUN_PHASE(8,
        pg8::Gemm g{H, (const bf16*)(F.ws + WS_WFIN), M, NGU, D}; pg8::StaticOrder S; S.init(M, NGU, F.G, (int)blockIdx.x);
        pg8::Epi<pg8::EPI_BF16> E{(bf16*)(F.ws + WS_GU), NGU, nullptr, 0, nullptr, 0, nullptr, 0};
        pg8::gemm_phase<pg8::Epi<pg8::EPI_BF16>, pg8::StaticOrder, true, true>(F.lds + RING_OFF, g, S, E);
    ); SEAM(8);
    RUN_PHASE(9, p9_convglu(F);); SEAM(9);
    RUN_PHASE(10,
        pg8::Gemm g{(const bf16*)(F.ws + WS_HID), (const bf16*)(F.ws + WS_WFOUT), M, D, DFF}; pg8::StaticOrder S; S.init(M, D, F.G, (int)blockIdx.x);
        pg8::Epi<pg8::EPI_RES> E{nullptr, 0, F.out, D, (const float*)(F.ws + WS_X1), D, nullptr, 0};
        pg8::gemm_phase<pg8::Epi<pg8::EPI_RES>, pg8::StaticOrder, true, true>(F.lds + RING_OFF, g, S, E);
    ); SEAM(10);
    if (IN(11)) { const int gw = F.vcu * NWAVES + F.wave, NGW = F.G * NWAVES;
        for (int m = gw; m < M; m += NGW) rms_row(F.out + (size_t)m * D, F.in[I_NORM_FIN], nullptr, F.out + (size_t)m * D, F.lane); }
#undef IN
#undef SEAM
}

extern "C" void kernel_launch(void* const* d_in, const int* in_sizes, int n_in, void* d_out, int out_size, void* d_ws, size_t ws_size, hipStream_t stream) {
    static int grid = 0;
    if (grid == 0) {
        if (n_in != 19 || in_sizes[0] != M * D || out_size != M * D || ws_size < WS_END) { fprintf(stderr, "kernel_launch: unexpected shapes: n_in %d in0 %d out %d ws %zu (need %zu)\n", n_in, n_in > 0 ? in_sizes[0] : -1, out_size, ws_size, (size_t)WS_END); grid = -1; return; }
        int dev = 0, cus = 0, per_cu = 0;
        if (hipGetDevice(&dev) != hipSuccess || hipDeviceGetAttribute(&cus, hipDeviceAttributeMultiprocessorCount, dev) != hipSuccess) { grid = -1; return; }
        if (hipFuncSetAttribute((const void*)mk_fwd, hipFuncAttributeMaxDynamicSharedMemorySize, LDS_BYTES) != hipSuccess) { fprintf(stderr, "kernel_launch: hipFuncSetAttribute failed\n"); grid = -1; return; }
        if (hipOccupancyMaxActiveBlocksPerMultiprocessor(&per_cu, (const void*)mk_fwd, NWAVES * 64, LDS_BYTES) != hipSuccess || per_cu < 1) fprintf(stderr, "kernel_launch: occupancy query says %d\n", per_cu);
        (void)hipGetLastError();
        grid = cus;
    }
    if (grid < 0) return;
    if (hipMemsetAsync((char*)d_ws + WS_CTL, 0, CTL_ZERO_BYTES, stream) != hipSuccess) return;
    Args a{};
    for (int i = 0; i < 19; ++i) a.in[i] = (const float*)d_in[i];
    a.out = (float*)d_out; a.ws = (unsigned char*)d_ws;
#if MK_ONE_LAUNCH
    a.ph_lo = 0; a.ph_hi = N_PHASES;
    hipLaunchKernelGGL(mk_fwd, dim3(grid), dim3(NWAVES * 64), LDS_BYTES, stream, a);
#else
    for (int p = 0; p < N_PHASES; ++p) { a.ph_lo = p; a.ph_hi = p + 1; hipLaunchKernelGGL(mk_fwd, dim3(grid), dim3(NWAVES * 64), LDS_BYTES, stream, a); }
#endif
}
```

```cpp
#define MK_ONE_LAUNCH 1
#include <hip/hip_runtime.h>
#include <cstdio>
#include <cstdint>
namespace pg8 {
#define PG8_LAS __attribute__((address_space(3)))
typedef unsigned short bf16_t;
typedef short bf16x8 __attribute__((ext_vector_type(8)));
typedef float f32x4 __attribute__((ext_vector_type(4)));
typedef unsigned u32x4 __attribute__((ext_vector_type(4)));
constexpr int BM = 256, BK = 64, HALF = 128, HTB = HALF * BK * 2  , STAGE_BYTES = 8 * HTB, NXCD = 8, WGM = 8;

__host__ __device__ __forceinline__ int lds_byte(int r, int c) { const int st = (r >> 4) * 2 + (c >> 5), rr = r & 15, cc = c & 31, ob = rr * 64 + cc * 2; return st * 1024 + (ob ^ (((ob >> 9) & 1) << 5)); }
__host__ __device__ __forceinline__ void stage_rc(int b, int& R, int& C) { const int st = b / 1024, sb = b % 1024, swz = sb ^ (((sb >> 9) & 1) << 5); R = (st >> 1) * 16 + swz / 64; C = (st & 1) * 32 + (swz % 64) / 2; }
__host__ __device__ __forceinline__ int perm32(int rho) { const int n = rho >> 4, i = rho & 15; return 8 * (i >> 2) + 4 * n + (i & 3); }

struct Unit { int pm, pn; };
struct Gemm { const bf16_t* A; const bf16_t* Bt; int M, N, K; };

struct StaticOrder {
    int nM, nN, nwg, G, c;
    __host__ __device__ void init(int M, int N, int G_, int c_) { nM = M / BM; nN = N / BM; nwg = nM * nN; G = G_; c = c_; }
    __host__ __device__ bool next(int i, Unit& u) const {
        const long L = (long)i * G + c; if (L >= nwg) return false;
        int wgid = (int)L; { const int q = nwg / NXCD, r = nwg % NXCD, xcd = wgid % NXCD, off = wgid / NXCD; wgid = (xcd < r ? xcd * (q + 1) : r * (q + 1) + (xcd - r) * q) + off; }
        const int nig = WGM * nN, gid = wgid / nig, fm = gid * WGM, gsz = (nM - fm) < WGM ? (nM - fm) : WGM;
        u.pm = fm + ((wgid % nig) % gsz); u.pn = (wgid % nig) / gsz; return true;
    }
    __device__ __forceinline__ void a_ready(const Unit&) const {}
    __device__ __forceinline__ void done(const Unit&) const {}
};

__device__ __forceinline__ unsigned cvt_pk_bf16(float lo, float hi) { unsigned r; asm volatile("v_cvt_pk_bf16_f32 %0, %1, %2" : "=v"(r) : "v"(lo), "v"(hi)); return r; }
__device__ __forceinline__ float bf_lo(unsigned w) { return __uint_as_float(w << 16); }
__device__ __forceinline__ float bf_hi(unsigned w) { return __uint_as_float(w & 0xffff0000u); }
__device__ __forceinline__ float sigm(float x) { return __builtin_amdgcn_rcpf(1.0f + __expf(-x)); }
template <int N> __device__ __forceinline__ float dpp_shr(float old, float x) { return __int_as_float(__builtin_amdgcn_update_dpp(__float_as_int(old), __float_as_int(x), 0x110 + N, 0xf, 0xf, false)); }
template <int N> __device__ __forceinline__ float dpp_shl(float x) { return __int_as_float(__builtin_amdgcn_update_dpp(0, __float_as_int(x), 0x100 + N, 0xf, 0xf, true)); }
#define PG8_DPP_SHR(old, x, n) dpp_shr<n>((old), (x))
#define PG8_DPP_SHL(x, n) dpp_shl<n>((x))
enum { EPI_BF16 = 0, EPI_BRA = 1, EPI_BRB = 2, EPI_RES = 3 };
template <int MODE> struct Epi {
    static constexpr bool PERM = true, AFTER_DRAIN = false;
    bf16_t* Ob; int ldo; float* Of; int ldf; const float* R; int ldr; const bf16_t* Gt; int ldg;
    __device__ __forceinline__ void operator()(const f32x4 (&acc)[2][2][4][2], const Unit& u, int wr, int wc, int fr, int fq) const {
        const int row0 = u.pm * BM + wr * 64 + fr, col0 = u.pn * BM + wc * 32 + 8 * fq;
#pragma unroll
        for (int ai = 0; ai < 2; ++ai)
#pragma unroll
            for (int m = 0; m < 4; ++m) { const size_t row = (size_t)(row0 + ai * HALF + m * 16);
#pragma unroll
                for (int bj = 0; bj < 2; ++bj) { const int col = col0 + bj * HALF; f32x4 v0 = acc[ai][bj][m][0], v1 = acc[ai][bj][m][1];
                    if (MODE == EPI_BRA || MODE == EPI_BRB) { const u32x4 g = *(const u32x4*)(Gt + row * ldg + col);
                        v0[0] *= sigm(bf_lo(g.x)); v0[1] *= sigm(bf_hi(g.x)); v0[2] *= sigm(bf_lo(g.y)); v0[3] *= sigm(bf_hi(g.y));
                        v1[0] *= sigm(bf_lo(g.z)); v1[1] *= sigm(bf_hi(g.z)); v1[2] *= sigm(bf_lo(g.w)); v1[3] *= sigm(bf_hi(g.w)); }
                    if (MODE == EPI_BRB) { const float* t = Of + row * ldf + col; v0 += *(const f32x4*)t; v1 += *(const f32x4*)(t + 4); }
                    if (MODE == EPI_RES) { const float* t = R + row * ldr + col; v0 += *(const f32x4*)t; v1 += *(const f32x4*)(t + 4); }
                    if (MODE == EPI_BF16 || MODE == EPI_BRB) { u32x4 w; w.x = cvt_pk_bf16(v0[0], v0[1]); w.y = cvt_pk_bf16(v0[2], v0[3]); w.z = cvt_pk_bf16(v1[0], v1[1]); w.w = cvt_pk_bf16(v1[2], v1[3]);
                        *(u32x4*)(Ob + row * ldo + col) = w; }
                    else { float* o = Of + row * ldf + col; *(f32x4*)o = v0; *(f32x4*)(o + 4) = v1; } }
                asm volatile("" ::: "memory"); }
    }
};

struct EpiGlu {
    static constexpr bool PERM = true, AFTER_DRAIN = false;
    bf16_t* HID; int ldh; const float* cw; const float* cb; int nch; float* GTAIL; float* GHEAD; float* UHEAD; PG8_LAS float* xl;
    __device__ __forceinline__ void operator()(const f32x4 (&acc)[2][2][4][2], const Unit& u, int wr, int wc, int fr, int fq) const {
        const int ch0 = u.pn * 128 + wc * 32 + 8 * fq;
        if (fr >= 14) {
#pragma unroll
            for (int ai = 0; ai < 2; ++ai) { PG8_LAS float* d = xl + ((wr * 4 + wc) * 2 + ai) * 64 + (fr - 14) * 32 + 8 * fq; *(PG8_LAS f32x4*)d = acc[ai][0][3][0]; *(PG8_LAS f32x4*)(d + 4) = acc[ai][0][3][1]; }
        }
        asm volatile("s_waitcnt lgkmcnt(0)" ::: "memory"); __builtin_amdgcn_s_barrier(); asm volatile("" ::: "memory");
        f32x4 w[3][2], bb[2];
#pragma unroll
        for (int k = 0; k < 3; ++k) { w[k][0] = *(const f32x4*)(cw + (size_t)k * nch + ch0); w[k][1] = *(const f32x4*)(cw + (size_t)k * nch + ch0 + 4); }
        bb[0] = *(const f32x4*)(cb + ch0); bb[1] = *(const f32x4*)(cb + ch0 + 4);
#pragma unroll
        for (int ai = 0; ai < 2; ++ai) {
            f32x4 p1[2], p2[2];
            { f32x4 t0 = (f32x4){0.f, 0.f, 0.f, 0.f}, t1 = t0;
              if (!(ai == 0 && wr == 0)) { const int pwr = wr ^ 1, pai = (wr == 1) ? ai : ai - 1; const PG8_LAS float* sp = xl + ((pwr * 4 + wc) * 2 + pai) * 64 + (fr & 1) * 32 + 8 * fq; t0 = *(const PG8_LAS f32x4*)sp; t1 = *(const PG8_LAS f32x4*)(sp + 4); }
#pragma unroll
              for (int j = 0; j < 4; ++j) { p1[0][j] = PG8_DPP_SHL(t0[j], 15); p1[1][j] = PG8_DPP_SHL(t1[j], 15); p2[0][j] = PG8_DPP_SHL(t0[j], 14); p2[1][j] = PG8_DPP_SHL(t1[j], 14); } }
#pragma unroll
            for (int m = 0; m < 4; ++m) {
                const size_t row = (size_t)(u.pm * BM + ai * HALF + wr * 64 + m * 16 + fr);
                f32x4 hv[2];
#pragma unroll
                for (int n = 0; n < 2; ++n)
#pragma unroll
                    for (int j = 0; j < 4; ++j) { const float g = acc[ai][0][m][n][j];
                        const float g1 = PG8_DPP_SHR(p1[n][j], g, 1), g2 = PG8_DPP_SHR(p2[n][j], g, 2);
                        p1[n][j] = PG8_DPP_SHL(g, 15); p2[n][j] = PG8_DPP_SHL(g, 14);
                        const float y = bb[n][j] + w[0][n][j] * g2 + w[1][n][j] * g1 + w[2][n][j] * g;
                        hv[n][j] = y * __builtin_amdgcn_rcpf(1.0f + __expf(-y)) * acc[ai][1][m][n][j]; }
                u32x4 o; o.x = cvt_pk_bf16(hv[0][0], hv[0][1]); o.y = cvt_pk_bf16(hv[0][2], hv[0][3]); o.z = cvt_pk_bf16(hv[1][0], hv[1][1]); o.w = cvt_pk_bf16(hv[1][2], hv[1][3]);
                *(u32x4*)(HID + row * ldh + ch0) = o;
            }
        }
        if (wr == 0 && fr < 2) { float* g = GHEAD + ((size_t)u.pm * 2 + fr) * nch + ch0; float* q = UHEAD + ((size_t)u.pm * 2 + fr) * nch + ch0;
            *(f32x4*)g = acc[0][0][0][0]; *(f32x4*)(g + 4) = acc[0][0][0][1]; *(f32x4*)q = acc[0][1][0][0]; *(f32x4*)(q + 4) = acc[0][1][0][1]; }
        if (wr == 1 && fr >= 14) { float* g = GTAIL + ((size_t)u.pm * 2 + (fr - 14)) * nch + ch0; *(f32x4*)g = acc[1][0][3][0]; *(f32x4*)(g + 4) = acc[1][0][3][1]; }
    }
};

template <class Epi, class Sched, bool ALIGN_EPI = false, bool SP2 = false>
__device__ __forceinline__ void gemm_phase(PG8_LAS unsigned char* lds, const Gemm g, const Sched& S, const Epi& E) {
    const int tid = threadIdx.x, wid = __builtin_amdgcn_readfirstlane(tid >> 6), lane = tid & 63, wr = wid >> 2, wc = wid & 3, fr = lane & 15, fq = lane >> 4;
    const int K = g.K, nt = K / BK;
    unsigned voffA[2], voffB[2];
#pragma unroll
    for (int i = 0; i < 2; ++i) { int R, C; stage_rc(tid * 16 + i * 8192, R, C); const int Rb = Epi::PERM ? ((R & ~31) + perm32(R & 31)) : R;
        voffA[i] = (unsigned)(R * K + C) * 2u; voffB[i] = (unsigned)(Rb * K + C) * 2u; }
    const size_t kstep = (size_t)(BK * 2);
    const size_t hstep = (size_t)HALF * K * 2;
    const size_t tstep = 2 * hstep;
    const unsigned ldsw = (unsigned)wid * 1024u;
    const int aoff = lds_byte(wr * 64 + fr, fq * 8), boff = lds_byte(wc * 32 + fr, fq * 8);
#define PG8_SA(b, h) (((b) * 2 + (h)) * HTB)
#define PG8_SB(b, h) ((4 + (b) * 2 + (h)) * HTB)
#define PG8_STAGE(bufoff, gbase, voff) do { _Pragma("unroll") for (int _i = 0; _i < 2; ++_i) \
        __builtin_amdgcn_global_load_lds((const unsigned*)((const char*)(gbase) + (voff)[_i]), (PG8_LAS unsigned*)(lds + (bufoff) + ldsw + _i * 8192), 16, 0, 0); } while (0)
#define PG8_LDA(dst, b, h) do { _Pragma("unroll") for (int m = 0; m < 4; ++m) _Pragma("unroll") for (int k = 0; k < 2; ++k) dst[m][k] = *(const PG8_LAS bf16x8*)(lds + PG8_SA(b, h) + aoff + m * 2048 + k * 1024); } while (0)
#define PG8_LDB(dst, b, h) do { _Pragma("unroll") for (int n = 0; n < 2; ++n) _Pragma("unroll") for (int k = 0; k < 2; ++k) dst[n][k] = *(const PG8_LAS bf16x8*)(lds + PG8_SB(b, h) + boff + n * 2048 + k * 1024); } while (0)
#define PG8_MMA(ai, bj, At, Bt) do { __builtin_amdgcn_s_setprio(1); _Pragma("unroll") for (int m = 0; m < 4; ++m) _Pragma("unroll") for (int n = 0; n < 2; ++n) _Pragma("unroll") for (int k = 0; k < 2; ++k) \
        acc[ai][bj][m][n] = __builtin_amdgcn_mfma_f32_16x16x32_bf16(Bt[n][k], At[m][k], acc[ai][bj][m][n], 0, 0, 0); __builtin_amdgcn_s_setprio(0); } while (0)
#define PG8_WAIT_V(n) asm volatile("s_waitcnt vmcnt(" #n ")" ::: "memory")
#define PG8_WAIT_L(n) asm volatile("s_waitcnt lgkmcnt(" #n ")" ::: "memory")
#define PG8_BAR __builtin_amdgcn_s_barrier()
#define PG8_SCHED __builtin_amdgcn_sched_barrier(0)
    Unit cur, nxt; int ui = 0;
    if (!S.next(0, cur)) return;
    f32x4 acc[2][2][4][2];
#pragma unroll
    for (int a = 0; a < 2; ++a)
#pragma unroll
        for (int b = 0; b < 2; ++b)
#pragma unroll
            for (int m = 0; m < 4; ++m)
#pragma unroll
                for (int n = 0; n < 2; ++n) acc[a][b][m][n] = (f32x4){0.f, 0.f, 0.f, 0.f};
    bf16x8 At[4][2], B0[2][2], B1[2][2];
    const char* cA = (const char*)g.A + (size_t)cur.pm * tstep; const char* cB = (const char*)g.Bt + (size_t)cur.pn * tstep;
    S.a_ready(cur);
    if constexpr (SP2) {
        PG8_STAGE(PG8_SB(0, 0), cB, voffB); PG8_STAGE(PG8_SB(0, 1), cB + hstep, voffB); PG8_STAGE(PG8_SA(0, 0), cA, voffA); PG8_STAGE(PG8_SA(0, 1), cA + hstep, voffA);
        if (wr == 1) PG8_BAR;
        PG8_WAIT_V(2); PG8_BAR;
        PG8_STAGE(PG8_SB(1, 0), cB + kstep, voffB); PG8_STAGE(PG8_SA(1, 0), cA + kstep, voffA); PG8_STAGE(PG8_SB(1, 1), cB + hstep + kstep, voffB);
        PG8_WAIT_V(6); PG8_BAR;
    } else {
        PG8_STAGE(PG8_SB(0, 0), cB, voffB); PG8_STAGE(PG8_SA(0, 0), cA, voffA); PG8_STAGE(PG8_SB(0, 1), cB + hstep, voffB); PG8_STAGE(PG8_SA(0, 1), cA + hstep, voffA);
        if (wr == 1) PG8_BAR;
        PG8_WAIT_V(4); PG8_BAR;
        PG8_STAGE(PG8_SB(1, 0), cB + kstep, voffB); PG8_STAGE(PG8_SA(1, 0), cA + kstep, voffA); PG8_STAGE(PG8_SB(1, 1), cB + hstep + kstep, voffB);
        PG8_WAIT_V(6); PG8_BAR;
    }
    for (;;) {
        const bool has_next = S.next(ui + 1, nxt);
        const char* nA = has_next ? (const char*)g.A + (size_t)nxt.pm * tstep : cA; const char* nB = has_next ? (const char*)g.Bt + (size_t)nxt.pn * tstep : cB;
        for (int t = 0; t < nt; t += 2) {
            const bool last = (t == nt - 2);
            const char* a1 = cA + (size_t)(t + 1) * kstep;
            const char* a2 = last ? nA : cA + (size_t)(t + 2) * kstep; const char* b2 = last ? nB : cB + (size_t)(t + 2) * kstep;
            const char* a3 = a2 + kstep; const char* b3 = b2 + kstep;
            if (last && has_next) S.a_ready(nxt);
            if constexpr (SP2) {
            PG8_LDB(B0, 0, 0); PG8_LDB(B1, 0, 1); PG8_SCHED; PG8_LDA(At, 0, 0); PG8_STAGE(PG8_SA(1, 1), a1 + hstep, voffA);
            PG8_WAIT_V(8); PG8_WAIT_L(0); PG8_BAR; PG8_MMA(0, 0, At, B0); PG8_MMA(0, 1, At, B1); PG8_BAR; PG8_SCHED;
            PG8_LDA(At, 0, 1); PG8_STAGE(PG8_SB(0, 0), b2, voffB); PG8_STAGE(PG8_SB(0, 1), b2 + hstep, voffB); PG8_STAGE(PG8_SA(0, 0), a2, voffA);
            PG8_WAIT_V(8); PG8_WAIT_L(0); PG8_BAR; PG8_MMA(1, 0, At, B0); PG8_MMA(1, 1, At, B1); PG8_BAR; PG8_SCHED;
            PG8_LDB(B0, 1, 0); PG8_LDB(B1, 1, 1); PG8_SCHED; PG8_LDA(At, 1, 0); PG8_STAGE(PG8_SA(0, 1), a2 + hstep, voffA);
            PG8_WAIT_V(8); PG8_WAIT_L(0); PG8_BAR; PG8_MMA(0, 0, At, B0); PG8_MMA(0, 1, At, B1); PG8_BAR; PG8_SCHED;
            PG8_LDA(At, 1, 1); PG8_STAGE(PG8_SB(1, 0), b3, voffB); PG8_STAGE(PG8_SB(1, 1), b3 + hstep, voffB); PG8_STAGE(PG8_SA(1, 0), a3, voffA);
            PG8_WAIT_V(8); PG8_WAIT_L(0); PG8_BAR; PG8_MMA(1, 0, At, B0); PG8_MMA(1, 1, At, B1); PG8_BAR; PG8_SCHED;
            } else {
            PG8_LDB(B0, 0, 0); PG8_SCHED; PG8_LDA(At, 0, 0); PG8_STAGE(PG8_SA(1, 1), a1 + hstep, voffA);
            PG8_WAIT_L(8); PG8_BAR; PG8_WAIT_L(0); PG8_MMA(0, 0, At, B0); PG8_BAR; PG8_SCHED;
            PG8_LDB(B1, 0, 1); PG8_STAGE(PG8_SB(0, 0), b2, voffB);
            PG8_BAR; PG8_WAIT_L(0); PG8_MMA(0, 1, At, B1); PG8_BAR;
            PG8_LDA(At, 0, 1); PG8_STAGE(PG8_SA(0, 0), a2, voffA);
            PG8_BAR; PG8_WAIT_L(0); PG8_MMA(1, 0, At, B0); PG8_BAR; PG8_SCHED;
            PG8_STAGE(PG8_SB(0, 1), b2 + hstep, voffB);
            PG8_WAIT_V(6); PG8_BAR; PG8_MMA(1, 1, At, B1); PG8_BAR;
            PG8_LDB(B0, 1, 0); PG8_SCHED; PG8_LDA(At, 1, 0); PG8_STAGE(PG8_SA(0, 1), a2 + hstep, voffA);
            PG8_WAIT_L(8); PG8_BAR; PG8_WAIT_L(0); PG8_MMA(0, 0, At, B0); PG8_BAR; PG8_SCHED;
            PG8_LDB(B1, 1, 1); PG8_STAGE(PG8_SB(1, 0), b3, voffB);
            PG8_BAR; PG8_WAIT_L(0); PG8_MMA(0, 1, At, B1); PG8_BAR;
            PG8_LDA(At, 1, 1); PG8_STAGE(PG8_SA(1, 0), a3, voffA);
            PG8_BAR; PG8_WAIT_L(0); PG8_MMA(1, 0, At, B0); PG8_BAR; PG8_SCHED;
            PG8_STAGE(PG8_SB(1, 1), b3 + hstep, voffB);
            PG8_WAIT_V(6); PG8_BAR; PG8_MMA(1, 1, At, B1); PG8_BAR;
            }
        }
        if constexpr (ALIGN_EPI) { if (wr == 0) PG8_BAR; }
        if constexpr (!Epi::AFTER_DRAIN) { E(acc, cur, wr, wc, fr, fq); S.done(cur); }
        if (!has_next) break;
#pragma unroll
        for (int a = 0; a < 2; ++a)
#pragma unroll
            for (int b = 0; b < 2; ++b)
#pragma unroll
                for (int m = 0; m < 4; ++m)
#pragma unroll
                    for (int n = 0; n < 2; ++n) acc[a][b][m][n] = (f32x4){0.f, 0.f, 0.f, 0.f};
        cur = nxt; cA = nA; cB = nB; ++ui;
        if constexpr (ALIGN_EPI) { if (wr == 1) PG8_BAR; }
    }
    PG8_WAIT_V(0);
    if constexpr (!ALIGN_EPI) { if (wr == 0) PG8_BAR; }
    PG8_BAR;
    if constexpr (Epi::AFTER_DRAIN) { E.fused(acc, cur, wr, wc, fr, fq, lds, wid, lane); S.done(cur); }
#undef PG8_SA
#undef PG8_SB
#undef PG8_STAGE
#undef PG8_LDA
#undef PG8_LDB
#undef PG8_MMA
#undef PG8_WAIT_V
#undef PG8_WAIT_L
#undef PG8_BAR
#undef PG8_SCHED
}
}

constexpr int NWAVES = 8;
constexpr int BATCH = 4, SEQ = 2048, D = 4096, M = BATCH * SEQ;
constexpr int DN_H = 16, DN_DK = 128, DN_DV = 128, DN_KEY = 2048, DN_VAL = 2048, DN_QKV = 6144;
constexpr int GL_H = 8, GL_DK = 128, GL_DV = 256, GL_KEY = 1024, GL_VAL = 2048, GL_RANK = 16;
constexpr int DFF = 11008, IN_COLS = 22576;
constexpr float EPS = 1e-6f;
constexpr int PN = 22528;
constexpr int PC_QKV = 0, PC_Z = 6144, PC_GQ = 8192, PC_GK = 9216, PC_GV = 10240, PC_GR = 12288, PC_GATE_DN = 14336, PC_GATE_GLA = 18432;
constexpr int PSM = 64;
constexpr int NGU = 2 * DFF;

constexpr size_t MiB = 1u << 20;
constexpr size_t WS_CTL = 0, CTL_ZERO_BYTES = 1 * MiB;
constexpr size_t WS_WIN = 1 * MiB, WS_WSM = 177 * MiB, WS_WBDN = 178 * MiB, WS_WBGLA = 194 * MiB, WS_WOUT = 210 * MiB, WS_WFIN = 242 * MiB, WS_WFOUT = 414 * MiB;
constexpr size_t WS_H = 500 * MiB, WS_PROJ = 564 * MiB, WS_PSMALL = 916 * MiB;
constexpr size_t WS_DW = 918 * MiB, WS_DQE = 950 * MiB, WS_DKT = 982 * MiB, WS_DAT = 1014 * MiB, WS_DU = 1030 * MiB, WS_DDL = 1094 * MiB;
constexpr size_t WS_GQE = 1096 * MiB, WS_GKT = 1112 * MiB, WS_GAT = 1128 * MiB, WS_GVT = 1136 * MiB, WS_GDL = 1168 * MiB;
constexpr size_t WS_EK = 1170 * MiB;
constexpr size_t WS_QF = 918 * MiB, WS_KF = 982 * MiB, WS_VF = 1046 * MiB, WS_BETA = 1094 * MiB, WS_G = WS_BETA + 512 * 1024;
constexpr size_t WS_ODN = 1208 * MiB, WS_OGLA = 1272 * MiB, WS_ONDN = 1336 * MiB, WS_ONGLA = 1368 * MiB, WS_END = 1400 * MiB;
constexpr size_t WS_TMP = 918 * MiB, WS_MERGED = 1046 * MiB, WS_X1 = 1110 * MiB, WS_GU = WS_PROJ, WS_HID = WS_WIN;
static_assert(WS_WIN + (size_t)PN * D * 2 <= WS_WSM && WS_WFIN + (size_t)NGU * D * 2 <= WS_WFOUT && WS_WFOUT + (size_t)D * DFF * 2 <= WS_H, "ws map (weights)");
static_assert(WS_PROJ + (size_t)M * PN * 2 <= WS_PSMALL && WS_GU + (size_t)M * NGU * 2 <= WS_PSMALL && WS_HID + (size_t)M * DFF * 2 <= WS_WSM, "ws map (activations)");
static_assert(WS_X1 + (size_t)M * D * 4 <= WS_ONDN, "ws map (x1)");
constexpr size_t WS_GTAIL = WS_MERGED, WS_GHEAD = WS_MERGED + 4 * MiB, WS_UHEAD = WS_MERGED + 8 * MiB;
constexpr int CW_BAR = 4096;

constexpr int RING_OFF = 0, RING_BYTES = 131072;
constexpr int LDSCTL_OFF = RING_BYTES, MISC_OFF = LDSCTL_OFF + 320;
constexpr int XL_OFF = LDSCTL_OFF + 1024;
constexpr int LDS_BYTES = 147456;

#define GAS __attribute__((address_space(1)))
#define LAS __attribute__((address_space(3)))
typedef unsigned short bf16;
typedef unsigned v4u __attribute__((ext_vector_type(4)));
typedef unsigned v2u __attribute__((ext_vector_type(2)));
typedef float f32x4 __attribute__((ext_vector_type(4)));
typedef float f32x2 __attribute__((ext_vector_type(2)));
typedef short bf16x8 __attribute__((ext_vector_type(8)));
typedef GAS unsigned gu32;
#define RLX_AGENT __ATOMIC_RELAXED, __HIP_MEMORY_SCOPE_AGENT
#define LDS_WAIT() asm volatile("s_waitcnt lgkmcnt(0)" ::: "memory")
#define VM_WAIT() asm volatile("s_waitcnt vmcnt(0)" ::: "memory")
__device__ __forceinline__ unsigned f2bf(float f) { unsigned u = __builtin_bit_cast(unsigned, f); return (u + 0x7fffu + ((u >> 16) & 1u)) >> 16; }
__device__ __forceinline__ unsigned pk2(float lo, float hi) { return f2bf(lo) | (f2bf(hi) << 16); }
__device__ __forceinline__ float bflo(unsigned w) { return __uint_as_float(w << 16); }
__device__ __forceinline__ float bfhi(unsigned w) { return __uint_as_float(w & 0xffff0000u); }
__device__ __forceinline__ float bf1(bf16 b) { return __uint_as_float((unsigned)b << 16); }
__device__ __forceinline__ float sigmoid_f(float x) { return 1.0f / (1.0f + expf(-x)); }
__device__ __forceinline__ float silu_f(float x) { return x / (1.0f + expf(-x)); }
__device__ __forceinline__ float softplus_f(float x) { return fmaxf(x, 0.f) + log1pf(expf(-fabsf(x))); }
__device__ __forceinline__ float logsigmoid_f(float x) { return fminf(x, 0.f) - log1pf(expf(-fabsf(x))); }
__device__ __forceinline__ float wave_sum(float v) {
#pragma unroll
    for (int o = 1; o < 64; o <<= 1) v += __shfl_xor(v, o);
    return v;
}

#define XB_TMO      128
#define XB_XCNT(j)  (256  + 64 * (j))
#define XB_XSUB(j)  (1280 + 64 * (j))
#define XB_XGEN(j)  (2304 + 64 * (j))
#define XB_TOP      3328
#define XB_TOPGEN   3392
#define XCD_BAR_WORDS 3456
#define XB_SPIN_CAP (1u << 18)

__device__ __forceinline__ unsigned xb_ld(unsigned* p)              { return __hip_atomic_load(p, __ATOMIC_RELAXED, __HIP_MEMORY_SCOPE_AGENT); }
__device__ __forceinline__ unsigned xb_add(unsigned* p, unsigned v) { return __hip_atomic_fetch_add(p, v, __ATOMIC_RELAXED, __HIP_MEMORY_SCOPE_AGENT); }
__device__ __forceinline__ unsigned xb_xcc_id() { return (unsigned)__builtin_amdgcn_s_getreg((3 << 11) | 20) & 0xFu; }
#define XB_SPIN(cond, bar) do { unsigned _sp = 0; while (cond) { __builtin_amdgcn_s_sleep(1); \
    if ((++_sp & 255u) == 0u) { if (xb_ld(&(bar)[XB_TMO])) break; if (_sp > XB_SPIN_CAP) { atomicAdd(&(bar)[XB_TMO], 1u); break; } } } } while (0)

struct XcdBarrier {
    unsigned* bar; unsigned x;
    volatile LAS unsigned* st;
};

__device__ __forceinline__ XcdBarrier xcd_barrier_post(unsigned* bar, volatile LAS unsigned* st) {
    XcdBarrier b; b.bar = bar; b.x = xb_xcc_id(); b.st = st;
    if (threadIdx.x == 0) (void)xb_add(&bar[XB_XCNT(b.x)], 1u);
    return b;
}
__device__ __forceinline__ void xcd_barrier_complete(unsigned* bar, unsigned x, unsigned& nloc, unsigned& nx) {
    const unsigned G = gridDim.x * gridDim.y * gridDim.z;
    unsigned sum, cnt, mine, sp = 0u;
    for (;;) {
        sum = 0u; cnt = 0u; mine = 0u;
#pragma unroll
        for (unsigned j = 0; j < 16; ++j) { const unsigned c = xb_ld(&bar[XB_XCNT(j)]); sum += c; cnt += (c > 0u) ? 1u : 0u; mine = (j == x) ? c : mine; }
        if (sum == G) break;
        __builtin_amdgcn_s_sleep(1);
        if ((++sp & 255u) == 0u) { if (xb_ld(&bar[XB_TMO])) break; if (sp > XB_SPIN_CAP) { atomicAdd(&bar[XB_TMO], 1u); break; } }
    }
    nloc = mine > 0u ? mine : 1u; nx = cnt > 0u ? cnt : 1u;
}

__device__ __forceinline__ void xcd_barrier(const XcdBarrier& b) {
    asm volatile("s_waitcnt vmcnt(0)" ::: "memory");
    __syncthreads();
    if (threadIdx.x == 0) {
        unsigned* bar = b.bar;
        __builtin_amdgcn_s_waitcnt(0);
        unsigned nloc = b.st[0], nx = b.st[1];
        if (nloc == 0u) { xcd_barrier_complete(bar, b.x, nloc, nx); b.st[0] = nloc; b.st[1] = nx; }
        const unsigned old = xb_add(&bar[XB_XSUB(b.x)], 1u);
        const unsigned gen = old / nloc;
        if (old + 1u == (gen + 1u) * nloc) {
            __builtin_amdgcn_fence(__ATOMIC_RELEASE, "agent");
            asm volatile("s_waitcnt vmcnt(0)" ::: "memory");
            const unsigned og = xb_add(&bar[XB_TOP], 1u);
            const unsigned tg = og / nx;
            if (og + 1u == (tg + 1u) * nx) xb_add(&bar[XB_TOPGEN], 1u);
            else XB_SPIN(xb_ld(&bar[XB_TOPGEN]) == tg, bar);
            __builtin_amdgcn_fence(__ATOMIC_ACQUIRE, "agent");
            xb_add(&bar[XB_XGEN(b.x)], 1u);
            asm volatile("s_waitcnt vmcnt(0)" ::: "memory");
        } else {
            XB_SPIN(xb_ld(&bar[XB_XGEN(b.x)]) == gen, bar);
            __builtin_amdgcn_fence(__ATOMIC_ACQUIRE, "agent");
            asm volatile("s_waitcnt vmcnt(0)" ::: "memory");
        }
    }
    __syncthreads();
}

struct Frame {
    LAS unsigned char* lds;
    volatile LAS unsigned* MISC;
    gu32* ctl;
    int tid, lane, wave;
    int vcu, G;
    unsigned char* ws;
    const float* in[19];
    float* out;
};
enum { I_X = 0, I_NORM_MIX, I_W_IN, I_DN_CONV, I_DN_ALOG, I_DN_DTB, I_DN_NORM, I_GL_WA2, I_GL_BA, I_GL_NORM, I_W_BDN, I_W_BGLA, I_W_OUT, I_NORM_FFN, I_W_FIN, I_FFN_CW, I_FFN_CB, I_W_FOUT, I_NORM_FIN };

__device__ __forceinline__ void transpose_item(const float* W, size_t ldw, int k0, int sn0, bf16* WT, size_t ldk, int dn0, LAS float* scr, int lane) {
#pragma unroll 8
    for (int i = 0; i < 32; ++i) { const int kk = 2 * i + (lane >> 5); scr[kk * 33 + (lane & 31)] = W[(size_t)(k0 + kk) * ldw + sn0 + (lane & 31)]; }
    LDS_WAIT(); asm volatile("" ::: "memory");
    const int c = lane & 7;
#pragma unroll
    for (int j = 0; j < 4; ++j) { const int n = (lane >> 3) + 8 * j; const LAS float* s = scr + (8 * c) * 33 + n;
        v4u o; o.x = pk2(s[0 * 33], s[1 * 33]); o.y = pk2(s[2 * 33], s[3 * 33]); o.z = pk2(s[4 * 33], s[5 * 33]); o.w = pk2(s[6 * 33], s[7 * 33]);
        *(GAS v4u*)(WT + (size_t)(dn0 + n) * ldk + k0 + 8 * c) = o; }
    LDS_WAIT(); asm volatile("" ::: "memory");
}
__device__ __forceinline__ void rms_row(const float* xrow, const float* w, bf16* obf, float* of32, int lane) {
    const GAS f32x4* xr = (const GAS f32x4*)xrow + lane;
    f32x4 v[16]; float s = 0.f;
#pragma unroll
    for (int j = 0; j < 16; ++j) { v[j] = xr[64 * j]; s += (v[j].x * v[j].x + v[j].y * v[j].y) + (v[j].z * v[j].z + v[j].w * v[j].w); }
    const float rstd = 1.0f / sqrtf(wave_sum(s) * (1.f / D) + EPS);
    const GAS f32x4* wr = (const GAS f32x4*)w + lane;
    if (obf) { GAS v2u* o8 = (GAS v2u*)obf + lane;
#pragma unroll
        for (int j = 0; j < 16; ++j) { const f32x4 g = wr[64 * j]; v2u o; o.x = pk2(v[j].x * rstd * g.x, v[j].y * rstd * g.y); o.y = pk2(v[j].z * rstd * g.z, v[j].w * rstd * g.w); o8[64 * j] = o; } }
    else { GAS f32x4* o = (GAS f32x4*)of32 + lane;
#pragma unroll
        for (int j = 0; j < 16; ++j) { const f32x4 g = wr[64 * j]; o[64 * j] = (f32x4){v[j].x * rstd * g.x, v[j].y * rstd * g.y, v[j].z * rstd * g.z, v[j].w * rstd * g.w}; } }
}

__device__ __forceinline__ void p0_prologue(Frame& F) {
    LAS float* scr = (LAS float*)(F.lds + RING_OFF + F.wave * 16384);
    const int gw = F.vcu * NWAVES + F.wave, NGW = F.G * NWAVES;
    bf16* WIN = (bf16*)(F.ws + WS_WIN); bf16* WSM = (bf16*)(F.ws + WS_WSM); bf16* WBDN = (bf16*)(F.ws + WS_WBDN); bf16* WBGLA = (bf16*)(F.ws + WS_WBGLA);
    bf16* WOUT = (bf16*)(F.ws + WS_WOUT); bf16* WFIN = (bf16*)(F.ws + WS_WFIN); bf16* WFOUT = (bf16*)(F.ws + WS_WFOUT);
    constexpr int NB_IN = PN / 32, I_IN = (D / 64) * NB_IN;
    constexpr int I_SM = (D / 64) * 2;
    constexpr int I_BR = (2048 / 64) * (D / 32);
    constexpr int I_OUT = (D / 64) * (D / 32);
    constexpr int NB_FI = NGU / 32, I_FI = (D / 64) * NB_FI;
    constexpr int I_FO = (DFF / 64) * (D / 32);
    constexpr int NITEMS = I_IN + I_SM + 2 * I_BR + I_OUT + I_FI + I_FO;
    for (int it = gw; it < NITEMS; it += NGW) {
        int r = it;
        if (r < I_IN) { const int kb = r / NB_IN, nb = r % NB_IN, n0 = 32 * nb; const int sn0 = n0 + (n0 >= PC_GATE_DN ? 48 : (n0 >= PC_GQ ? 32 : 0));
            transpose_item(F.in[I_W_IN], IN_COLS, 64 * kb, sn0, WIN, D, n0, scr, F.lane); continue; } r -= I_IN;
        if (r < I_SM) { const int kb = r >> 1, nb = r & 1; transpose_item(F.in[I_W_IN], IN_COLS, 64 * kb, nb ? 14368 : 8192, WSM, D, 32 * nb, scr, F.lane); continue; } r -= I_SM;
        if (r < I_BR) { const int kb = r / (D / 32), nb = r % (D / 32); transpose_item(F.in[I_W_BDN], D, 64 * kb, 32 * nb, WBDN, 2048, 32 * nb, scr, F.lane); continue; } r -= I_BR;
        if (r < I_BR) { const int kb = r / (D / 32), nb = r % (D / 32); transpose_item(F.in[I_W_BGLA], D, 64 * kb, 32 * nb, WBGLA, 2048, 32 * nb, scr, F.lane); continue; } r -= I_BR;
        if (r < I_OUT) { const int kb = r / (D / 32), nb = r % (D / 32); transpose_item(F.in[I_W_OUT], D, 64 * kb, 32 * nb, WOUT, D, 32 * nb, scr, F.lane); continue; } r -= I_OUT;
        if (r < I_FI) { const int kb = r / NB_FI, nb = r % NB_FI, n0 = 32 * nb, j = n0 >> 8, i = n0 & 255; const int sn0 = (i < 128) ? (128 * j + i) : (DFF + 128 * j + (i - 128));
            transpose_item(F.in[I_W_FIN], NGU, 64 * kb, sn0, WFIN, D, n0, scr, F.lane); continue; } r -= I_FI;
        { const int kb = r / (D / 32), nb = r % (D / 32); transpose_item(F.in[I_W_FOUT], D, 64 * kb, 32 * nb, WFOUT, DFF, 32 * nb, scr, F.lane); }
    }
    bf16* H = (bf16*)(F.ws + WS_H);
    for (int m = gw; m < M; m += NGW) rms_row(F.in[I_X] + (size_t)m * D, F.in[I_NORM_MIX], H + (size_t)m * D, nullptr, F.lane);
}

__device__ __forceinline__ void p1_skinny(Frame& F) {
    const bf16* H = (const bf16*)(F.ws + WS_H); const bf16* WSM = (const bf16*)(F.ws + WS_WSM); float* PS = (float*)(F.ws + WS_PSMALL);
    const int lane = F.lane, fr = lane & 15, fq = lane >> 4;
    for (int t = (int)blockIdx.x + F.G * F.wave; t < M / 16; t += F.G * NWAVES) {
        const int row0 = 16 * t;
        const bf16* ap = H + (size_t)(row0 + fr) * D + 8 * fq; const bf16* bp = WSM + (size_t)fr * D + 8 * fq;
        f32x4 acc[4] = {{0.f, 0.f, 0.f, 0.f}, {0.f, 0.f, 0.f, 0.f}, {0.f, 0.f, 0.f, 0.f}, {0.f, 0.f, 0.f, 0.f}};
#pragma unroll 4
        for (int kk = 0; kk < D / 32; ++kk) {
            const bf16x8 a = *(const GAS bf16x8*)(ap + kk * 32);
#pragma unroll
            for (int cb = 0; cb < 4; ++cb) { const bf16x8 b = *(const GAS bf16x8*)(bp + (size_t)cb * 16 * D + kk * 32); acc[cb] = __builtin_amdgcn_mfma_f32_16x16x32_bf16(a, b, acc[cb], 0, 0, 0); }
        }
#pragma unroll
        for (int cb = 0; cb < 4; ++cb)
#pragma unroll
            for (int r = 0; r < 4; ++r) PS[(size_t)(row0 + 4 * fq + r) * PSM + cb * 16 + fr] = acc[cb][r];
    }
}


constexpr int PQ = 136, PT = 72;
constexpr float QSCALE = 0.08838834764831845f;
__device__ __forceinline__ float silu_fast(float x) { return x / (1.0f + __expf(-x)); }
__device__ __forceinline__ v4u pack8(const float* y) { v4u o; o.x = pk2(y[0], y[1]); o.y = pk2(y[2], y[3]); o.z = pk2(y[4], y[5]); o.w = pk2(y[6], y[7]); return o; }
#define MFMA16(a, b, c) __builtin_amdgcn_mfma_f32_16x16x32_bf16((a), (b), (c), 0, 0, 0)

__device__ __forceinline__ void dn_conv16(const bf16* P, const float* cw, int tg, int t, int col, float (&y)[16]) {
#pragma unroll
    for (int c = 0; c < 16; ++c) y[c] = 0.f;
#pragma unroll
    for (int i = 0; i < 4; ++i) {
        const bool ok = (t - 3 + i >= 0); const float m = ok ? 1.f : 0.f;
        const bf16* src = P + (size_t)(ok ? tg - 3 + i : tg) * PN + PC_QKV + col;
        const v4u x0 = *(const GAS v4u*)src, x1 = *(const GAS v4u*)(src + 8);
        const float* w = cw + (size_t)i * DN_QKV + col;
        const f32x4 w0 = *(const GAS f32x4*)w * m, w1 = *(const GAS f32x4*)(w + 4) * m, w2 = *(const GAS f32x4*)(w + 8) * m, w3 = *(const GAS f32x4*)(w + 12) * m;
        y[0] += w0.x * bflo(x0.x); y[1] += w0.y * bfhi(x0.x); y[2] += w0.z * bflo(x0.y); y[3] += w0.w * bfhi(x0.y);
        y[4] += w1.x * bflo(x0.z); y[5] += w1.y * bfhi(x0.z); y[6] += w1.z * bflo(x0.w); y[7] += w1.w * bfhi(x0.w);
        y[8] += w2.x * bflo(x1.x); y[9] += w2.y * bfhi(x1.x); y[10] += w2.z * bflo(x1.y); y[11] += w2.w * bfhi(x1.y);
        y[12] += w3.x * bflo(x1.z); y[13] += w3.y * bfhi(x1.z); y[14] += w3.z * bflo(x1.w); y[15] += w3.w * bfhi(x1.w);
    }
#pragma unroll
    for (int c = 0; c < 16; ++c) y[c] = silu_fast(y[c]);
}

constexpr int LP_KN = 0, LP_QN = 17408, LP_KB = 34816, LP_KDT = 52224, LP_RHS = 0, LP_A = 70656, LP_BV = 87040, LP_BETA = 87296;
__device__ __forceinline__ void dn_prep_chunk(Frame& F, int ch) {
    const int tid = F.tid, lane = F.lane, wave = F.wave, fr = lane & 15, fq = lane >> 4;
    const int h = ch & 15, bn = ch >> 4, n = bn & 31, b = bn >> 5, tg0 = b * SEQ + n * 64;
    const size_t id = (size_t)((b * DN_H + h) * 32 + n);
    LAS unsigned char* L = F.lds + RING_OFF;
    LAS bf16* Kn = (LAS bf16*)(L + LP_KN); LAS bf16* Qn = (LAS bf16*)(L + LP_QN); LAS bf16* KB = (LAS bf16*)(L + LP_KB); LAS bf16* KDTl = (LAS bf16*)(L + LP_KDT);
    LAS float* RHS = (LAS float*)(L + LP_RHS); LAS float* Al = (LAS float*)(L + LP_A); LAS float* bv = (LAS float*)(L + LP_BV); LAS float* betav = (LAS float*)(L + LP_BETA);
    const bf16* PROJ = (const bf16*)(F.ws + WS_PROJ); const float* PS = (const float*)(F.ws + WS_PSMALL);
    bf16* DW = (bf16*)(F.ws + WS_DW) + id * 8192; bf16* DQE = (bf16*)(F.ws + WS_DQE) + id * 8192; bf16* DKT = (bf16*)(F.ws + WS_DKT) + id * 8192;
    bf16* DAT = (bf16*)(F.ws + WS_DAT) + id * 4096; float* DU = (float*)(F.ws + WS_DU) + id * 8192; float* DDL = (float*)(F.ws + WS_DDL);
    if (tid < 64) {
        const int tg = tg0 + tid;
        float g = -expf(F.in[I_DN_ALOG][h]) * softplus_f(PS[(size_t)tg * PSM + 16 + h] + F.in[I_DN_DTB][h]);
#pragma unroll
        for (int o = 1; o < 64; o <<= 1) { const float tt = __shfl_up(g, o); if (lane >= o) g += tt; }
        bv[tid] = g; betav[tid] = sigmoid_f(PS[(size_t)tg * PSM + h]);
    }
    const int row = tid >> 3, cg = tid & 7, t = n * 64 + row, tg = tg0 + row, c0 = 16 * cg;
    float q[16], k[16], v[16];
    dn_conv16(PROJ, F.in[I_DN_CONV], tg, t, h * 128 + c0, q); asm volatile("" ::: "memory");
    dn_conv16(PROJ, F.in[I_DN_CONV], tg, t, 2048 + h * 128 + c0, k); asm volatile("" ::: "memory");
    dn_conv16(PROJ, F.in[I_DN_CONV], tg, t, 4096 + h * 128 + c0, v);
    float sq = 0.f, sk = 0.f;
#pragma unroll
    for (int c = 0; c < 16; ++c) { sq += q[c] * q[c]; sk += k[c] * k[c]; }
    sq += __shfl_xor(sq, 1); sq += __shfl_xor(sq, 2); sq += __shfl_xor(sq, 4);
    sk += __shfl_xor(sk, 1); sk += __shfl_xor(sk, 2); sk += __shfl_xor(sk, 4);
    const float iq = QSCALE / sqrtf(sq + EPS), ik = 1.0f / sqrtf(sk + EPS);
#pragma unroll
    for (int c = 0; c < 16; ++c) { q[c] *= iq; k[c] *= ik; }
    __syncthreads();
    const float bt = bv[row], bl = bv[63], beta = betav[row], eb = __expf(bt), ekd = __expf(bl - bt);
    {
        float tmp[16];
        *(LAS v4u*)(Kn + row * PQ + c0) = pack8(k); *(LAS v4u*)(Kn + row * PQ + c0 + 8) = pack8(k + 8);
        *(LAS v4u*)(Qn + row * PQ + c0) = pack8(q); *(LAS v4u*)(Qn + row * PQ + c0 + 8) = pack8(q + 8);
#pragma unroll
        for (int c = 0; c < 16; ++c) tmp[c] = k[c] * beta;
        *(LAS v4u*)(KB + row * PQ + c0) = pack8(tmp); *(LAS v4u*)(KB + row * PQ + c0 + 8) = pack8(tmp + 8);
#pragma unroll
        for (int c = 0; c < 16; ++c) KDTl[(c0 + c) * PT + row] = (bf16)f2bf(k[c] * ekd);
#pragma unroll
        for (int c = 0; c < 16; ++c) tmp[c] = q[c] * eb;
        *(GAS v4u*)(DQE + row * 128 + c0) = pack8(tmp); *(GAS v4u*)(DQE + row * 128 + c0 + 8) = pack8(tmp + 8);
        if (tid == 0) DDL[id] = expf(bl);
    }
    __syncthreads();
    {
        const int rb = wave >> 1;
        f32x4 kk[2] = {{0.f, 0.f, 0.f, 0.f}, {0.f, 0.f, 0.f, 0.f}}, qk[2] = {{0.f, 0.f, 0.f, 0.f}, {0.f, 0.f, 0.f, 0.f}};
#pragma unroll
        for (int ks = 0; ks < 4; ++ks) {
            const bf16x8 a = *(const LAS bf16x8*)(Kn + (16 * rb + fr) * PQ + 32 * ks + 8 * fq);
#pragma unroll
            for (int c2 = 0; c2 < 2; ++c2) { const int cb = (wave & 1) * 2 + c2;
                const bf16x8 b1 = *(const LAS bf16x8*)(KB + (16 * cb + fr) * PQ + 32 * ks + 8 * fq);
                const bf16x8 b2 = *(const LAS bf16x8*)(Qn + (16 * cb + fr) * PQ + 32 * ks + 8 * fq);
                kk[c2] = MFMA16(a, b1, kk[c2]); qk[c2] = MFMA16(a, b2, qk[c2]); }
        }
#pragma unroll
        for (int c2 = 0; c2 < 2; ++c2) { const int cb = (wave & 1) * 2 + c2, i = 16 * cb + fr, j0 = 16 * rb + 4 * fq; const float bi = bv[i];
            f32x4 av; float at[4];
#pragma unroll
            for (int r = 0; r < 4; ++r) { const int j = j0 + r; const float dec = (i >= j) ? __expf(bi - bv[j]) : 0.f; av[r] = (i > j) ? kk[c2][r] * dec : 0.f; at[r] = (i >= j) ? qk[c2][r] * dec : 0.f; }
            *(LAS f32x4*)(Al + i * 64 + j0) = av;
            v2u w; w.x = pk2(at[0], at[1]); w.y = pk2(at[2], at[3]); *(GAS v2u*)(DAT + i * 64 + j0) = w; }
#pragma unroll
        for (int i = 0; i < 2; ++i) { const int id2 = tid + 512 * i, r = id2 >> 3, c = id2 & 7; *(GAS v4u*)(DKT + r * 64 + 8 * c) = *(const LAS v4u*)(KDTl + r * PT + 8 * c); }
    }
    __syncthreads();
    {
#pragma unroll
        for (int c = 0; c < 16; c += 4) {
            *(LAS f32x4*)(RHS + row * 256 + c0 + c) = (f32x4){k[c] * beta * eb, k[c + 1] * beta * eb, k[c + 2] * beta * eb, k[c + 3] * beta * eb};
            *(LAS f32x4*)(RHS + row * 256 + 128 + c0 + c) = (f32x4){v[c] * beta, v[c + 1] * beta, v[c + 2] * beta, v[c + 3] * beta}; }
    }
    __syncthreads();
    if (wave < 4) {
        const int c = 64 * wave + lane;
        float X[64];
#pragma unroll
        for (int i = 0; i < 64; ++i) {
            float x0 = RHS[i * 256 + c], x1 = 0.f, x2 = 0.f, x3 = 0.f;
#pragma unroll
            for (int j4 = 0; j4 < i; j4 += 4) {
                const f32x4 a = *(const LAS f32x4*)(Al + i * 64 + j4);
                x0 -= a.x * X[j4];
                if (j4 + 1 < i) x1 -= a.y * X[j4 + 1];
                if (j4 + 2 < i) x2 -= a.z * X[j4 + 2];
                if (j4 + 3 < i) x3 -= a.w * X[j4 + 3];
            }
            X[i] = (x0 + x1) + (x2 + x3);
            asm volatile("" ::: "memory");
        }
        if (wave < 2) {
#pragma unroll
            for (int i = 0; i < 64; ++i) DW[i * 128 + c] = (bf16)f2bf(-X[i]);
        } else {
#pragma unroll
            for (int i = 0; i < 64; ++i) DU[i * 128 + (c - 128)] = X[i];
        }
    }
    __syncthreads();
}

constexpr int LG_QE = 0, LG_KE = 17408, LG_VT = 34816, LG_LR = 71680, LG_TOT = 75776;
__device__ __forceinline__ void gla_prep_chunk(Frame& F, int ch) {
    const int tid = F.tid, lane = F.lane, wave = F.wave, fr = lane & 15, fq = lane >> 4;
    const int h = ch & 7, bn = ch >> 3, n = bn & 31, b = bn >> 5, tg0 = b * SEQ + n * 64;
    const size_t id = (size_t)((b * GL_H + h) * 32 + n);
    LAS unsigned char* L = F.lds + RING_OFF;
    LAS bf16* QEl = (LAS bf16*)(L + LG_QE); LAS bf16* KEl = (LAS bf16*)(L + LG_KE); LAS bf16* VTl = (LAS bf16*)(L + LG_VT);
    LAS float* lrl = (LAS float*)(L + LG_LR); LAS float* tot = (LAS float*)(L + LG_TOT);
    const bf16* PROJ = (const bf16*)(F.ws + WS_PROJ); const float* PS = (const float*)(F.ws + WS_PSMALL);
    bf16* GQE = (bf16*)(F.ws + WS_GQE) + id * 8192; bf16* GKT = (bf16*)(F.ws + WS_GKT) + id * 8192; bf16* GAT = (bf16*)(F.ws + WS_GAT) + id * 4096;
    bf16* GVT = (bf16*)(F.ws + WS_GVT) + id * 16384; float* GDL = (float*)(F.ws + WS_GDL) + id * 128;
#pragma unroll
    for (int i = 0; i < 2; ++i) { const int e = tid + 512 * i; lrl[e] = PS[(size_t)(tg0 + (e >> 4)) * PSM + 32 + (e & 15)]; }
#pragma unroll
    for (int i = 0; i < 4; ++i) { const int e = tid + 512 * i, r = e >> 5, c = e & 31; const v4u x = *(const GAS v4u*)(PROJ + (size_t)(tg0 + r) * PN + PC_GV + h * 256 + 8 * c);
        LAS bf16* d = VTl + (8 * c) * PT + r;
        d[0 * PT] = (bf16)(x.x & 0xffffu); d[1 * PT] = (bf16)(x.x >> 16); d[2 * PT] = (bf16)(x.y & 0xffffu); d[3 * PT] = (bf16)(x.y >> 16);
        d[4 * PT] = (bf16)(x.z & 0xffffu); d[5 * PT] = (bf16)(x.z >> 16); d[6 * PT] = (bf16)(x.w & 0xffffu); d[7 * PT] = (bf16)(x.w >> 16); }
    const int d = tid & 127, rg = tid >> 7, r0 = 16 * rg, col = h * 128 + d;
    float w2[16];
#pragma unroll
    for (int r = 0; r < 16; ++r) w2[r] = F.in[I_GL_WA2][(size_t)r * GL_KEY + col];
    const float ba = F.in[I_GL_BA][col];
    float qv[16], kv[16];
#pragma unroll
    for (int i = 0; i < 16; ++i) { const size_t o = (size_t)(tg0 + r0 + i) * PN + h * 128 + d; qv[i] = bf1(PROJ[o + PC_GQ]) * QSCALE; kv[i] = bf1(PROJ[o + PC_GK]); }
    __syncthreads();
    float cs[16]; float run = 0.f;
#pragma unroll
    for (int i = 0; i < 16; ++i) { float x = ba;
#pragma unroll
        for (int r = 0; r < 16; r += 4) { const f32x4 l4 = *(const LAS f32x4*)(lrl + (r0 + i) * 16 + r); x += l4.x * w2[r] + l4.y * w2[r + 1] + l4.z * w2[r + 2] + l4.w * w2[r + 3]; }
        run += (fminf(x, 0.f) - __logf(1.0f + __expf(-fabsf(x)))) * (1.f / 16.f); cs[i] = run; }
    tot[rg * 128 + d] = run;
    __syncthreads();
    float off = 0.f, bl = 0.f;
#pragma unroll
    for (int g = 0; g < 4; ++g) { const float tg_ = tot[g * 128 + d]; if (g < rg) off += tg_; bl += tg_; }
    {
        float kd[16];
#pragma unroll
        for (int i = 0; i < 16; ++i) { const float bb = off + cs[i]; QEl[(r0 + i) * PQ + d] = (bf16)f2bf(qv[i] * __expf(bb)); KEl[(r0 + i) * PQ + d] = (bf16)f2bf(kv[i] * __expf(-bb)); kd[i] = kv[i] * __expf(bl - bb); }
        *(GAS v4u*)(GKT + d * 64 + r0) = pack8(kd); *(GAS v4u*)(GKT + d * 64 + r0 + 8) = pack8(kd + 8);
        if (rg == 0) GDL[d] = expf(bl);
    }
    __syncthreads();
    {
        const int rb = wave >> 1;
        f32x4 qk[2] = {{0.f, 0.f, 0.f, 0.f}, {0.f, 0.f, 0.f, 0.f}};
#pragma unroll
        for (int ks = 0; ks < 4; ++ks) {
            const bf16x8 a = *(const LAS bf16x8*)(KEl + (16 * rb + fr) * PQ + 32 * ks + 8 * fq);
#pragma unroll
            for (int c2 = 0; c2 < 2; ++c2) { const int cb = (wave & 1) * 2 + c2; const bf16x8 b2 = *(const LAS bf16x8*)(QEl + (16 * cb + fr) * PQ + 32 * ks + 8 * fq); qk[c2] = MFMA16(a, b2, qk[c2]); }
        }
#pragma unroll
        for (int c2 = 0; c2 < 2; ++c2) { const int cb = (wave & 1) * 2 + c2, i = 16 * cb + fr, j0 = 16 * rb + 4 * fq; float at[4];
#pragma unroll
            for (int r = 0; r < 4; ++r) at[r] = (i >= j0 + r) ? qk[c2][r] : 0.f;
            v2u w; w.x = pk2(at[0], at[1]); w.y = pk2(at[2], at[3]); *(GAS v2u*)(GAT + i * 64 + j0) = w; }
#pragma unroll
        for (int i = 0; i < 2; ++i) { const int e = tid + 512 * i, r = e >> 4, c = e & 15; *(GAS v4u*)(GQE + r * 128 + 8 * c) = *(const LAS v4u*)(QEl + r * PQ + 8 * c); }
#pragma unroll
        for (int i = 0; i < 4; ++i) { const int e = tid + 512 * i, r = e >> 3, c = e & 7; *(GAS v4u*)(GVT + r * 64 + 8 * c) = *(const LAS v4u*)(VTl + r * PT + 8 * c); }
    }
    __syncthreads();
}

constexpr int LS_W = 0, LS_QE = 17408, LS_KDT = 34816, LS_ATT = 53248, LS_VN = 62464, LS_ST0 = 71680, LS_ST1 = 89088, LS_END = 106496;
template <bool DN> __device__ __forceinline__ void scan_task(Frame& F, int bh, int part) {
    constexpr int H = DN ? DN_H : GL_H, DV = DN ? DN_DV : GL_DV;
    const int tid = F.tid, lane = F.lane, wave = F.wave, fr = lane & 15, fq = lane >> 4;
    const int b = bh / H, h = bh % H, dv0 = 64 * part;
    LAS unsigned char* L = F.lds + RING_OFF;
    LAS bf16* Wl = (LAS bf16*)(L + LS_W); LAS bf16* QEl = (LAS bf16*)(L + LS_QE); LAS bf16* KDTl = (LAS bf16*)(L + LS_KDT); LAS bf16* ATTl = (LAS bf16*)(L + LS_ATT);
    LAS bf16* VNt = (LAS bf16*)(L + LS_VN);
    const bf16* gW = (const bf16*)(F.ws + WS_DW) + (size_t)bh * 32 * 8192;
    const bf16* gQE = (const bf16*)(F.ws + (DN ? WS_DQE : WS_GQE)) + (size_t)bh * 32 * 8192;
    const bf16* gKT = (const bf16*)(F.ws + (DN ? WS_DKT : WS_GKT)) + (size_t)bh * 32 * 8192;
    const bf16* gAT = (const bf16*)(F.ws + (DN ? WS_DAT : WS_GAT)) + (size_t)bh * 32 * 4096;
    const float* gU = (const float*)(F.ws + WS_DU) + (size_t)bh * 32 * 8192;
    const bf16* gVT = (const bf16*)(F.ws + WS_GVT) + (size_t)bh * 32 * 16384 + (size_t)dv0 * 64;
    const float* gDL = DN ? (const float*)(F.ws + WS_DDL) + (size_t)bh * 32 : (const float*)(F.ws + WS_GDL) + (size_t)bh * 32 * 128;
    float* gO = (float*)(F.ws + (DN ? WS_ODN : WS_OGLA)) + (size_t)(b * SEQ) * 2048 + h * DV + dv0;
    for (int e = tid; e < 17408 / 4; e += NWAVES * 64) ((LAS unsigned*)(L + LS_ST0))[e] = 0u;
    f32x4 Sacc[4] = {{0.f, 0.f, 0.f, 0.f}, {0.f, 0.f, 0.f, 0.f}, {0.f, 0.f, 0.f, 0.f}, {0.f, 0.f, 0.f, 0.f}};
    const int rw0 = tid >> 4, cw0 = tid & 15;
    const int rk0 = tid >> 3, ck0 = tid & 7;
    const int rb = wave >> 1, cbw = (wave & 1) * 2;
    v4u sW[2], sQ[2], sK[2], sA, sV; f32x4 sDL; float sdl = 0.f; float uN[2][4];
    sW[0] = sW[1] = sQ[0] = sQ[1] = sK[0] = sK[1] = sA = sV = (v4u){0u, 0u, 0u, 0u}; sDL = (f32x4){0.f, 0.f, 0.f, 0.f};
#define SCAN_LOAD(n_) do { const size_t o8 = (size_t)(n_) * 8192, o4 = (size_t)(n_) * 4096; \
        if (DN) { sW[0] = *(const GAS v4u*)(gW + o8 + tid * 8); sW[1] = *(const GAS v4u*)(gW + o8 + 4096 + tid * 8); } \
        sQ[0] = *(const GAS v4u*)(gQE + o8 + tid * 8); sQ[1] = *(const GAS v4u*)(gQE + o8 + 4096 + tid * 8); \
        sK[0] = *(const GAS v4u*)(gKT + o8 + tid * 8); sK[1] = *(const GAS v4u*)(gKT + o8 + 4096 + tid * 8); \
        sA = *(const GAS v4u*)(gAT + o4 + tid * 8); \
        if (DN) { sdl = gDL[(n_)]; _Pragma("unroll") for (int c2 = 0; c2 < 2; ++c2) _Pragma("unroll") for (int r = 0; r < 4; ++r) uN[c2][r] = gU[o8 + (16 * rb + 4 * fq + r) * 128 + dv0 + 16 * (cbw + c2) + fr]; } \
        else { sV = *(const GAS v4u*)(gVT + (size_t)(n_) * 16384 + tid * 8); sDL = *(const GAS f32x4*)(gDL + (n_) * 128 + 16 * wave + 4 * fq); } } while (0)
#define SCAN_STORE() do { \
        if (DN) { *(LAS v4u*)(Wl + rw0 * PQ + 8 * cw0) = sW[0]; *(LAS v4u*)(Wl + (rw0 + 32) * PQ + 8 * cw0) = sW[1]; } \
        *(LAS v4u*)(QEl + rw0 * PQ + 8 * cw0) = sQ[0]; *(LAS v4u*)(QEl + (rw0 + 32) * PQ + 8 * cw0) = sQ[1]; \
        *(LAS v4u*)(KDTl + rk0 * PT + 8 * ck0) = sK[0]; *(LAS v4u*)(KDTl + (rk0 + 64) * PT + 8 * ck0) = sK[1]; \
        *(LAS v4u*)(ATTl + rk0 * PT + 8 * ck0) = sA; \
        if (!DN) *(LAS v4u*)(VNt + rk0 * PT + 8 * ck0) = sV; } while (0)
    SCAN_LOAD(0);
    SCAN_STORE();
    float uC[2][4]; float dlC = sdl; f32x4 dlV = sDL;
#pragma unroll
    for (int c2 = 0; c2 < 2; ++c2)
#pragma unroll
        for (int r = 0; r < 4; ++r) uC[c2][r] = DN ? uN[c2][r] : 0.f;
    __syncthreads();
    for (int n = 0; n < 32; ++n) {
        LAS bf16* Sc = (LAS bf16*)(L + ((n & 1) ? LS_ST1 : LS_ST0)); LAS bf16* Sn = (LAS bf16*)(L + ((n & 1) ? LS_ST0 : LS_ST1));
        if (n + 1 < 32) SCAN_LOAD(n + 1);
        if (DN) {
            f32x4 va[2];
#pragma unroll
            for (int c2 = 0; c2 < 2; ++c2) va[c2] = (f32x4){uC[c2][0], uC[c2][1], uC[c2][2], uC[c2][3]};
#pragma unroll
            for (int ks = 0; ks < 4; ++ks) { const bf16x8 a = *(const LAS bf16x8*)(Wl + (16 * rb + fr) * PQ + 32 * ks + 8 * fq);
#pragma unroll
                for (int c2 = 0; c2 < 2; ++c2) { const bf16x8 bb = *(const LAS bf16x8*)(Sc + (16 * (cbw + c2) + fr) * PQ + 32 * ks + 8 * fq); va[c2] = MFMA16(a, bb, va[c2]); } }
#pragma unroll
            for (int c2 = 0; c2 < 2; ++c2) { v2u w; w.x = pk2(va[c2][0], va[c2][1]); w.y = pk2(va[c2][2], va[c2][3]); *(LAS v2u*)(VNt + (16 * (cbw + c2) + fr) * PT + 16 * rb + 4 * fq) = w; }
            __syncthreads();
        }
        {
            f32x4 oa[2] = {{0.f, 0.f, 0.f, 0.f}, {0.f, 0.f, 0.f, 0.f}};
#pragma unroll
            for (int ks = 0; ks < 4; ++ks) { const bf16x8 a = *(const LAS bf16x8*)(QEl + (16 * rb + fr) * PQ + 32 * ks + 8 * fq);
#pragma unroll
                for (int c2 = 0; c2 < 2; ++c2) { const bf16x8 bb = *(const LAS bf16x8*)(Sc + (16 * (cbw + c2) + fr) * PQ + 32 * ks + 8 * fq); oa[c2] = MFMA16(a, bb, oa[c2]); } }
#pragma unroll
            for (int ks = 0; ks < 2; ++ks) { const bf16x8 a = *(const LAS bf16x8*)(ATTl + (16 * rb + fr) * PT + 32 * ks + 8 * fq);
#pragma unroll
                for (int c2 = 0; c2 < 2; ++c2) { const bf16x8 bb = *(const LAS bf16x8*)(VNt + (16 * (cbw + c2) + fr) * PT + 32 * ks + 8 * fq); oa[c2] = MFMA16(a, bb, oa[c2]); } }
#pragma unroll
            for (int c2 = 0; c2 < 2; ++c2)
#pragma unroll
                for (int r = 0; r < 4; ++r) gO[(size_t)(n * 64 + 16 * rb + 4 * fq + r) * 2048 + 16 * (cbw + c2) + fr] = oa[c2][r];
        }
        {
#pragma unroll
            for (int cb = 0; cb < 4; ++cb) { if (DN) Sacc[cb] *= dlC; else Sacc[cb] *= dlV; }
#pragma unroll
            for (int ks = 0; ks < 2; ++ks) { const bf16x8 a = *(const LAS bf16x8*)(KDTl + (16 * wave + fr) * PT + 32 * ks + 8 * fq);
#pragma unroll
                for (int cb = 0; cb < 4; ++cb) { const bf16x8 bb = *(const LAS bf16x8*)(VNt + (16 * cb + fr) * PT + 32 * ks + 8 * fq); Sacc[cb] = MFMA16(a, bb, Sacc[cb]); } }
#pragma unroll
            for (int cb = 0; cb < 4; ++cb) { v2u w; w.x = pk2(Sacc[cb][0], Sacc[cb][1]); w.y = pk2(Sacc[cb][2], Sacc[cb][3]); *(LAS v2u*)(Sn + (16 * cb + fr) * PQ + 16 * wave + 4 * fq) = w; }
        }
        __syncthreads();
        if (n + 1 < 32) { SCAN_STORE(); dlC = sdl; dlV = sDL;
#pragma unroll
            for (int c2 = 0; c2 < 2; ++c2)
#pragma unroll
                for (int r = 0; r < 4; ++r) uC[c2][r] = DN ? uN[c2][r] : 0.f; }
        __syncthreads();
    }
#undef SCAN_LOAD
#undef SCAN_STORE
}

#ifndef CHUNK_DN
#define CHUNK_DN 1
#endif
#ifndef CHUNK_GLA
#define CHUNK_GLA 1
#endif
__device__ __forceinline__ void p2_prep(Frame& F) {
    const int gw = F.vcu * NWAVES + F.wave, NGW = F.G * NWAVES, lane = F.lane;
    const bf16* PROJ = (const bf16*)(F.ws + WS_PROJ); const float* PS = (const float*)(F.ws + WS_PSMALL);
    float* QF = (float*)(F.ws + WS_QF); float* KF = (float*)(F.ws + WS_KF); float* VF = (float*)(F.ws + WS_VF);
    float* EK = (float*)(F.ws + WS_EK); float* BETA = (float*)(F.ws + WS_BETA); float* GD = (float*)(F.ws + WS_G);
    const float* cw = F.in[I_DN_CONV];
#if !CHUNK_DN
    for (int id = gw; id < M * DN_H; id += NGW) {
        const int tg = id >> 4, h = id & 15, t = tg & (SEQ - 1), d0 = 2 * lane;
        float res[3][2];
#pragma unroll
        for (int p = 0; p < 3; ++p) { const int col = p * 2048 + h * 128 + d0; float y0 = 0.f, y1 = 0.f;
#pragma unroll
            for (int i = 0; i < 4; ++i) { const int tt = t - 3 + i; if (tt >= 0) { const unsigned xw = *(const GAS unsigned*)(PROJ + (size_t)(tg - 3 + i) * PN + PC_QKV + col);
                    const f32x2 w = *(const GAS f32x2*)(cw + (size_t)i * DN_QKV + col); y0 += w.x * bflo(xw); y1 += w.y * bfhi(xw); } }
            res[p][0] = silu_f(y0); res[p][1] = silu_f(y1); }
        const float sq = wave_sum(res[0][0] * res[0][0] + res[0][1] * res[0][1]), sk = wave_sum(res[1][0] * res[1][0] + res[1][1] * res[1][1]);
        const float iq = (1.0f / sqrtf(sq + EPS)) * 0.08838834764831845f, ik = 1.0f / sqrtf(sk + EPS);
        const size_t o = (size_t)tg * DN_KEY + h * 128 + d0;
        *(GAS f32x2*)(QF + o) = (f32x2){res[0][0] * iq, res[0][1] * iq}; *(GAS f32x2*)(KF + o) = (f32x2){res[1][0] * ik, res[1][1] * ik}; *(GAS f32x2*)(VF + o) = (f32x2){res[2][0], res[2][1]};
        if (lane == 0) { BETA[id] = sigmoid_f(PS[(size_t)tg * PSM + h]); GD[id] = -expf(F.in[I_DN_ALOG][h]) * softplus_f(PS[(size_t)tg * PSM + 16 + h] + F.in[I_DN_DTB][h]); }
    }
#else
    for (int ch = F.vcu; ch < BATCH * 32 * DN_H; ch += F.G) dn_prep_chunk(F, ch);
#endif
#if !CHUNK_GLA
    const float* wa2 = F.in[I_GL_WA2]; const float* ba = F.in[I_GL_BA];
    for (int id = gw; id < M * GL_H; id += NGW) {
        const int tg = id >> 3, h = id & 7, c = h * 128 + 2 * lane;
        f32x2 x = *(const GAS f32x2*)(ba + c);
#pragma unroll
        for (int r = 0; r < GL_RANK; ++r) { const float lr = PS[(size_t)tg * PSM + 32 + r]; const f32x2 w = *(const GAS f32x2*)(wa2 + (size_t)r * GL_KEY + c); x.x += lr * w.x; x.y += lr * w.y; }
        *(GAS f32x2*)(EK + (size_t)tg * GL_KEY + c) = (f32x2){expf(logsigmoid_f(x.x) * (1.f / 16.f)), expf(logsigmoid_f(x.y) * (1.f / 16.f))};
    }
#else
    for (int ch = F.vcu; ch < BATCH * 32 * GL_H; ch += F.G) gla_prep_chunk(F, ch);
#endif
}

__device__ __forceinline__ void p3_scan_naive(Frame& F, const int wg) {
    LAS float* sh = (LAS float*)(F.lds + RING_OFF);
    const int tid = F.tid;
    if (wg < 32) {
        const int sub = tid >> 8, tt = tid & 255, e = tt >> 1, half = tt & 1, bh = wg * 2 + sub, b = bh >> 4, h = bh & 15;
        const float* QF = (const float*)(F.ws + WS_QF); const float* KF = (const float*)(F.ws + WS_KF); const float* VF = (const float*)(F.ws + WS_VF);
        const float* BETA = (const float*)(F.ws + WS_BETA); const float* GD = (const float*)(F.ws + WS_G); float* ODN = (float*)(F.ws + WS_ODN);
        float S[64];
#pragma unroll
        for (int d = 0; d < 64; ++d) S[d] = 0.f;
        const float* KQ = (tt < 128) ? KF : QF;
        size_t o = (size_t)(b * SEQ) * DN_KEY + h * 128; int gi = (b * SEQ) * DN_H + h;
        float kqr = KQ[o + (tt & 127)], vr = VF[o + e], be = BETA[gi], gg = GD[gi];
        for (int t = 0; t < SEQ; ++t) {
            LAS float* kq = sh + ((t & 1) * 2 + sub) * 256;
            kq[tt] = kqr; const float v = vr, beta = be, decay = expf(gg); const size_t oc = o;
            if (t + 1 < SEQ) { o += DN_KEY; gi += DN_H; kqr = KQ[o + (tt & 127)]; vr = VF[o + e]; be = BETA[gi]; gg = GD[gi]; }
            __syncthreads();
            const LAS float* kp = kq + 64 * half; const LAS float* qp = kq + 128 + 64 * half;
            float ks0 = 0.f, ks1 = 0.f, ks2 = 0.f, ks3 = 0.f;
#pragma unroll
            for (int d = 0; d < 64; d += 4) { const f32x4 k4 = *(const LAS f32x4*)(kp + d); ks0 += k4.x * S[d]; ks1 += k4.y * S[d + 1]; ks2 += k4.z * S[d + 2]; ks3 += k4.w * S[d + 3]; }
            float ks = (ks0 + ks1) + (ks2 + ks3); ks += __shfl_xor(ks, 1);
            const float delta = beta * (v - decay * ks);
            float o0 = 0.f, o1 = 0.f, o2 = 0.f, o3 = 0.f;
#pragma unroll
            for (int d = 0; d < 64; d += 4) { const f32x4 k4 = *(const LAS f32x4*)(kp + d); const f32x4 q4 = *(const LAS f32x4*)(qp + d);
                S[d] = k4.x * delta + decay * S[d]; S[d + 1] = k4.y * delta + decay * S[d + 1]; S[d + 2] = k4.z * delta + decay * S[d + 2]; S[d + 3] = k4.w * delta + decay * S[d + 3];
                o0 += q4.x * S[d]; o1 += q4.y * S[d + 1]; o2 += q4.z * S[d + 2]; o3 += q4.w * S[d + 3]; }
            float ov = (o0 + o1) + (o2 + o3); ov += __shfl_xor(ov, 1);
            if (half == 0) ODN[oc + e] = ov;
        }
    } else if (wg < 64) {
        const int e = tid >> 1, half = tid & 1, bh = wg - 32, b = bh >> 3, h = bh & 7;
        const bf16* PROJ = (const bf16*)(F.ws + WS_PROJ); const float* EK = (const float*)(F.ws + WS_EK); float* OGLA = (float*)(F.ws + WS_OGLA);
        float S[64];
#pragma unroll
        for (int d = 0; d < 64; ++d) S[d] = 0.f;
        const int ee = tid & 127, role = tid >> 7;
        size_t tg = (size_t)b * SEQ;
        float a0 = (role == 0) ? EK[tg * GL_KEY + h * 128 + ee] : (role == 1) ? bf1(PROJ[tg * PN + PC_GK + h * 128 + ee]) : bf1(PROJ[tg * PN + PC_GQ + h * 128 + ee]) * 0.08838834764831845f;
        float vr = bf1(PROJ[tg * PN + PC_GV + h * 256 + e]);
        for (int t = 0; t < SEQ; ++t) {
            LAS float* buf = sh + (t & 1) * 384;
            if (role < 3) buf[tid] = a0;
            const float v = vr; const size_t tc = tg;
            if (t + 1 < SEQ) { ++tg; a0 = (role == 0) ? EK[tg * GL_KEY + h * 128 + ee] : (role == 1) ? bf1(PROJ[tg * PN + PC_GK + h * 128 + ee]) : bf1(PROJ[tg * PN + PC_GQ + h * 128 + ee]) * 0.08838834764831845f;
                vr = bf1(PROJ[tg * PN + PC_GV + h * 256 + e]); }
            __syncthreads();
            const LAS float* gp = buf + 64 * half;
            float o0 = 0.f, o1 = 0.f, o2 = 0.f, o3 = 0.f;
#pragma unroll
            for (int d = 0; d < 64; d += 4) { const f32x4 g4 = *(const LAS f32x4*)(gp + d); const f32x4 k4 = *(const LAS f32x4*)(gp + 128 + d); const f32x4 q4 = *(const LAS f32x4*)(gp + 256 + d);
                S[d] = g4.x * S[d] + k4.x * v; S[d + 1] = g4.y * S[d + 1] + k4.y * v; S[d + 2] = g4.z * S[d + 2] + k4.z * v; S[d + 3] = g4.w * S[d + 3] + k4.w * v;
                o0 += q4.x * S[d]; o1 += q4.y * S[d + 1]; o2 += q4.z * S[d + 2]; o3 += q4.w * S[d + 3]; }
            float ov = (o0 + o1) + (o2 + o3); ov += __shfl_xor(ov, 1);
            if (half == 0) OGLA[tc * GL_VAL + h * 256 + e] = ov;
        }
    }
}

__device__ __forceinline__ void p4_gated_norm(Frame& F) {
    const int gw = F.vcu * NWAVES + F.wave, NGW = F.G * NWAVES, lane = F.lane;
    const bf16* PROJ = (const bf16*)(F.ws + WS_PROJ); const float* ODN = (const float*)(F.ws + WS_ODN); const float* OGLA = (const float*)(F.ws + WS_OGLA);
    bf16* ONDN = (bf16*)(F.ws + WS_ONDN); bf16* ONGLA = (bf16*)(F.ws + WS_ONGLA);
    const f32x2 wd = *(const GAS f32x2*)(F.in[I_DN_NORM] + 2 * lane); const f32x4 wg = *(const GAS f32x4*)(F.in[I_GL_NORM] + 4 * lane);
    for (int tg = gw; tg < M; tg += NGW) {
        f32x2 v[16]; unsigned z[16]; f32x4 u[8]; v2u r[8];
#pragma unroll
        for (int h = 0; h < 16; ++h) { v[h] = *(const GAS f32x2*)(ODN + (size_t)tg * DN_VAL + h * 128 + 2 * lane); z[h] = *(const GAS unsigned*)(PROJ + (size_t)tg * PN + PC_Z + h * 128 + 2 * lane); }
#pragma unroll
        for (int h = 0; h < 8; ++h) { u[h] = *(const GAS f32x4*)(OGLA + (size_t)tg * GL_VAL + h * 256 + 4 * lane); r[h] = *(const GAS v2u*)(PROJ + (size_t)tg * PN + PC_GR + h * 256 + 4 * lane); }
#pragma unroll
        for (int h = 0; h < 16; ++h) { const float rstd = 1.0f / sqrtf(wave_sum(v[h].x * v[h].x + v[h].y * v[h].y) * (1.f / 128.f) + EPS);
            *(GAS unsigned*)(ONDN + (size_t)tg * DN_VAL + h * 128 + 2 * lane) = pk2(v[h].x * rstd * wd.x * silu_fast(bflo(z[h])), v[h].y * rstd * wd.y * silu_fast(bfhi(z[h]))); }
#pragma unroll
        for (int h = 0; h < 8; ++h) { const float rstd = 1.0f / sqrtf(wave_sum((u[h].x * u[h].x + u[h].y * u[h].y) + (u[h].z * u[h].z + u[h].w * u[h].w)) * (1.f / 256.f) + EPS);
            v2u ob; ob.x = pk2(u[h].x * rstd * wg.x * silu_fast(bflo(r[h].x)), u[h].y * rstd * wg.y * silu_fast(bfhi(r[h].x))); ob.y = pk2(u[h].z * rstd * wg.z * silu_fast(bflo(r[h].y)), u[h].w * rstd * wg.w * silu_fast(bfhi(r[h].y)));
            *(GAS v2u*)(ONGLA + (size_t)tg * GL_VAL + h * 256 + 4 * lane) = ob; }
    }
}

__device__ __forceinline__ void p9_glu_fixup(Frame& F) {
    bf16* HID = (bf16*)(F.ws + WS_HID); const float* GTAIL = (const float*)(F.ws + WS_GTAIL); const float* GHEAD = (const float*)(F.ws + WS_GHEAD); const float* UHEAD = (const float*)(F.ws + WS_UHEAD);
    const float* cw = F.in[I_FFN_CW]; const float* cb = F.in[I_FFN_CB];
    const int gt = F.vcu * (NWAVES * 64) + F.tid, NT = F.G * NWAVES * 64;
    constexpr int CG = DFF / 4;
    for (int id = gt; id < (M / 256) * 2 * CG; id += NT) {
        const int pm = id / (2 * CG), rr = (id / CG) & 1, c0 = 4 * (id % CG);
        const bool first = (pm & 7) == 0;
        const f32x4 z = (f32x4){0.f, 0.f, 0.f, 0.f};
        const f32x4 t0 = first ? z : *(const GAS f32x4*)(GTAIL + ((size_t)(first ? 0 : pm - 1) * 2 + 0) * DFF + c0), t1 = first ? z : *(const GAS f32x4*)(GTAIL + ((size_t)(first ? 0 : pm - 1) * 2 + 1) * DFF + c0);
        const f32x4 h0 = *(const GAS f32x4*)(GHEAD + ((size_t)pm * 2 + 0) * DFF + c0), h1 = *(const GAS f32x4*)(GHEAD + ((size_t)pm * 2 + 1) * DFF + c0);
        const f32x4 up = *(const GAS f32x4*)(UHEAD + ((size_t)pm * 2 + rr) * DFF + c0);
        const f32x4 w0 = *(const GAS f32x4*)(cw + c0), w1 = *(const GAS f32x4*)(cw + DFF + c0), w2 = *(const GAS f32x4*)(cw + 2 * DFF + c0), bb = *(const GAS f32x4*)(cb + c0);
        const f32x4 g2 = rr ? t1 : t0, g1 = rr ? h0 : t1, g0 = rr ? h1 : h0;
        const f32x4 y = bb + w0 * g2 + w1 * g1 + w2 * g0;
        v2u o; o.x = pk2(silu_fast(y.x) * up.x, silu_fast(y.y) * up.y); o.y = pk2(silu_fast(y.z) * up.z, silu_fast(y.w) * up.w);
        *(GAS v2u*)(HID + (size_t)(pm * 256 + rr) * DFF + c0) = o;
    }
}

#ifndef MK_ONE_LAUNCH
#define MK_ONE_LAUNCH 0
#endif
constexpr int N_PHASES = 12;
struct Args { const float* in[19]; float* out; unsigned char* ws; int ph_lo, ph_hi; };
__global__ void __launch_bounds__(NWAVES * 64, 2) mk_fwd(Args args) {
    extern __shared__ __attribute__((aligned(16))) unsigned char lds[];
    Frame F;
    F.lds = (LAS unsigned char*)lds;
    F.MISC = (volatile LAS unsigned*)(F.lds + MISC_OFF);
    F.tid = threadIdx.x; F.lane = F.tid & 63; F.wave = __builtin_amdgcn_readfirstlane(F.tid >> 6);
    F.G = gridDim.x; { const int bx = blockIdx.x; F.vcu = (F.G % 8 == 0) ? (bx % 8) * (F.G / 8) + bx / 8 : bx; }
    F.ws = args.ws; F.ctl = (gu32*)(args.ws + WS_CTL); F.out = args.out;
#pragma unroll
    for (int i = 0; i < 19; ++i) F.in[i] = args.in[i];
    for (int u = F.tid; u < (LDS_BYTES - LDSCTL_OFF) / 4; u += NWAVES * 64) ((LAS unsigned*)(F.lds + LDSCTL_OFF))[u] = 0u;
    __syncthreads();
    XcdBarrier bar; bar.bar = (unsigned*)(F.ctl + CW_BAR); bar.x = 0; bar.st = nullptr;
    if (MK_ONE_LAUNCH) bar = xcd_barrier_post((unsigned*)(F.ctl + CW_BAR), F.MISC + 8);
    const int lo = args.ph_lo, hi = args.ph_hi;
#define IN(k) (lo <= (k) && (k) < hi)
#define SEAM(k) do { if (IN(k) && IN((k) + 1)) xcd_barrier(bar); } while (0)
    bf16* H = (bf16*)(F.ws + WS_H); bf16* PROJ = (bf16*)(F.ws + WS_PROJ);

#ifndef PROBE_MASK
#define PROBE_MASK 0
#endif
#define RUN_PHASE(k, ...) do { if (IN(k)) { __VA_ARGS__ } if ((PROBE_MASK >> (k)) & 1) { if (IN(k)) { __VA_ARGS__ } } } while (0)
    RUN_PHASE(0, p0_prologue(F);); SEAM(0);
    RUN_PHASE(1,
        p1_skinny(F);
        pg8::Gemm g{H, (const bf16*)(F.ws + WS_WIN), M, PN, D}; pg8::StaticOrder S; S.init(M, PN, F.G, (int)blockIdx.x);
        pg8::Epi<pg8::EPI_BF16> E{PROJ, PN, nullptr, 0, nullptr, 0, nullptr, 0};
        pg8::gemm_phase<pg8::Epi<pg8::EPI_BF16>, pg8::StaticOrder, true, true>(F.lds + RING_OFF, g, S, E);
    ); SEAM(1);
    RUN_PHASE(2, p2_prep(F);); SEAM(2);
    RUN_PHASE(3,
        for (int task = F.vcu; task < 256; task += F.G) {
            if (task < 128) {
#if CHUNK_DN
                scan_task<true>(F, task >> 1, task & 1);
#else
                if (task < 32) p3_scan_naive(F, task);
#endif
            } else {
#if CHUNK_GLA
                scan_task<false>(F, (task - 128) >> 2, (task - 128) & 3);
#else
                if (task < 160) p3_scan_naive(F, task - 96);
#endif
            }
        }
    ); SEAM(3);
    RUN_PHASE(4, p4_gated_norm(F);); SEAM(4);
    RUN_PHASE(5,
        { pg8::Gemm g{(const bf16*)(F.ws + WS_ONDN), (const bf16*)(F.ws + WS_WBDN), M, D, DN_VAL}; pg8::StaticOrder S; S.init(M, D, F.G, (int)blockIdx.x);
          pg8::Epi<pg8::EPI_BRA> E{nullptr, 0, (float*)(F.ws + WS_TMP), D, nullptr, 0, PROJ + PC_GATE_DN, PN};
          pg8::gemm_phase<pg8::Epi<pg8::EPI_BRA>, pg8::StaticOrder, true, true>(F.lds + RING_OFF, g, S, E); }
        { pg8::Gemm g{(const bf16*)(F.ws + WS_ONGLA), (const bf16*)(F.ws + WS_WBGLA), M, D, GL_VAL}; pg8::StaticOrder S; S.init(M, D, F.G, (int)blockIdx.x);
          pg8::Epi<pg8::EPI_BRB> E{(bf16*)(F.ws + WS_MERGED), D, (float*)(F.ws + WS_TMP), D, nullptr, 0, PROJ + PC_GATE_GLA, PN};
          pg8::gemm_phase<pg8::Epi<pg8::EPI_BRB>, pg8::StaticOrder, true, true>(F.lds + RING_OFF, g, S, E); }
    ); SEAM(5);
    RUN_PHASE(6,
        pg8::Gemm g{(const bf16*)(F.ws + WS_MERGED), (const bf16*)(F.ws + WS_WOUT), M, D, D}; pg8::StaticOrder S; S.init(M, D, F.G, (int)blockIdx.x);
        pg8::Epi<pg8::EPI_RES> E{nullptr, 0, (float*)(F.ws + WS_X1), D, F.in[I_X], D, nullptr, 0};
        pg8::gemm_phase<pg8::Epi<pg8::EPI_RES>, pg8::StaticOrder, true, true>(F.lds + RING_OFF, g, S, E);
    ); SEAM(6);
    RUN_PHASE(7, { const int gw = F.vcu * NWAVES + F.wave; const int NGW = F.G * NWAVES; const float* X1 = (const float*)(F.ws + WS_X1);
        for (int m = gw; m < M; m += NGW) rms_row(X1 + (size_t)m * D, F.in[I_NORM_FFN], H + (size_t)m * D, nullptr, F.lane); }); SEAM(7);
    RUN_PHASE(8,
        pg8::Gemm g{H, (const bf16*)(F.ws + WS_WFIN), M, NGU, D}; pg8::StaticOrder S; S.init(M, NGU, F.G, (int)blockIdx.x);
        pg8::EpiGlu E{(bf16*)(F.ws + WS_HID), DFF, F.in[I_FFN_CW], F.in[I_FFN_CB], DFF, (float*)(F.ws + WS_GTAIL), (float*)(F.ws + WS_GHEAD), (float*)(F.ws + WS_UHEAD), (LAS float*)(F.lds + XL_OFF)};
        pg8::gemm_phase<pg8::EpiGlu, pg8::StaticOrder, true, true>(F.lds + RING_OFF, g, S, E);
    ); SEAM(8);
    RUN_PHASE(9, p9_glu_fixup(F);); SEAM(9);
    RUN_PHASE(10,
        pg8::Gemm g{(const bf16*)(F.ws + WS_HID), (const bf16*)(F.ws + WS_WFOUT), M, D, DFF}; pg8::StaticOrder S; S.init(M, D, F.G, (int)blockIdx.x);
        pg8::Epi<pg8::EPI_RES> E{nullptr, 0, F.out, D, (const float*)(F.ws + WS_X1), D, nullptr, 0};
        pg8::gemm_phase<pg8::Epi<pg8::EPI_RES>, pg8::StaticOrder, true, true>(F.lds + RING_OFF, g, S, E);
    ); SEAM(10);
    if (IN(11)) { const int gw = F.vcu * NWAVES + F.wave, NGW = F.G * NWAVES;
        for (int m = gw; m < M; m += NGW) rms_row(F.out + (size_t)m * D, F.in[I_NORM_FIN], nullptr, F.out + (size_t)m * D, F.lane); }
#undef IN
#undef SEAM
}

extern "C" void kernel_launch(void* const* d_in, const int* in_sizes, int n_in, void* d_out, int out_size, void* d_ws, size_t ws_size, hipStream_t stream) {
    static int grid = 0;
    if (grid == 0) {
        if (n_in != 19 || in_sizes[0] != M * D || out_size != M * D || ws_size < WS_END) { fprintf(stderr, "kernel_launch: unexpected shapes: n_in %d in0 %d out %d ws %zu (need %zu)\n", n_in, n_in > 0 ? in_sizes[0] : -1, out_size, ws_size, (size_t)WS_END); grid = -1; return; }
        int dev = 0, cus = 0, per_cu = 0;
        if (hipGetDevice(&dev) != hipSuccess || hipDeviceGetAttribute(&cus, hipDeviceAttributeMultiprocessorCount, dev) != hipSuccess) { grid = -1; return; }
        if (hipFuncSetAttribute((const void*)mk_fwd, hipFuncAttributeMaxDynamicSharedMemorySize, LDS_BYTES) != hipSuccess) { fprintf(stderr, "kernel_launch: hipFuncSetAttribute failed\n"); grid = -1; return; }
        if (hipOccupancyMaxActiveBlocksPerMultiprocessor(&per_cu, (const void*)mk_fwd, NWAVES * 64, LDS_BYTES) != hipSuccess || per_cu < 1) fprintf(stderr, "kernel_launch: occupancy query says %d\n", per_cu);
        (void)hipGetLastError();
        grid = cus;
    }
    if (grid < 0) return;
    if (hipMemsetAsync((char*)d_ws + WS_CTL, 0, CTL_ZERO_BYTES, stream) != hipSuccess) return;
    Args a{};
    for (int i = 0; i < 19; ++i) a.in[i] = (const float*)d_in[i];
    a.out = (float*)d_out; a.ws = (unsigned char*)d_ws;
#if MK_ONE_LAUNCH
    a.ph_lo = 0; a.ph_hi = N_PHASES;
    hipLaunchKernelGGL(mk_fwd, dim3(grid), dim3(NWAVES * 64), LDS_BYTES, stream, a);
#else
    for (int p = 0; p < N_PHASES; ++p) { a.ph_lo = p; a.ph_hi = p + 1; hipLaunchKernelGGL(mk_fwd, dim3(grid), dim3(NWAVES * 64), LDS_BYTES, stream, a); }
#endif
}
```

```cpp
#define MK_ONE_LAUNCH 1
#include <hip/hip_runtime.h>
#include <cstdio>
#include <cstdint>
namespace pg8 {
#define PG8_LAS __attribute__((address_space(3)))
typedef unsigned short bf16_t;
typedef short bf16x8 __attribute__((ext_vector_type(8)));
typedef float f32x4 __attribute__((ext_vector_type(4)));
typedef unsigned u32x4 __attribute__((ext_vector_type(4)));
constexpr int BM = 256, BK = 64, HALF = 128, HTB = HALF * BK * 2  , STAGE_BYTES = 8 * HTB, NXCD = 8, WGM = 8;

__host__ __device__ __forceinline__ int lds_byte(int r, int c) { const int st = (r >> 4) * 2 + (c >> 5), rr = r & 15, cc = c & 31, ob = rr * 64 + cc * 2; return st * 1024 + (ob ^ (((ob >> 9) & 1) << 5)); }
__host__ __device__ __forceinline__ void stage_rc(int b, int& R, int& C) { const int st = b / 1024, sb = b % 1024, swz = sb ^ (((sb >> 9) & 1) << 5); R = (st >> 1) * 16 + swz / 64; C = (st & 1) * 32 + (swz % 64) / 2; }
__host__ __device__ __forceinline__ int perm32(int rho) { const int n = rho >> 4, i = rho & 15; return 8 * (i >> 2) + 4 * n + (i & 3); }

struct Unit { int pm, pn; };
struct Gemm { const bf16_t* A; const bf16_t* Bt; int M, N, K; };

struct StaticOrder {
    int nM, nN, nwg, G, c;
    __host__ __device__ void init(int M, int N, int G_, int c_) { nM = M / BM; nN = N / BM; nwg = nM * nN; G = G_; c = c_; }
    __host__ __device__ bool next(int i, Unit& u) const {
        const long L = (long)i * G + c; if (L >= nwg) return false;
        int wgid = (int)L; { const int q = nwg / NXCD, r = nwg % NXCD, xcd = wgid % NXCD, off = wgid / NXCD; wgid = (xcd < r ? xcd * (q + 1) : r * (q + 1) + (xcd - r) * q) + off; }
        const int nig = WGM * nN, gid = wgid / nig, fm = gid * WGM, gsz = (nM - fm) < WGM ? (nM - fm) : WGM;
        u.pm = fm + ((wgid % nig) % gsz); u.pn = (wgid % nig) / gsz; return true;
    }
    __device__ __forceinline__ void a_ready(const Unit&) const {}
    __device__ __forceinline__ void done(const Unit&) const {}
};

__device__ __forceinline__ unsigned cvt_pk_bf16(float lo, float hi) { unsigned r; asm volatile("v_cvt_pk_bf16_f32 %0, %1, %2" : "=v"(r) : "v"(lo), "v"(hi)); return r; }
__device__ __forceinline__ float bf_lo(unsigned w) { return __uint_as_float(w << 16); }
__device__ __forceinline__ float bf_hi(unsigned w) { return __uint_as_float(w & 0xffff0000u); }
__device__ __forceinline__ float sigm(float x) { return __builtin_amdgcn_rcpf(1.0f + __expf(-x)); }
template <int N> __device__ __forceinline__ float dpp_shr(float old, float x) { return __int_as_float(__builtin_amdgcn_update_dpp(__float_as_int(old), __float_as_int(x), 0x110 + N, 0xf, 0xf, false)); }
template <int N> __device__ __forceinline__ float dpp_shl(float x) { return __int_as_float(__builtin_amdgcn_update_dpp(0, __float_as_int(x), 0x100 + N, 0xf, 0xf, true)); }
#define PG8_DPP_SHR(old, x, n) dpp_shr<n>((old), (x))
#define PG8_DPP_SHL(x, n) dpp_shl<n>((x))
enum { EPI_BF16 = 0, EPI_BRA = 1, EPI_BRB = 2, EPI_RES = 3 };
template <int MODE> struct Epi {
    static constexpr bool PERM = true, AFTER_DRAIN = false;
    bf16_t* Ob; int ldo; float* Of; int ldf; const float* R; int ldr; const bf16_t* Gt; int ldg;
    __device__ __forceinline__ void operator()(const f32x4 (&acc)[2][2][4][2], const Unit& u, int wr, int wc, int fr, int fq) const {
        const int row0 = u.pm * BM + wr * 64 + fr, col0 = u.pn * BM + wc * 32 + 8 * fq;
#pragma unroll
        for (int ai = 0; ai < 2; ++ai)
#pragma unroll
            for (int m = 0; m < 4; ++m) { const size_t row = (size_t)(row0 + ai * HALF + m * 16);
#pragma unroll
                for (int bj = 0; bj < 2; ++bj) { const int col = col0 + bj * HALF; f32x4 v0 = acc[ai][bj][m][0], v1 = acc[ai][bj][m][1];
                    if (MODE == EPI_BRA || MODE == EPI_BRB) { const u32x4 g = *(const u32x4*)(Gt + row * ldg + col);
                        v0[0] *= sigm(bf_lo(g.x)); v0[1] *= sigm(bf_hi(g.x)); v0[2] *= sigm(bf_lo(g.y)); v0[3] *= sigm(bf_hi(g.y));
                        v1[0] *= sigm(bf_lo(g.z)); v1[1] *= sigm(bf_hi(g.z)); v1[2] *= sigm(bf_lo(g.w)); v1[3] *= sigm(bf_hi(g.w)); }
                    if (MODE == EPI_BRB) { const float* t = Of + row * ldf + col; v0 += *(const f32x4*)t; v1 += *(const f32x4*)(t + 4); }
                    if (MODE == EPI_RES) { const float* t = R + row * ldr + col; v0 += *(const f32x4*)t; v1 += *(const f32x4*)(t + 4); }
                    if (MODE == EPI_BF16 || MODE == EPI_BRB) { u32x4 w; w.x = cvt_pk_bf16(v0[0], v0[1]); w.y = cvt_pk_bf16(v0[2], v0[3]); w.z = cvt_pk_bf16(v1[0], v1[1]); w.w = cvt_pk_bf16(v1[2], v1[3]);
                        *(u32x4*)(Ob + row * ldo + col) = w; }
                    else { float* o = Of + row * ldf + col; *(f32x4*)o = v0; *(f32x4*)(o + 4) = v1; } }
                asm volatile("" ::: "memory"); }
    }
};

struct EpiRes2 {
    static constexpr bool PERM = true, AFTER_DRAIN = false;
    float* X1; bf16_t* Xb; const float* R; int ld; unsigned long long* ssq;
    __device__ __forceinline__ void operator()(const f32x4 (&acc)[2][2][4][2], const Unit& u, int wr, int wc, int fr, int fq) const {
        const int row0 = u.pm * BM + wr * 64 + fr, col0 = u.pn * BM + wc * 32 + 8 * fq;
#pragma unroll
        for (int ai = 0; ai < 2; ++ai)
#pragma unroll
            for (int m = 0; m < 4; ++m) { const size_t row = (size_t)(row0 + ai * HALF + m * 16); float ss = 0.f;
#pragma unroll
                for (int bj = 0; bj < 2; ++bj) { const int col = col0 + bj * HALF; const float* t = R + row * ld + col;
                    const f32x4 v0 = acc[ai][bj][m][0] + *(const f32x4*)t, v1 = acc[ai][bj][m][1] + *(const f32x4*)(t + 4);
                    float* o = X1 + row * ld + col; *(f32x4*)o = v0; *(f32x4*)(o + 4) = v1;
                    u32x4 w; w.x = cvt_pk_bf16(v0[0], v0[1]); w.y = cvt_pk_bf16(v0[2], v0[3]); w.z = cvt_pk_bf16(v1[0], v1[1]); w.w = cvt_pk_bf16(v1[2], v1[3]);
                    *(u32x4*)(Xb + row * ld + col) = w;
                    ss += (v0[0] * v0[0] + v0[1] * v0[1]) + (v0[2] * v0[2] + v0[3] * v0[3]) + (v1[0] * v1[0] + v1[1] * v1[1]) + (v1[2] * v1[2] + v1[3] * v1[3]); }
                ss += __shfl_xor(ss, 16); ss += __shfl_xor(ss, 32);
                if (fq == 0) atomicAdd(ssq + row, (unsigned long long)(ss * 16777216.0f + 0.5f));
                asm volatile("" ::: "memory"); }
    }
};

struct EpiGlu {
    static constexpr bool PERM = true, AFTER_DRAIN = false;
    bf16_t* HID; int ldh; const float* cw; const float* cb; int nch; float* GTAIL; float* GHEAD; float* UHEAD; PG8_LAS float* xl; const unsigned long long* ssq;
    __device__ __forceinline__ void operator()(f32x4 (&acc)[2][2][4][2], const Unit& u, int wr, int wc, int fr, int fq) const {
        const int ch0 = u.pn * 128 + wc * 32 + 8 * fq;
#pragma unroll
        for (int ai = 0; ai < 2; ++ai)
#pragma unroll
            for (int m = 0; m < 4; ++m) { const float rs = 1.0f / sqrtf((float)ssq[u.pm * BM + ai * HALF + wr * 64 + m * 16 + fr] * (1.0f / (16777216.0f * 4096.0f)) + 1e-6f);
#pragma unroll
                for (int bj = 0; bj < 2; ++bj) { acc[ai][bj][m][0] *= rs; acc[ai][bj][m][1] *= rs; } }
        if (fr >= 14) {
#pragma unroll
            for (int ai = 0; ai < 2; ++ai) { PG8_LAS float* d = xl + ((wr * 4 + wc) * 2 + ai) * 64 + (fr - 14) * 32 + 8 * fq; *(PG8_LAS f32x4*)d = acc[ai][0][3][0]; *(PG8_LAS f32x4*)(d + 4) = acc[ai][0][3][1]; }
        }
        asm volatile("s_waitcnt lgkmcnt(0)" ::: "memory"); __builtin_amdgcn_s_barrier(); asm volatile("" ::: "memory");
        f32x4 w[3][2], bb[2];
#pragma unroll
        for (int k = 0; k < 3; ++k) { w[k][0] = *(const f32x4*)(cw + (size_t)k * nch + ch0); w[k][1] = *(const f32x4*)(cw + (size_t)k * nch + ch0 + 4); }
        bb[0] = *(const f32x4*)(cb + ch0); bb[1] = *(const f32x4*)(cb + ch0 + 4);
#pragma unroll
        for (int ai = 0; ai < 2; ++ai) {
            f32x4 p1[2], p2[2];
            { f32x4 t0 = (f32x4){0.f, 0.f, 0.f, 0.f}, t1 = t0;
              if (!(ai == 0 && wr == 0)) { const int pwr = wr ^ 1, pai = (wr == 1) ? ai : ai - 1; const PG8_LAS float* sp = xl + ((pwr * 4 + wc) * 2 + pai) * 64 + (fr & 1) * 32 + 8 * fq; t0 = *(const PG8_LAS f32x4*)sp; t1 = *(const PG8_LAS f32x4*)(sp + 4); }
#pragma unroll
              for (int j = 0; j < 4; ++j) { p1[0][j] = PG8_DPP_SHL(t0[j], 15); p1[1][j] = PG8_DPP_SHL(t1[j], 15); p2[0][j] = PG8_DPP_SHL(t0[j], 14); p2[1][j] = PG8_DPP_SHL(t1[j], 14); } }
#pragma unroll
            for (int m = 0; m < 4; ++m) {
                const size_t row = (size_t)(u.pm * BM + ai * HALF + wr * 64 + m * 16 + fr);
                f32x4 hv[2];
#pragma unroll
                for (int n = 0; n < 2; ++n)
#pragma unroll
                    for (int j = 0; j < 4; ++j) { const float g = acc[ai][0][m][n][j];
                        const float g1 = PG8_DPP_SHR(p1[n][j], g, 1), g2 = PG8_DPP_SHR(p2[n][j], g, 2);
                        p1[n][j] = PG8_DPP_SHL(g, 15); p2[n][j] = PG8_DPP_SHL(g, 14);
                        const float y = bb[n][j] + w[0][n][j] * g2 + w[1][n][j] * g1 + w[2][n][j] * g;
                        hv[n][j] = y * __builtin_amdgcn_rcpf(1.0f + __expf(-y)) * acc[ai][1][m][n][j]; }
                u32x4 o; o.x = cvt_pk_bf16(hv[0][0], hv[0][1]); o.y = cvt_pk_bf16(hv[0][2], hv[0][3]); o.z = cvt_pk_bf16(hv[1][0], hv[1][1]); o.w = cvt_pk_bf16(hv[1][2], hv[1][3]);
                *(u32x4*)(HID + row * ldh + ch0) = o;
            }
        }
        if (wr == 0 && fr < 2) { float* g = GHEAD + ((size_t)u.pm * 2 + fr) * nch + ch0; float* q = UHEAD + ((size_t)u.pm * 2 + fr) * nch + ch0;
            *(f32x4*)g = acc[0][0][0][0]; *(f32x4*)(g + 4) = acc[0][0][0][1]; *(f32x4*)q = acc[0][1][0][0]; *(f32x4*)(q + 4) = acc[0][1][0][1]; }
        if (wr == 1 && fr >= 14) { float* g = GTAIL + ((size_t)u.pm * 2 + (fr - 14)) * nch + ch0; *(f32x4*)g = acc[1][0][3][0]; *(f32x4*)(g + 4) = acc[1][0][3][1]; }
    }
};

template <class Epi, class Sched, bool ALIGN_EPI = false, bool SP2 = false>
__device__ __forceinline__ void gemm_phase(PG8_LAS unsigned char* lds, const Gemm g, const Sched& S, const Epi& E) {
    const int tid = threadIdx.x, wid = __builtin_amdgcn_readfirstlane(tid >> 6), lane = tid & 63, wr = wid >> 2, wc = wid & 3, fr = lane & 15, fq = lane >> 4;
    const int K = g.K, nt = K / BK;
    unsigned voffA[2], voffB[2];
#pragma unroll
    for (int i = 0; i < 2; ++i) { int R, C; stage_rc(tid * 16 + i * 8192, R, C); const int Rb = Epi::PERM ? ((R & ~31) + perm32(R & 31)) : R;
        voffA[i] = (unsigned)(R * K + C) * 2u; voffB[i] = (unsigned)(Rb * K + C) * 2u; }
    const size_t kstep = (size_t)(BK * 2);
    const size_t hstep = (size_t)HALF * K * 2;
    const size_t tstep = 2 * hstep;
    const unsigned ldsw = (unsigned)wid * 1024u;
    const int aoff = lds_byte(wr * 64 + fr, fq * 8), boff = lds_byte(wc * 32 + fr, fq * 8);
#define PG8_SA(b, h) (((b) * 2 + (h)) * HTB)
#define PG8_SB(b, h) ((4 + (b) * 2 + (h)) * HTB)
#define PG8_STAGE(bufoff, gbase, voff) do { _Pragma("unroll") for (int _i = 0; _i < 2; ++_i) \
        __builtin_amdgcn_global_load_lds((const unsigned*)((const char*)(gbase) + (voff)[_i]), (PG8_LAS unsigned*)(lds + (bufoff) + ldsw + _i * 8192), 16, 0, 0); } while (0)
#define PG8_LDA(dst, b, h) do { _Pragma("unroll") for (int m = 0; m < 4; ++m) _Pragma("unroll") for (int k = 0; k < 2; ++k) dst[m][k] = *(const PG8_LAS bf16x8*)(lds + PG8_SA(b, h) + aoff + m * 2048 + k * 1024); } while (0)
#define PG8_LDB(dst, b, h) do { _Pragma("unroll") for (int n = 0; n < 2; ++n) _Pragma("unroll") for (int k = 0; k < 2; ++k) dst[n][k] = *(const PG8_LAS bf16x8*)(lds + PG8_SB(b, h) + boff + n * 2048 + k * 1024); } while (0)
#define PG8_MMA(ai, bj, At, Bt) do { __builtin_amdgcn_s_setprio(1); _Pragma("unroll") for (int m = 0; m < 4; ++m) _Pragma("unroll") for (int n = 0; n < 2; ++n) _Pragma("unroll") for (int k = 0; k < 2; ++k) \
        acc[ai][bj][m][n] = __builtin_amdgcn_mfma_f32_16x16x32_bf16(Bt[n][k], At[m][k], acc[ai][bj][m][n], 0, 0, 0); __builtin_amdgcn_s_setprio(0); } while (0)
#define PG8_WAIT_V(n) asm volatile("s_waitcnt vmcnt(" #n ")" ::: "memory")
#define PG8_WAIT_L(n) asm volatile("s_waitcnt lgkmcnt(" #n ")" ::: "memory")
#define PG8_BAR __builtin_amdgcn_s_barrier()
#define PG8_SCHED __builtin_amdgcn_sched_barrier(0)
    Unit cur, nxt; int ui = 0;
    if (!S.next(0, cur)) return;
    f32x4 acc[2][2][4][2];
#pragma unroll
    for (int a = 0; a < 2; ++a)
#pragma unroll
        for (int b = 0; b < 2; ++b)
#pragma unroll
            for (int m = 0; m < 4; ++m)
#pragma unroll
                for (int n = 0; n < 2; ++n) acc[a][b][m][n] = (f32x4){0.f, 0.f, 0.f, 0.f};
    bf16x8 At[4][2], B0[2][2], B1[2][2];
    const char* cA = (const char*)g.A + (size_t)cur.pm * tstep; const char* cB = (const char*)g.Bt + (size_t)cur.pn * tstep;
    S.a_ready(cur);
    if constexpr (SP2) {
        PG8_STAGE(PG8_SB(0, 0), cB, voffB); PG8_STAGE(PG8_SB(0, 1), cB + hstep, voffB); PG8_STAGE(PG8_SA(0, 0), cA, voffA); PG8_STAGE(PG8_SA(0, 1), cA + hstep, voffA);
        if (wr == 1) PG8_BAR;
        PG8_WAIT_V(2); PG8_BAR;
        PG8_STAGE(PG8_SB(1, 0), cB + kstep, voffB); PG8_STAGE(PG8_SA(1, 0), cA + kstep, voffA); PG8_STAGE(PG8_SB(1, 1), cB + hstep + kstep, voffB);
        PG8_WAIT_V(6); PG8_BAR;
    } else {
        PG8_STAGE(PG8_SB(0, 0), cB, voffB); PG8_STAGE(PG8_SA(0, 0), cA, voffA); PG8_STAGE(PG8_SB(0, 1), cB + hstep, voffB); PG8_STAGE(PG8_SA(0, 1), cA + hstep, voffA);
        if (wr == 1) PG8_BAR;
        PG8_WAIT_V(4); PG8_BAR;
        PG8_STAGE(PG8_SB(1, 0), cB + kstep, voffB); PG8_STAGE(PG8_SA(1, 0), cA + kstep, voffA); PG8_STAGE(PG8_SB(1, 1), cB + hstep + kstep, voffB);
        PG8_WAIT_V(6); PG8_BAR;
    }
    for (;;) {
        const bool has_next = S.next(ui + 1, nxt);
        const char* nA = has_next ? (const char*)g.A + (size_t)nxt.pm * tstep : cA; const char* nB = has_next ? (const char*)g.Bt + (size_t)nxt.pn * tstep : cB;
        for (int t = 0; t < nt; t += 2) {
            const bool last = (t == nt - 2);
            const char* a1 = cA + (size_t)(t + 1) * kstep;
            const char* a2 = last ? nA : cA + (size_t)(t + 2) * kstep; const char* b2 = last ? nB : cB + (size_t)(t + 2) * kstep;
            const char* a3 = a2 + kstep; const char* b3 = b2 + kstep;
            if (last && has_next) S.a_ready(nxt);
            if constexpr (SP2) {
            PG8_LDB(B0, 0, 0); PG8_LDB(B1, 0, 1); PG8_SCHED; PG8_LDA(At, 0, 0); PG8_STAGE(PG8_SA(1, 1), a1 + hstep, voffA);
            PG8_WAIT_V(8); PG8_WAIT_L(0); PG8_BAR; PG8_MMA(0, 0, At, B0); PG8_MMA(0, 1, At, B1); PG8_BAR; PG8_SCHED;
            PG8_LDA(At, 0, 1); PG8_STAGE(PG8_SB(0, 0), b2, voffB); PG8_STAGE(PG8_SB(0, 1), b2 + hstep, voffB); PG8_STAGE(PG8_SA(0, 0), a2, voffA);
            PG8_WAIT_V(8); PG8_WAIT_L(0); PG8_BAR; PG8_MMA(1, 0, At, B0); PG8_MMA(1, 1, At, B1); PG8_BAR; PG8_SCHED;
            PG8_LDB(B0, 1, 0); PG8_LDB(B1, 1, 1); PG8_SCHED; PG8_LDA(At, 1, 0); PG8_STAGE(PG8_SA(0, 1), a2 + hstep, voffA);
            PG8_WAIT_V(8); PG8_WAIT_L(0); PG8_BAR; PG8_MMA(0, 0, At, B0); PG8_MMA(0, 1, At, B1); PG8_BAR; PG8_SCHED;
            PG8_LDA(At, 1, 1); PG8_STAGE(PG8_SB(1, 0), b3, voffB); PG8_STAGE(PG8_SB(1, 1), b3 + hstep, voffB); PG8_STAGE(PG8_SA(1, 0), a3, voffA);
            PG8_WAIT_V(8); PG8_WAIT_L(0); PG8_BAR; PG8_MMA(1, 0, At, B0); PG8_MMA(1, 1, At, B1); PG8_BAR; PG8_SCHED;
            } else {
            PG8_LDB(B0, 0, 0); PG8_SCHED; PG8_LDA(At, 0, 0); PG8_STAGE(PG8_SA(1, 1), a1 + hstep, voffA);
            PG8_WAIT_L(8); PG8_BAR; PG8_WAIT_L(0); PG8_MMA(0, 0, At, B0); PG8_BAR; PG8_SCHED;
            PG8_LDB(B1, 0, 1); PG8_STAGE(PG8_SB(0, 0), b2, voffB);
            PG8_BAR; PG8_WAIT_L(0); PG8_MMA(0, 1, At, B1); PG8_BAR;
            PG8_LDA(At, 0, 1); PG8_STAGE(PG8_SA(0, 0), a2, voffA);
            PG8_BAR; PG8_WAIT_L(0); PG8_MMA(1, 0, At, B0); PG8_BAR; PG8_SCHED;
            PG8_STAGE(PG8_SB(0, 1), b2 + hstep, voffB);
            PG8_WAIT_V(6); PG8_BAR; PG8_MMA(1, 1, At, B1); PG8_BAR;
            PG8_LDB(B0, 1, 0); PG8_SCHED; PG8_LDA(At, 1, 0); PG8_STAGE(PG8_SA(0, 1), a2 + hstep, voffA);
            PG8_WAIT_L(8); PG8_BAR; PG8_WAIT_L(0); PG8_MMA(0, 0, At, B0); PG8_BAR; PG8_SCHED;
            PG8_LDB(B1, 1, 1); PG8_STAGE(PG8_SB(1, 0), b3, voffB);
            PG8_BAR; PG8_WAIT_L(0); PG8_MMA(0, 1, At, B1); PG8_BAR;
            PG8_LDA(At, 1, 1); PG8_STAGE(PG8_SA(1, 0), a3, voffA);
            PG8_BAR; PG8_WAIT_L(0); PG8_MMA(1, 0, At, B0); PG8_BAR; PG8_SCHED;
            PG8_STAGE(PG8_SB(1, 1), b3 + hstep, voffB);
            PG8_WAIT_V(6); PG8_BAR; PG8_MMA(1, 1, At, B1); PG8_BAR;
            }
        }
        if constexpr (ALIGN_EPI) { if (wr == 0) PG8_BAR; }
        if constexpr (!Epi::AFTER_DRAIN) { E(acc, cur, wr, wc, fr, fq); S.done(cur); }
        if (!has_next) break;
#pragma unroll
        for (int a = 0; a < 2; ++a)
#pragma unroll
            for (int b = 0; b < 2; ++b)
#pragma unroll
                for (int m = 0; m < 4; ++m)
#pragma unroll
                    for (int n = 0; n < 2; ++n) acc[a][b][m][n] = (f32x4){0.f, 0.f, 0.f, 0.f};
        cur = nxt; cA = nA; cB = nB; ++ui;
        if constexpr (ALIGN_EPI) { if (wr == 1) PG8_BAR; }
    }
    PG8_WAIT_V(0);
    if constexpr (!ALIGN_EPI) { if (wr == 0) PG8_BAR; }
    PG8_BAR;
    if constexpr (Epi::AFTER_DRAIN) { E.fused(acc, cur, wr, wc, fr, fq, lds, wid, lane); S.done(cur); }
#undef PG8_SA
#undef PG8_SB
#undef PG8_STAGE
#undef PG8_LDA
#undef PG8_LDB
#undef PG8_MMA
#undef PG8_WAIT_V
#undef PG8_WAIT_L
#undef PG8_BAR
#undef PG8_SCHED
}
}

constexpr int NWAVES = 8;
constexpr int BATCH = 4, SEQ = 2048, D = 4096, M = BATCH * SEQ;
constexpr int DN_H = 16, DN_DK = 128, DN_DV = 128, DN_KEY = 2048, DN_VAL = 2048, DN_QKV = 6144;
constexpr int GL_H = 8, GL_DK = 128, GL_DV = 256, GL_KEY = 1024, GL_VAL = 2048, GL_RANK = 16;
constexpr int DFF = 11008, IN_COLS = 22576;
constexpr float EPS = 1e-6f;
constexpr int PN = 22528;
constexpr int PC_QKV = 0, PC_Z = 6144, PC_GQ = 8192, PC_GK = 9216, PC_GV = 10240, PC_GR = 12288, PC_GATE_DN = 14336, PC_GATE_GLA = 18432;
constexpr int PSM = 64;
constexpr int NGU = 2 * DFF;

constexpr size_t MiB = 1u << 20;
constexpr size_t WS_CTL = 0, CTL_ZERO_BYTES = 1 * MiB;
constexpr size_t WS_WIN = 1 * MiB, WS_WSM = 177 * MiB, WS_WBDN = 178 * MiB, WS_WBGLA = 194 * MiB, WS_WOUT = 210 * MiB, WS_WFIN = 242 * MiB, WS_WFOUT = 414 * MiB;
constexpr size_t WS_H = 500 * MiB, WS_PROJ = 564 * MiB, WS_PSMALL = 916 * MiB;
constexpr size_t WS_DW = 918 * MiB, WS_DQE = 950 * MiB, WS_DKT = 982 * MiB, WS_DAT = 1014 * MiB, WS_DU = 1030 * MiB, WS_DDL = 1094 * MiB;
constexpr size_t WS_GQE = 1096 * MiB, WS_GKT = 1112 * MiB, WS_GAT = 1128 * MiB, WS_GVT = 1136 * MiB, WS_GDL = 1168 * MiB;
constexpr size_t WS_EK = 1170 * MiB;
constexpr size_t WS_QF = 918 * MiB, WS_KF = 982 * MiB, WS_VF = 1046 * MiB, WS_BETA = 1094 * MiB, WS_G = WS_BETA + 512 * 1024;
constexpr size_t WS_ODN = 1208 * MiB, WS_OGLA = 1272 * MiB, WS_ONDN = 1336 * MiB, WS_ONGLA = 1368 * MiB, WS_END = 1400 * MiB;
constexpr size_t WS_TMP = 918 * MiB, WS_MERGED = 1046 * MiB, WS_X1 = 1110 * MiB, WS_GU = WS_PROJ, WS_HID = WS_WIN;
static_assert(WS_WIN + (size_t)PN * D * 2 <= WS_WSM && WS_WFIN + (size_t)NGU * D * 2 <= WS_WFOUT && WS_WFOUT + (size_t)D * DFF * 2 <= WS_H, "ws map (weights)");
static_assert(WS_PROJ + (size_t)M * PN * 2 <= WS_PSMALL && WS_GU + (size_t)M * NGU * 2 <= WS_PSMALL && WS_HID + (size_t)M * DFF * 2 <= WS_WSM, "ws map (activations)");
static_assert(WS_X1 + (size_t)M * D * 4 <= WS_ONDN, "ws map (x1)");
constexpr size_t WS_GTAIL = WS_MERGED, WS_GHEAD = WS_MERGED + 4 * MiB, WS_UHEAD = WS_MERGED + 8 * MiB;
constexpr size_t WS_SSQ = WS_CTL + 256 * 1024;
constexpr int CW_BAR = 4096;

constexpr int RING_OFF = 0, RING_BYTES = 131072;
constexpr int LDSCTL_OFF = RING_BYTES, MISC_OFF = LDSCTL_OFF + 320;
constexpr int PTR_OFF = LDSCTL_OFF + 512;
constexpr int XL_OFF = LDSCTL_OFF + 1024;
constexpr int LDS_BYTES = 147456;

#define GAS __attribute__((address_space(1)))
#define LAS __attribute__((address_space(3)))
typedef unsigned short bf16;
typedef unsigned v4u __attribute__((ext_vector_type(4)));
typedef unsigned v2u __attribute__((ext_vector_type(2)));
typedef float f32x4 __attribute__((ext_vector_type(4)));
typedef float f32x2 __attribute__((ext_vector_type(2)));
typedef short bf16x8 __attribute__((ext_vector_type(8)));
typedef GAS unsigned gu32;
#define RLX_AGENT __ATOMIC_RELAXED, __HIP_MEMORY_SCOPE_AGENT
#define LDS_WAIT() asm volatile("s_waitcnt lgkmcnt(0)" ::: "memory")
#define VM_WAIT() asm volatile("s_waitcnt vmcnt(0)" ::: "memory")
__device__ __forceinline__ unsigned f2bf(float f) { unsigned u = __builtin_bit_cast(unsigned, f); return (u + 0x7fffu + ((u >> 16) & 1u)) >> 16; }
__device__ __forceinline__ unsigned pk2(float lo, float hi) { return f2bf(lo) | (f2bf(hi) << 16); }
__device__ __forceinline__ float bflo(unsigned w) { return __uint_as_float(w << 16); }
__device__ __forceinline__ float bfhi(unsigned w) { return __uint_as_float(w & 0xffff0000u); }
__device__ __forceinline__ float bf1(bf16 b) { return __uint_as_float((unsigned)b << 16); }
__device__ __forceinline__ float sigmoid_f(float x) { return 1.0f / (1.0f + expf(-x)); }
__device__ __forceinline__ float silu_f(float x) { return x / (1.0f + expf(-x)); }
__device__ __forceinline__ float softplus_f(float x) { return fmaxf(x, 0.f) + log1pf(expf(-fabsf(x))); }
__device__ __forceinline__ float logsigmoid_f(float x) { return fminf(x, 0.f) - log1pf(expf(-fabsf(x))); }
__device__ __forceinline__ float wave_sum(float v) {
#pragma unroll
    for (int o = 1; o < 64; o <<= 1) v += __shfl_xor(v, o);
    return v;
}

#define XB_TMO      128
#define XB_XCNT(j)  (256  + 64 * (j))
#define XB_XSUB(j)  (1280 + 64 * (j))
#define XB_XGEN(j)  (2304 + 64 * (j))
#define XB_TOP      3328
#define XB_TOPGEN   3392
#define XCD_BAR_WORDS 3456
#define XB_SPIN_CAP (1u << 18)

__device__ __forceinline__ unsigned xb_ld(unsigned* p)              { return __hip_atomic_load(p, __ATOMIC_RELAXED, __HIP_MEMORY_SCOPE_AGENT); }
__device__ __forceinline__ unsigned xb_add(unsigned* p, unsigned v) { return __hip_atomic_fetch_add(p, v, __ATOMIC_RELAXED, __HIP_MEMORY_SCOPE_AGENT); }
__device__ __forceinline__ unsigned xb_xcc_id() { return (unsigned)__builtin_amdgcn_s_getreg((3 << 11) | 20) & 0xFu; }
#define XB_SPIN(cond, bar) do { unsigned _sp = 0; while (cond) { __builtin_amdgcn_s_sleep(1); \
    if ((++_sp & 255u) == 0u) { if (xb_ld(&(bar)[XB_TMO])) break; if (_sp > XB_SPIN_CAP) { atomicAdd(&(bar)[XB_TMO], 1u); break; } } } } while (0)

struct XcdBarrier {
    unsigned* bar; unsigned x;
    volatile LAS unsigned* st;
};

__device__ __forceinline__ XcdBarrier xcd_barrier_post(unsigned* bar, volatile LAS unsigned* st) {
    XcdBarrier b; b.bar = bar; b.x = xb_xcc_id(); b.st = st;
    if (threadIdx.x == 0) (void)xb_add(&bar[XB_XCNT(b.x)], 1u);
    return b;
}
__device__ __forceinline__ void xcd_barrier_complete(unsigned* bar, unsigned x, unsigned& nloc, unsigned& nx) {
    const unsigned G = gridDim.x * gridDim.y * gridDim.z;
    unsigned sum, cnt, mine, sp = 0u;
    for (;;) {
        sum = 0u; cnt = 0u; mine = 0u;
#pragma unroll
        for (unsigned j = 0; j < 16; ++j) { const unsigned c = xb_ld(&bar[XB_XCNT(j)]); sum += c; cnt += (c > 0u) ? 1u : 0u; mine = (j == x) ? c : mine; }
        if (sum == G) break;
        __builtin_amdgcn_s_sleep(1);
        if ((++sp & 255u) == 0u) { if (xb_ld(&bar[XB_TMO])) break; if (sp > XB_SPIN_CAP) { atomicAdd(&bar[XB_TMO], 1u); break; } }
    }
    nloc = mine > 0u ? mine : 1u; nx = cnt > 0u ? cnt : 1u;
}

__device__ __forceinline__ void xcd_barrier(const XcdBarrier& b) {
    asm volatile("s_waitcnt vmcnt(0)" ::: "memory");
    __syncthreads();
    if (threadIdx.x == 0) {
        unsigned* bar = b.bar;
        __builtin_amdgcn_s_waitcnt(0);
        unsigned nloc = b.st[0], nx = b.st[1];
        if (nloc == 0u) { xcd_barrier_complete(bar, b.x, nloc, nx); b.st[0] = nloc; b.st[1] = nx; }
        const unsigned old = xb_add(&bar[XB_XSUB(b.x)], 1u);
        const unsigned gen = old / nloc;
        if (old + 1u == (gen + 1u) * nloc) {
            __builtin_amdgcn_fence(__ATOMIC_RELEASE, "agent");
            asm volatile("s_waitcnt vmcnt(0)" ::: "memory");
            const unsigned og = xb_add(&bar[XB_TOP], 1u);
            const unsigned tg = og / nx;
            if (og + 1u == (tg + 1u) * nx) xb_add(&bar[XB_TOPGEN], 1u);
            else XB_SPIN(xb_ld(&bar[XB_TOPGEN]) == tg, bar);
            __builtin_amdgcn_fence(__ATOMIC_ACQUIRE, "agent");
            xb_add(&bar[XB_XGEN(b.x)], 1u);
            asm volatile("s_waitcnt vmcnt(0)" ::: "memory");
        } else {
            XB_SPIN(xb_ld(&bar[XB_XGEN(b.x)]) == gen, bar);
            __builtin_amdgcn_fence(__ATOMIC_ACQUIRE, "agent");
            asm volatile("s_waitcnt vmcnt(0)" ::: "memory");
        }
    }
    __syncthreads();
}

struct Frame {
    LAS unsigned char* lds;
    volatile LAS unsigned* MISC;
    gu32* ctl;
    int tid, lane, wave;
    int vcu, G;
    unsigned char* ws;
    const float* in[19];
    float* out;
};
enum { I_X = 0, I_NORM_MIX, I_W_IN, I_DN_CONV, I_DN_ALOG, I_DN_DTB, I_DN_NORM, I_GL_WA2, I_GL_BA, I_GL_NORM, I_W_BDN, I_W_BGLA, I_W_OUT, I_NORM_FFN, I_W_FIN, I_FFN_CW, I_FFN_CB, I_W_FOUT, I_NORM_FIN };

__device__ __forceinline__ unsigned long long lds_ptr_get(Frame& F, int i) {
    const volatile LAS unsigned* p = (const volatile LAS unsigned*)(F.lds + PTR_OFF) + 2 * i;
    const unsigned lo = __builtin_amdgcn_readfirstlane(p[0]), hi = __builtin_amdgcn_readfirstlane(p[1]);
    return ((unsigned long long)hi << 32) | lo;
}
__device__ __forceinline__ void frame_reload(Frame& F) {
#pragma unroll
    for (int i = 0; i < 19; ++i) F.in[i] = (const float*)lds_ptr_get(F, i);
    F.out = (float*)lds_ptr_get(F, 19); F.ws = (unsigned char*)lds_ptr_get(F, 20); F.ctl = (gu32*)(F.ws + WS_CTL);
}

__device__ __forceinline__ void transpose_item(const float* W, size_t ldw, int k0, int sn0, bf16* WT, size_t ldk, int dn0, LAS float* scr, int lane, const float* ksc) {
    const int nq = lane & 7, kr = lane >> 3;
    f32x4 v[8];
#pragma unroll
    for (int i = 0; i < 8; ++i) v[i] = *(const GAS f32x4*)(W + (size_t)(k0 + 8 * i + kr) * ldw + sn0 + 4 * nq);
    if (ksc) {
#pragma unroll
        for (int i = 0; i < 8; ++i) v[i] *= ksc[k0 + 8 * i + kr]; }
#pragma unroll
    for (int i = 0; i < 8; ++i) { LAS float* d = scr + (8 * i + kr) * 33 + 4 * nq; d[0] = v[i].x; d[1] = v[i].y; d[2] = v[i].z; d[3] = v[i].w; }
    LDS_WAIT(); asm volatile("" ::: "memory");
    const int c = lane >> 3;
#pragma unroll
    for (int j = 0; j < 4; ++j) { const int n = (lane & 7) + 8 * j; const LAS float* s = scr + (8 * c) * 33 + n;
        v4u o; o.x = pk2(s[0 * 33], s[1 * 33]); o.y = pk2(s[2 * 33], s[3 * 33]); o.z = pk2(s[4 * 33], s[5 * 33]); o.w = pk2(s[6 * 33], s[7 * 33]);
        *(GAS v4u*)(WT + (size_t)(dn0 + n) * ldk + k0 + 8 * c) = o; }
    LDS_WAIT(); asm volatile("" ::: "memory");
}
__device__ __forceinline__ void rms_row(const float* xrow, const float* w, bf16* obf, float* of32, int lane) {
    const GAS f32x4* xr = (const GAS f32x4*)xrow + lane;
    f32x4 v[16]; float s = 0.f;
#pragma unroll
    for (int j = 0; j < 16; ++j) { v[j] = xr[64 * j]; s += (v[j].x * v[j].x + v[j].y * v[j].y) + (v[j].z * v[j].z + v[j].w * v[j].w); }
    const float rstd = 1.0f / sqrtf(wave_sum(s) * (1.f / D) + EPS);
    const GAS f32x4* wr = (const GAS f32x4*)w + lane;
    if (obf) { GAS v2u* o8 = (GAS v2u*)obf + lane;
#pragma unroll
        for (int j = 0; j < 16; ++j) { const f32x4 g = wr[64 * j]; v2u o; o.x = pk2(v[j].x * rstd * g.x, v[j].y * rstd * g.y); o.y = pk2(v[j].z * rstd * g.z, v[j].w * rstd * g.w); o8[64 * j] = o; } }
    else { GAS f32x4* o = (GAS f32x4*)of32 + lane;
#pragma unroll
        for (int j = 0; j < 16; ++j) { const f32x4 g = wr[64 * j]; o[64 * j] = (f32x4){v[j].x * rstd * g.x, v[j].y * rstd * g.y, v[j].z * rstd * g.z, v[j].w * rstd * g.w}; } }
}

__device__ __forceinline__ void p0_prologue(Frame& F) {
    LAS float* scr = (LAS float*)(F.lds + RING_OFF + F.wave * 16384);
    const int gw = F.vcu * NWAVES + F.wave, NGW = F.G * NWAVES;
    bf16* WIN = (bf16*)(F.ws + WS_WIN); bf16* WSM = (bf16*)(F.ws + WS_WSM); bf16* WBDN = (bf16*)(F.ws + WS_WBDN); bf16* WBGLA = (bf16*)(F.ws + WS_WBGLA);
    bf16* WOUT = (bf16*)(F.ws + WS_WOUT); bf16* WFIN = (bf16*)(F.ws + WS_WFIN); bf16* WFOUT = (bf16*)(F.ws + WS_WFOUT);
    constexpr int NB_IN = PN / 32, I_IN = (D / 64) * NB_IN;
    constexpr int I_SM = (D / 64) * 2;
    constexpr int I_BR = (2048 / 64) * (D / 32);
    constexpr int I_OUT = (D / 64) * (D / 32);
    constexpr int NB_FI = NGU / 32, I_FI = (D / 64) * NB_FI;
    constexpr int I_FO = (DFF / 64) * (D / 32);
    constexpr int NITEMS = I_IN + I_SM + 2 * I_BR + I_OUT + I_FI + I_FO;
    for (int it = gw; it < NITEMS; it += NGW) {
        int r = it;
        if (r < I_IN) { const int kb = r / NB_IN, nb = r % NB_IN, n0 = 32 * nb; const int sn0 = n0 + (n0 >= PC_GATE_DN ? 48 : (n0 >= PC_GQ ? 32 : 0));
            transpose_item(F.in[I_W_IN], IN_COLS, 64 * kb, sn0, WIN, D, n0, scr, F.lane, nullptr); continue; } r -= I_IN;
        if (r < I_SM) { const int kb = r >> 1, nb = r & 1; transpose_item(F.in[I_W_IN], IN_COLS, 64 * kb, nb ? 14368 : 8192, WSM, D, 32 * nb, scr, F.lane, nullptr); continue; } r -= I_SM;
        if (r < I_BR) { const int kb = r / (D / 32), nb = r % (D / 32); transpose_item(F.in[I_W_BDN], D, 64 * kb, 32 * nb, WBDN, 2048, 32 * nb, scr, F.lane, nullptr); continue; } r -= I_BR;
        if (r < I_BR) { const int kb = r / (D / 32), nb = r % (D / 32); transpose_item(F.in[I_W_BGLA], D, 64 * kb, 32 * nb, WBGLA, 2048, 32 * nb, scr, F.lane, nullptr); continue; } r -= I_BR;
        if (r < I_OUT) { const int kb = r / (D / 32), nb = r % (D / 32); transpose_item(F.in[I_W_OUT], D, 64 * kb, 32 * nb, WOUT, D, 32 * nb, scr, F.lane, nullptr); continue; } r -= I_OUT;
        if (r < I_FI) { const int kb = r / NB_FI, nb = r % NB_FI, n0 = 32 * nb, j = n0 >> 8, i = n0 & 255; const int sn0 = (i < 128) ? (128 * j + i) : (DFF + 128 * j + (i - 128));
            transpose_item(F.in[I_W_FIN], NGU, 64 * kb, sn0, WFIN, D, n0, scr, F.lane, F.in[I_NORM_FFN]); continue; } r -= I_FI;
        { const int kb = r / (D / 32), nb = r % (D / 32); transpose_item(F.in[I_W_FOUT], D, 64 * kb, 32 * nb, WFOUT, DFF, 32 * nb, scr, F.lane, nullptr); }
    }
    bf16* H = (bf16*)(F.ws + WS_H);
    for (int m = gw; m < M; m += NGW) rms_row(F.in[I_X] + (size_t)m * D, F.in[I_NORM_MIX], H + (size_t)m * D, nullptr, F.lane);
}

__device__ __forceinline__ void p1_skinny(Frame& F) {
    const bf16* H = (const bf16*)(F.ws + WS_H); const bf16* WSM = (const bf16*)(F.ws + WS_WSM); float* PS = (float*)(F.ws + WS_PSMALL);
    const int lane = F.lane, fr = lane & 15, fq = lane >> 4;
    for (int t = (int)blockIdx.x + F.G * F.wave; t < M / 16; t += F.G * NWAVES) {
        const int row0 = 16 * t;
        const bf16* ap = H + (size_t)(row0 + fr) * D + 8 * fq; const bf16* bp = WSM + (size_t)fr * D + 8 * fq;
        f32x4 acc[4] = {{0.f, 0.f, 0.f, 0.f}, {0.f, 0.f, 0.f, 0.f}, {0.f, 0.f, 0.f, 0.f}, {0.f, 0.f, 0.f, 0.f}};
#pragma unroll 4
        for (int kk = 0; kk < D / 32; ++kk) {
            const bf16x8 a = *(const GAS bf16x8*)(ap + kk * 32);
#pragma unroll
            for (int cb = 0; cb < 4; ++cb) { const bf16x8 b = *(const GAS bf16x8*)(bp + (size_t)cb * 16 * D + kk * 32); acc[cb] = __builtin_amdgcn_mfma_f32_16x16x32_bf16(a, b, acc[cb], 0, 0, 0); }
        }
#pragma unroll
        for (int cb = 0; cb < 4; ++cb)
#pragma unroll
            for (int r = 0; r < 4; ++r) PS[(size_t)(row0 + 4 * fq + r) * PSM + cb * 16 + fr] = acc[cb][r];
    }
}


constexpr int PQ = 136, PT = 72;
constexpr float QSCALE = 0.08838834764831845f;
__device__ __forceinline__ float silu_fast(float x) { return x / (1.0f + __expf(-x)); }
__device__ __forceinline__ v4u pack8(const float* y) { v4u o; o.x = pk2(y[0], y[1]); o.y = pk2(y[2], y[3]); o.z = pk2(y[4], y[5]); o.w = pk2(y[6], y[7]); return o; }
#define MFMA16(a, b, c) __builtin_amdgcn_mfma_f32_16x16x32_bf16((a), (b), (c), 0, 0, 0)

__device__ __forceinline__ void dn_conv16(const bf16* P, const float* cw, int tg, int t, int col, float (&y)[16]) {
#pragma unroll
    for (int c = 0; c < 16; ++c) y[c] = 0.f;
    v4u x0[4], x1[4];
#pragma unroll
    for (int i = 0; i < 4; ++i) {
        const bf16* src = P + (size_t)((t - 3 + i >= 0) ? tg - 3 + i : tg) * PN + PC_QKV + col;
        x0[i] = *(const GAS v4u*)src; x1[i] = *(const GAS v4u*)(src + 8);
    }
#pragma unroll
    for (int i = 0; i < 4; ++i) {
        const float m = (t - 3 + i >= 0) ? 1.f : 0.f;
        const float* w = cw + (size_t)i * DN_QKV + col;
        const f32x4 w0 = *(const GAS f32x4*)w * m, w1 = *(const GAS f32x4*)(w + 4) * m, w2 = *(const GAS f32x4*)(w + 8) * m, w3 = *(const GAS f32x4*)(w + 12) * m;
        y[0] += w0.x * bflo(x0[i].x); y[1] += w0.y * bfhi(x0[i].x); y[2] += w0.z * bflo(x0[i].y); y[3] += w0.w * bfhi(x0[i].y);
        y[4] += w1.x * bflo(x0[i].z); y[5] += w1.y * bfhi(x0[i].z); y[6] += w1.z * bflo(x0[i].w); y[7] += w1.w * bfhi(x0[i].w);
        y[8] += w2.x * bflo(x1[i].x); y[9] += w2.y * bfhi(x1[i].x); y[10] += w2.z * bflo(x1[i].y); y[11] += w2.w * bfhi(x1[i].y);
        y[12] += w3.x * bflo(x1[i].z); y[13] += w3.y * bfhi(x1[i].z); y[14] += w3.z * bflo(x1[i].w); y[15] += w3.w * bfhi(x1[i].w);
        asm volatile("" ::: "memory");
    }
#pragma unroll
    for (int c = 0; c < 16; ++c) y[c] = silu_fast(y[c]);
}

constexpr int LP_KN = 0, LP_QN = 17408, LP_KB = 34816, LP_KDT = 52224, LP_RHS = 0, LP_A = 70656, LP_BV = 87040, LP_BETA = 87296;
__device__ __forceinline__ void dn_prep_chunk(Frame& F, int ch) {
    int tid = F.tid; asm volatile("" : "+v"(tid));
    const int lane = tid & 63, wave = F.wave, fr = lane & 15, fq = lane >> 4;
    const int h = ch & 15, bn = ch >> 4, n = bn & 31, b = bn >> 5, tg0 = b * SEQ + n * 64;
    const size_t id = (size_t)((b * DN_H + h) * 32 + n);
    LAS unsigned char* L = F.lds + RING_OFF;
    LAS bf16* Kn = (LAS bf16*)(L + LP_KN); LAS bf16* Qn = (LAS bf16*)(L + LP_QN); LAS bf16* KB = (LAS bf16*)(L + LP_KB); LAS bf16* KDTl = (LAS bf16*)(L + LP_KDT);
    LAS float* RHS = (LAS float*)(L + LP_RHS); LAS float* Al = (LAS float*)(L + LP_A);
    const bf16* PROJ = (const bf16*)(F.ws + WS_PROJ); const float* PS = (const float*)(F.ws + WS_PSMALL);
    bf16* DW = (bf16*)(F.ws + WS_DW) + id * 8192; bf16* DQE = (bf16*)(F.ws + WS_DQE) + id * 8192; bf16* DKT = (bf16*)(F.ws + WS_DKT) + id * 8192;
    bf16* DAT = (bf16*)(F.ws + WS_DAT) + id * 4096; float* DU = (float*)(F.ws + WS_DU) + id * 8192; float* DDL = (float*)(F.ws + WS_DDL);
    float gp, betal;
    { const int tgl = tg0 + lane;
      gp = -expf(F.in[I_DN_ALOG][h]) * softplus_f(PS[(size_t)tgl * PSM + 16 + h] + F.in[I_DN_DTB][h]);
#pragma unroll
      for (int o = 1; o < 64; o <<= 1) { const float tt = __shfl_up(gp, o); if (lane >= o) gp += tt; }
      betal = sigmoid_f(PS[(size_t)tgl * PSM + h]); }
    const int row = tid >> 3, cg = tid & 7, t = n * 64 + row, tg = tg0 + row, c0 = 16 * cg;
    const float bt = __shfl(gp, row), bl = __shfl(gp, 63), beta = __shfl(betal, row), eb = __expf(bt), ekd = __expf(bl - bt);
    float k[16], v[16];
    {
        float q[16], tmp[16];
        dn_conv16(PROJ, F.in[I_DN_CONV], tg, t, h * 128 + c0, q);
        float sq = 0.f;
#pragma unroll
        for (int c = 0; c < 16; ++c) sq += q[c] * q[c];
        sq += __shfl_xor(sq, 1); sq += __shfl_xor(sq, 2); sq += __shfl_xor(sq, 4);
        const float iq = QSCALE * __builtin_amdgcn_rsqf(sq + EPS);
#pragma unroll
        for (int c = 0; c < 16; ++c) { q[c] *= iq; tmp[c] = q[c] * eb; }
        *(LAS v4u*)(Qn + row * PQ + c0) = pack8(q); *(LAS v4u*)(Qn + row * PQ + c0 + 8) = pack8(q + 8);
        *(GAS v4u*)(DQE + row * 128 + c0) = pack8(tmp); *(GAS v4u*)(DQE + row * 128 + c0 + 8) = pack8(tmp + 8);
        asm volatile("" ::: "memory");
    }
    {
        float tmp[16];
        dn_conv16(PROJ, F.in[I_DN_CONV], tg, t, 2048 + h * 128 + c0, k);
        float sk = 0.f;
#pragma unroll
        for (int c = 0; c < 16; ++c) sk += k[c] * k[c];
        sk += __shfl_xor(sk, 1); sk += __shfl_xor(sk, 2); sk += __shfl_xor(sk, 4);
        const float ik = __builtin_amdgcn_rsqf(sk + EPS);
#pragma unroll
        for (int c = 0; c < 16; ++c) { k[c] *= ik; tmp[c] = k[c] * beta; }
        *(LAS v4u*)(Kn + row * PQ + c0) = pack8(k); *(LAS v4u*)(Kn + row * PQ + c0 + 8) = pack8(k + 8);
        *(LAS v4u*)(KB + row * PQ + c0) = pack8(tmp); *(LAS v4u*)(KB + row * PQ + c0 + 8) = pack8(tmp + 8);
#pragma unroll
        for (int c = 0; c < 16; ++c) KDTl[(c0 + c) * PT + row] = (bf16)f2bf(k[c] * ekd);
        asm volatile("" ::: "memory");
    }
    dn_conv16(PROJ, F.in[I_DN_CONV], tg, t, 4096 + h * 128 + c0, v);
    if (tid == 0) DDL[id] = __expf(bl);
    __syncthreads();
    {
        const int rb = wave >> 1;
        f32x4 kk[2] = {{0.f, 0.f, 0.f, 0.f}, {0.f, 0.f, 0.f, 0.f}}, qk[2] = {{0.f, 0.f, 0.f, 0.f}, {0.f, 0.f, 0.f, 0.f}};
#pragma unroll
        for (int ks = 0; ks < 4; ++ks) {
            const bf16x8 a = *(const LAS bf16x8*)(Kn + (16 * rb + fr) * PQ + 32 * ks + 8 * fq);
#pragma unroll
            for (int c2 = 0; c2 < 2; ++c2) { const int cb = (wave & 1) * 2 + c2;
                const bf16x8 b1 = *(const LAS bf16x8*)(KB + (16 * cb + fr) * PQ + 32 * ks + 8 * fq);
                const bf16x8 b2 = *(const LAS bf16x8*)(Qn + (16 * cb + fr) * PQ + 32 * ks + 8 * fq);
                kk[c2] = MFMA16(a, b1, kk[c2]); qk[c2] = MFMA16(a, b2, qk[c2]); }
        }
#pragma unroll
        for (int c2 = 0; c2 < 2; ++c2) { const int cb = (wave & 1) * 2 + c2, i = 16 * cb + fr, j0 = 16 * rb + 4 * fq; const float bi = __shfl(gp, i);
            f32x4 av; float at[4];
#pragma unroll
            for (int r = 0; r < 4; ++r) { const int j = j0 + r; const float bj = __shfl(gp, j); const float dec = (i >= j) ? __expf(bi - bj) : 0.f; av[r] = (i > j) ? kk[c2][r] * dec : 0.f; at[r] = (i >= j) ? qk[c2][r] * dec : 0.f; }
            *(LAS f32x4*)(Al + i * 64 + j0) = av;
            v2u w; w.x = pk2(at[0], at[1]); w.y = pk2(at[2], at[3]); *(GAS v2u*)(DAT + i * 64 + j0) = w; }
#pragma unroll
        for (int i = 0; i < 2; ++i) { const int id2 = tid + 512 * i, r = id2 >> 3, c = id2 & 7; *(GAS v4u*)(DKT + r * 64 + 8 * c) = *(const LAS v4u*)(KDTl + r * PT + 8 * c); }
    }
    __syncthreads();
    {
#pragma unroll
        for (int c = 0; c < 16; c += 4) {
            *(LAS f32x4*)(RHS + row * 256 + c0 + c) = (f32x4){k[c] * beta * eb, k[c + 1] * beta * eb, k[c + 2] * beta * eb, k[c + 3] * beta * eb};
            *(LAS f32x4*)(RHS + row * 256 + 128 + c0 + c) = (f32x4){v[c] * beta, v[c + 1] * beta, v[c + 2] * beta, v[c + 3] * beta}; }
    }
    __syncthreads();
    if (wave < 4) {
        const int c = 64 * wave + lane;
        unsigned abase = LP_A; asm volatile("" : "+v"(abase));
        const LAS float* Av = (const LAS float*)(L + abase);
        float X[64];
#pragma unroll
        for (int i = 0; i < 64; ++i) {
            float x0 = RHS[i * 256 + c], x1 = 0.f, x2 = 0.f, x3 = 0.f;
#pragma unroll
            for (int j4 = 0; j4 < i; j4 += 4) {
                const f32x4 a = *(const LAS f32x4*)(Av + i * 64 + j4);
                x0 -= a.x * X[j4];
                if (j4 + 1 < i) x1 -= a.y * X[j4 + 1];
                if (j4 + 2 < i) x2 -= a.z * X[j4 + 2];
                if (j4 + 3 < i) x3 -= a.w * X[j4 + 3];
            }
            X[i] = (x0 + x1) + (x2 + x3);
            asm volatile("" ::: "memory");
        }
        if (wave < 2) { bf16* pw = DW + c;
#pragma unroll
            for (int i = 0; i < 64; ++i) { *pw = (bf16)f2bf(-X[i]); pw += 128; asm volatile("" : "+v"(pw)); }
        } else { float* pu = DU + (c - 128);
#pragma unroll
            for (int i = 0; i < 64; ++i) { *pu = X[i]; pu += 128; asm volatile("" : "+v"(pu)); }
        }
    }
    __syncthreads();
}

constexpr int LG_QE = 0, LG_KE = 17408, LG_VT = 34816, LG_LR = 71680, LG_TOT = 75776;
__device__ __forceinline__ void gla_prep_chunk(Frame& F, int ch) {
    int tid = F.tid; asm volatile("" : "+v"(tid));
    const int lane = tid & 63, wave = F.wave, fr = lane & 15, fq = lane >> 4;
    const int h = ch & 7, bn = ch >> 3, n = bn & 31, b = bn >> 5, tg0 = b * SEQ + n * 64;
    const size_t id = (size_t)((b * GL_H + h) * 32 + n);
    LAS unsigned char* L = F.lds + RING_OFF;
    LAS bf16* QEl = (LAS bf16*)(L + LG_QE); LAS bf16* KEl = (LAS bf16*)(L + LG_KE); LAS bf16* VTl = (LAS bf16*)(L + LG_VT);
    LAS float* lrl = (LAS float*)(L + LG_LR); LAS float* tot = (LAS float*)(L + LG_TOT);
    const bf16* PROJ = (const bf16*)(F.ws + WS_PROJ); const float* PS = (const float*)(F.ws + WS_PSMALL);
    bf16* GQE = (bf16*)(F.ws + WS_GQE) + id * 8192; bf16* GKT = (bf16*)(F.ws + WS_GKT) + id * 8192; bf16* GAT = (bf16*)(F.ws + WS_GAT) + id * 4096;
    bf16* GVT = (bf16*)(F.ws + WS_GVT) + id * 16384; float* GDL = (float*)(F.ws + WS_GDL) + id * 128;
#pragma unroll
    for (int i = 0; i < 2; ++i) { const int e = tid + 512 * i; lrl[e] = PS[(size_t)(tg0 + (e >> 4)) * PSM + 32 + (e & 15)]; }
#pragma unroll
    for (int i = 0; i < 4; ++i) { const int e = tid + 512 * i, r = e >> 5, c = e & 31; const v4u x = *(const GAS v4u*)(PROJ + (size_t)(tg0 + r) * PN + PC_GV + h * 256 + 8 * c);
        LAS bf16* d = VTl + (8 * c) * PT + r;
        d[0 * PT] = (bf16)(x.x & 0xffffu); d[1 * PT] = (bf16)(x.x >> 16); d[2 * PT] = (bf16)(x.y & 0xffffu); d[3 * PT] = (bf16)(x.y >> 16);
        d[4 * PT] = (bf16)(x.z & 0xffffu); d[5 * PT] = (bf16)(x.z >> 16); d[6 * PT] = (bf16)(x.w & 0xffffu); d[7 * PT] = (bf16)(x.w >> 16); }
    const int d = tid & 127, rg = tid >> 7, r0 = 16 * rg, col = h * 128 + d;
    float w2[16];
#pragma unroll
    for (int r = 0; r < 16; ++r) w2[r] = F.in[I_GL_WA2][(size_t)r * GL_KEY + col];
    const float ba = F.in[I_GL_BA][col];
    float qv[16], kv[16];
#pragma unroll
    for (int i = 0; i < 16; ++i) { const size_t o = (size_t)(tg0 + r0 + i) * PN + h * 128 + d; qv[i] = bf1(PROJ[o + PC_GQ]) * QSCALE; kv[i] = bf1(PROJ[o + PC_GK]); }
    __syncthreads();
    float cs[16]; float run = 0.f;
#pragma unroll
    for (int i = 0; i < 16; ++i) { float x = ba;
#pragma unroll
        for (int r = 0; r < 16; r += 4) { const f32x4 l4 = *(const LAS f32x4*)(lrl + (r0 + i) * 16 + r); x += l4.x * w2[r] + l4.y * w2[r + 1] + l4.z * w2[r + 2] + l4.w * w2[r + 3]; }
        run += (fminf(x, 0.f) - __logf(1.0f + __expf(-fabsf(x)))) * (1.f / 16.f); cs[i] = run; }
    tot[rg * 128 + d] = run;
    __syncthreads();
    float off = 0.f, bl = 0.f;
#pragma unroll
    for (int g = 0; g < 4; ++g) { const float tg_ = tot[g * 128 + d]; if (g < rg) off += tg_; bl += tg_; }
    {
        float kd[16];
#pragma unroll
        for (int i = 0; i < 16; ++i) { const float bb = off + cs[i]; QEl[(r0 + i) * PQ + d] = (bf16)f2bf(qv[i] * __expf(bb)); KEl[(r0 + i) * PQ + d] = (bf16)f2bf(kv[i] * __expf(-bb)); kd[i] = kv[i] * __expf(bl - bb); }
        *(GAS v4u*)(GKT + d * 64 + r0) = pack8(kd); *(GAS v4u*)(GKT + d * 64 + r0 + 8) = pack8(kd + 8);
        if (rg == 0) GDL[d] = expf(bl);
    }
    __syncthreads();
    {
        const int rb = wave >> 1;
        f32x4 qk[2] = {{0.f, 0.f, 0.f, 0.f}, {0.f, 0.f, 0.f, 0.f}};
#pragma unroll
        for (int ks = 0; ks < 4; ++ks) {
            const bf16x8 a = *(const LAS bf16x8*)(KEl + (16 * rb + fr) * PQ + 32 * ks + 8 * fq);
#pragma unroll
            for (int c2 = 0; c2 < 2; ++c2) { const int cb = (wave & 1) * 2 + c2; const bf16x8 b2 = *(const LAS bf16x8*)(QEl + (16 * cb + fr) * PQ + 32 * ks + 8 * fq); qk[c2] = MFMA16(a, b2, qk[c2]); }
        }
#pragma unroll
        for (int c2 = 0; c2 < 2; ++c2) { const int cb = (wave & 1) * 2 + c2, i = 16 * cb + fr, j0 = 16 * rb + 4 * fq; float at[4];
#pragma unroll
            for (int r = 0; r < 4; ++r) at[r] = (i >= j0 + r) ? qk[c2][r] : 0.f;
            v2u w; w.x = pk2(at[0], at[1]); w.y = pk2(at[2], at[3]); *(GAS v2u*)(GAT + i * 64 + j0) = w; }
#pragma unroll
        for (int i = 0; i < 2; ++i) { const int e = tid + 512 * i, r = e >> 4, c = e & 15; *(GAS v4u*)(GQE + r * 128 + 8 * c) = *(const LAS v4u*)(QEl + r * PQ + 8 * c); }
#pragma unroll
        for (int i = 0; i < 4; ++i) { const int e = tid + 512 * i, r = e >> 3, c = e & 7; *(GAS v4u*)(GVT + r * 64 + 8 * c) = *(const LAS v4u*)(VTl + r * PT + 8 * c); }
    }
    __syncthreads();
}

constexpr int LS_W = 0, LS_QE = 17408, LS_KDT = 34816, LS_ATT = 53248, LS_VN = 62464, LS_ST0 = 71680, LS_ST1 = 89088, LS_END = 106496;
template <bool DN> __device__ __forceinline__ void scan_task(Frame& F, int bh, int part) {
    constexpr int H = DN ? DN_H : GL_H, DV = DN ? DN_DV : GL_DV;
    const int tid = F.tid, lane = F.lane, wave = F.wave, fr = lane & 15, fq = lane >> 4;
    const int b = bh / H, h = bh % H, dv0 = 64 * part;
    LAS unsigned char* L = F.lds + RING_OFF;
    LAS bf16* Wl = (LAS bf16*)(L + LS_W); LAS bf16* QEl = (LAS bf16*)(L + LS_QE); LAS bf16* KDTl = (LAS bf16*)(L + LS_KDT); LAS bf16* ATTl = (LAS bf16*)(L + LS_ATT);
    LAS bf16* VNt = (LAS bf16*)(L + LS_VN);
    const bf16* gW = (const bf16*)(F.ws + WS_DW) + (size_t)bh * 32 * 8192;
    const bf16* gQE = (const bf16*)(F.ws + (DN ? WS_DQE : WS_GQE)) + (size_t)bh * 32 * 8192;
    const bf16* gKT = (const bf16*)(F.ws + (DN ? WS_DKT : WS_GKT)) + (size_t)bh * 32 * 8192;
    const bf16* gAT = (const bf16*)(F.ws + (DN ? WS_DAT : WS_GAT)) + (size_t)bh * 32 * 4096;
    const float* gU = (const float*)(F.ws + WS_DU) + (size_t)bh * 32 * 8192;
    const bf16* gVT = (const bf16*)(F.ws + WS_GVT) + (size_t)bh * 32 * 16384 + (size_t)dv0 * 64;
    const float* gDL = DN ? (const float*)(F.ws + WS_DDL) + (size_t)bh * 32 : (const float*)(F.ws + WS_GDL) + (size_t)bh * 32 * 128;
    float* gO = (float*)(F.ws + (DN ? WS_ODN : WS_OGLA)) + (size_t)(b * SEQ) * 2048 + h * DV + dv0;
    for (int e = tid; e < 17408 / 4; e += NWAVES * 64) ((LAS unsigned*)(L + LS_ST0))[e] = 0u;
    f32x4 Sacc[4] = {{0.f, 0.f, 0.f, 0.f}, {0.f, 0.f, 0.f, 0.f}, {0.f, 0.f, 0.f, 0.f}, {0.f, 0.f, 0.f, 0.f}};
    const int rw0 = tid >> 4, cw0 = tid & 15;
    const int rk0 = tid >> 3, ck0 = tid & 7;
    const int rb = wave >> 1, cbw = (wave & 1) * 2;
    v4u sW[2], sQ[2], sK[2], sA, sV; f32x4 sDL; float sdl = 0.f; float uN[2][4];
    sW[0] = sW[1] = sQ[0] = sQ[1] = sK[0] = sK[1] = sA = sV = (v4u){0u, 0u, 0u, 0u}; sDL = (f32x4){0.f, 0.f, 0.f, 0.f};
#define SCAN_LOAD(n_) do { const size_t o8 = (size_t)(n_) * 8192, o4 = (size_t)(n_) * 4096; \
        if (DN) { sW[0] = *(const GAS v4u*)(gW + o8 + tid * 8); sW[1] = *(const GAS v4u*)(gW + o8 + 4096 + tid * 8); } \
        sQ[0] = *(const GAS v4u*)(gQE + o8 + tid * 8); sQ[1] = *(const GAS v4u*)(gQE + o8 + 4096 + tid * 8); \
        sK[0] = *(const GAS v4u*)(gKT + o8 + tid * 8); sK[1] = *(const GAS v4u*)(gKT + o8 + 4096 + tid * 8); \
        sA = *(const GAS v4u*)(gAT + o4 + tid * 8); \
        if (DN) { sdl = gDL[(n_)]; _Pragma("unroll") for (int c2 = 0; c2 < 2; ++c2) _Pragma("unroll") for (int r = 0; r < 4; ++r) uN[c2][r] = gU[o8 + (16 * rb + 4 * fq + r) * 128 + dv0 + 16 * (cbw + c2) + fr]; } \
        else { sV = *(const GAS v4u*)(gVT + (size_t)(n_) * 16384 + tid * 8); sDL = *(const GAS f32x4*)(gDL + (n_) * 128 + 16 * wave + 4 * fq); } } while (0)
#define SCAN_STORE() do { \
        if (DN) { *(LAS v4u*)(Wl + rw0 * PQ + 8 * cw0) = sW[0]; *(LAS v4u*)(Wl + (rw0 + 32) * PQ + 8 * cw0) = sW[1]; } \
        *(LAS v4u*)(QEl + rw0 * PQ + 8 * cw0) = sQ[0]; *(LAS v4u*)(QEl + (rw0 + 32) * PQ + 8 * cw0) = sQ[1]; \
        *(LAS v4u*)(KDTl + rk0 * PT + 8 * ck0) = sK[0]; *(LAS v4u*)(KDTl + (rk0 + 64) * PT + 8 * ck0) = sK[1]; \
        *(LAS v4u*)(ATTl + rk0 * PT + 8 * ck0) = sA; \
        if (!DN) *(LAS v4u*)(VNt + rk0 * PT + 8 * ck0) = sV; } while (0)
    SCAN_LOAD(0);
    SCAN_STORE();
    float uC[2][4]; float dlC = sdl; f32x4 dlV = sDL;
#pragma unroll
    for (int c2 = 0; c2 < 2; ++c2)
#pragma unroll
        for (int r = 0; r < 4; ++r) uC[c2][r] = DN ? uN[c2][r] : 0.f;
    __syncthreads();
    for (int n = 0; n < 32; ++n) {
        LAS bf16* Sc = (LAS bf16*)(L + ((n & 1) ? LS_ST1 : LS_ST0)); LAS bf16* Sn = (LAS bf16*)(L + ((n & 1) ? LS_ST0 : LS_ST1));
        if (n + 1 < 32) SCAN_LOAD(n + 1);
        if (DN) {
            f32x4 va[2];
#pragma unroll
            for (int c2 = 0; c2 < 2; ++c2) va[c2] = (f32x4){uC[c2][0], uC[c2][1], uC[c2][2], uC[c2][3]};
#pragma unroll
            for (int ks = 0; ks < 4; ++ks) { const bf16x8 a = *(const LAS bf16x8*)(Wl + (16 * rb + fr) * PQ + 32 * ks + 8 * fq);
#pragma unroll
                for (int c2 = 0; c2 < 2; ++c2) { const bf16x8 bb = *(const LAS bf16x8*)(Sc + (16 * (cbw + c2) + fr) * PQ + 32 * ks + 8 * fq); va[c2] = MFMA16(a, bb, va[c2]); } }
#pragma unroll
            for (int c2 = 0; c2 < 2; ++c2) { v2u w; w.x = pk2(va[c2][0], va[c2][1]); w.y = pk2(va[c2][2], va[c2][3]); *(LAS v2u*)(VNt + (16 * (cbw + c2) + fr) * PT + 16 * rb + 4 * fq) = w; }
            __syncthreads();
        }
        {
            f32x4 oa[2] = {{0.f, 0.f, 0.f, 0.f}, {0.f, 0.f, 0.f, 0.f}};
#pragma unroll
            for (int ks = 0; ks < 4; ++ks) { const bf16x8 a = *(const LAS bf16x8*)(QEl + (16 * rb + fr) * PQ + 32 * ks + 8 * fq);
#pragma unroll
                for (int c2 = 0; c2 < 2; ++c2) { const bf16x8 bb = *(const LAS bf16x8*)(Sc + (16 * (cbw + c2) + fr) * PQ + 32 * ks + 8 * fq); oa[c2] = MFMA16(a, bb, oa[c2]); } }
#pragma unroll
            for (int ks = 0; ks < 2; ++ks) { const bf16x8 a = *(const LAS bf16x8*)(ATTl + (16 * rb + fr) * PT + 32 * ks + 8 * fq);
#pragma unroll
                for (int c2 = 0; c2 < 2; ++c2) { const bf16x8 bb = *(const LAS bf16x8*)(VNt + (16 * (cbw + c2) + fr) * PT + 32 * ks + 8 * fq); oa[c2] = MFMA16(a, bb, oa[c2]); } }
#pragma unroll
            for (int c2 = 0; c2 < 2; ++c2)
#pragma unroll
                for (int r = 0; r < 4; ++r) gO[(size_t)(n * 64 + 16 * rb + 4 * fq + r) * 2048 + 16 * (cbw + c2) + fr] = oa[c2][r];
        }
        {
#pragma unroll
            for (int cb = 0; cb < 4; ++cb) { if (DN) Sacc[cb] *= dlC; else Sacc[cb] *= dlV; }
#pragma unroll
            for (int ks = 0; ks < 2; ++ks) { const bf16x8 a = *(const LAS bf16x8*)(KDTl + (16 * wave + fr) * PT + 32 * ks + 8 * fq);
#pragma unroll
                for (int cb = 0; cb < 4; ++cb) { const bf16x8 bb = *(const LAS bf16x8*)(VNt + (16 * cb + fr) * PT + 32 * ks + 8 * fq); Sacc[cb] = MFMA16(a, bb, Sacc[cb]); } }
#pragma unroll
            for (int cb = 0; cb < 4; ++cb) { v2u w; w.x = pk2(Sacc[cb][0], Sacc[cb][1]); w.y = pk2(Sacc[cb][2], Sacc[cb][3]); *(LAS v2u*)(Sn + (16 * cb + fr) * PQ + 16 * wave + 4 * fq) = w; }
        }
        __syncthreads();
        if (n + 1 < 32) { SCAN_STORE(); dlC = sdl; dlV = sDL;
#pragma unroll
            for (int c2 = 0; c2 < 2; ++c2)
#pragma unroll
                for (int r = 0; r < 4; ++r) uC[c2][r] = DN ? uN[c2][r] : 0.f; }
        __syncthreads();
    }
#undef SCAN_LOAD
#undef SCAN_STORE
}

#ifndef CHUNK_DN
#define CHUNK_DN 1
#endif
#ifndef CHUNK_GLA
#define CHUNK_GLA 1
#endif
__device__ __forceinline__ void p2_prep(Frame& F) {
    const int gw = F.vcu * NWAVES + F.wave, NGW = F.G * NWAVES, lane = F.lane;
    const bf16* PROJ = (const bf16*)(F.ws + WS_PROJ); const float* PS = (const float*)(F.ws + WS_PSMALL);
    float* QF = (float*)(F.ws + WS_QF); float* KF = (float*)(F.ws + WS_KF); float* VF = (float*)(F.ws + WS_VF);
    float* EK = (float*)(F.ws + WS_EK); float* BETA = (float*)(F.ws + WS_BETA); float* GD = (float*)(F.ws + WS_G);
    const float* cw = F.in[I_DN_CONV];
#if !CHUNK_DN
    for (int id = gw; id < M * DN_H; id += NGW) {
        const int tg = id >> 4, h = id & 15, t = tg & (SEQ - 1), d0 = 2 * lane;
        float res[3][2];
#pragma unroll
        for (int p = 0; p < 3; ++p) { const int col = p * 2048 + h * 128 + d0; float y0 = 0.f, y1 = 0.f;
#pragma unroll
            for (int i = 0; i < 4; ++i) { const int tt = t - 3 + i; if (tt >= 0) { const unsigned xw = *(const GAS unsigned*)(PROJ + (size_t)(tg - 3 + i) * PN + PC_QKV + col);
                    const f32x2 w = *(const GAS f32x2*)(cw + (size_t)i * DN_QKV + col); y0 += w.x * bflo(xw); y1 += w.y * bfhi(xw); } }
            res[p][0] = silu_f(y0); res[p][1] = silu_f(y1); }
        const float sq = wave_sum(res[0][0] * res[0][0] + res[0][1] * res[0][1]), sk = wave_sum(res[1][0] * res[1][0] + res[1][1] * res[1][1]);
        const float iq = (1.0f / sqrtf(sq + EPS)) * 0.08838834764831845f, ik = 1.0f / sqrtf(sk + EPS);
        const size_t o = (size_t)tg * DN_KEY + h * 128 + d0;
        *(GAS f32x2*)(QF + o) = (f32x2){res[0][0] * iq, res[0][1] * iq}; *(GAS f32x2*)(KF + o) = (f32x2){res[1][0] * ik, res[1][1] * ik}; *(GAS f32x2*)(VF + o) = (f32x2){res[2][0], res[2][1]};
        if (lane == 0) { BETA[id] = sigmoid_f(PS[(size_t)tg * PSM + h]); GD[id] = -expf(F.in[I_DN_ALOG][h]) * softplus_f(PS[(size_t)tg * PSM + 16 + h] + F.in[I_DN_DTB][h]); }
    }
#else
    for (int ch = F.vcu; ch < BATCH * 32 * DN_H; ch += F.G) dn_prep_chunk(F, ch);
#endif
#if !CHUNK_GLA
    const float* wa2 = F.in[I_GL_WA2]; const float* ba = F.in[I_GL_BA];
    for (int id = gw; id < M * GL_H; id += NGW) {
        const int tg = id >> 3, h = id & 7, c = h * 128 + 2 * lane;
        f32x2 x = *(const GAS f32x2*)(ba + c);
#pragma unroll
        for (int r = 0; r < GL_RANK; ++r) { const float lr = PS[(size_t)tg * PSM + 32 + r]; const f32x2 w = *(const GAS f32x2*)(wa2 + (size_t)r * GL_KEY + c); x.x += lr * w.x; x.y += lr * w.y; }
        *(GAS f32x2*)(EK + (size_t)tg * GL_KEY + c) = (f32x2){expf(logsigmoid_f(x.x) * (1.f / 16.f)), expf(logsigmoid_f(x.y) * (1.f / 16.f))};
    }
#else
    for (int ch = F.vcu; ch < BATCH * 32 * GL_H; ch += F.G) gla_prep_chunk(F, ch);
#endif
}

__device__ __forceinline__ void p3_scan_naive(Frame& F, const int wg) {
    LAS float* sh = (LAS float*)(F.lds + RING_OFF);
    const int tid = F.tid;
    if (wg < 32) {
        const int sub = tid >> 8, tt = tid & 255, e = tt >> 1, half = tt & 1, bh = wg * 2 + sub, b = bh >> 4, h = bh & 15;
        const float* QF = (const float*)(F.ws + WS_QF); const float* KF = (const float*)(F.ws + WS_KF); const float* VF = (const float*)(F.ws + WS_VF);
        const float* BETA = (const float*)(F.ws + WS_BETA); const float* GD = (const float*)(F.ws + WS_G); float* ODN = (float*)(F.ws + WS_ODN);
        float S[64];
#pragma unroll
        for (int d = 0; d < 64; ++d) S[d] = 0.f;
        const float* KQ = (tt < 128) ? KF : QF;
        size_t o = (size_t)(b * SEQ) * DN_KEY + h * 128; int gi = (b * SEQ) * DN_H + h;
        float kqr = KQ[o + (tt & 127)], vr = VF[o + e], be = BETA[gi], gg = GD[gi];
        for (int t = 0; t < SEQ; ++t) {
            LAS float* kq = sh + ((t & 1) * 2 + sub) * 256;
            kq[tt] = kqr; const float v = vr, beta = be, decay = expf(gg); const size_t oc = o;
            if (t + 1 < SEQ) { o += DN_KEY; gi += DN_H; kqr = KQ[o + (tt & 127)]; vr = VF[o + e]; be = BETA[gi]; gg = GD[gi]; }
            __syncthreads();
            const LAS float* kp = kq + 64 * half; const LAS float* qp = kq + 128 + 64 * half;
            float ks0 = 0.f, ks1 = 0.f, ks2 = 0.f, ks3 = 0.f;
#pragma unroll
            for (int d = 0; d < 64; d += 4) { const f32x4 k4 = *(const LAS f32x4*)(kp + d); ks0 += k4.x * S[d]; ks1 += k4.y * S[d + 1]; ks2 += k4.z * S[d + 2]; ks3 += k4.w * S[d + 3]; }
            float ks = (ks0 + ks1) + (ks2 + ks3); ks += __shfl_xor(ks, 1);
            const float delta = beta * (v - decay * ks);
            float o0 = 0.f, o1 = 0.f, o2 = 0.f, o3 = 0.f;
#pragma unroll
            for (int d = 0; d < 64; d += 4) { const f32x4 k4 = *(const LAS f32x4*)(kp + d); const f32x4 q4 = *(const LAS f32x4*)(qp + d);
                S[d] = k4.x * delta + decay * S[d]; S[d + 1] = k4.y * delta + decay * S[d + 1]; S[d + 2] = k4.z * delta + decay * S[d + 2]; S[d + 3] = k4.w * delta + decay * S[d + 3];
                o0 += q4.x * S[d]; o1 += q4.y * S[d + 1]; o2 += q4.z * S[d + 2]; o3 += q4.w * S[d + 3]; }
            float ov = (o0 + o1) + (o2 + o3); ov += __shfl_xor(ov, 1);
            if (half == 0) ODN[oc + e] = ov;
        }
    } else if (wg < 64) {
        const int e = tid >> 1, half = tid & 1, bh = wg - 32, b = bh >> 3, h = bh & 7;
        const bf16* PROJ = (const bf16*)(F.ws + WS_PROJ); const float* EK = (const float*)(F.ws + WS_EK); float* OGLA = (float*)(F.ws + WS_OGLA);
        float S[64];
#pragma unroll
        for (int d = 0; d < 64; ++d) S[d] = 0.f;
        const int ee = tid & 127, role = tid >> 7;
        size_t tg = (size_t)b * SEQ;
        float a0 = (role == 0) ? EK[tg * GL_KEY + h * 128 + ee] : (role == 1) ? bf1(PROJ[tg * PN + PC_GK + h * 128 + ee]) : bf1(PROJ[tg * PN + PC_GQ + h * 128 + ee]) * 0.08838834764831845f;
        float vr = bf1(PROJ[tg * PN + PC_GV + h * 256 + e]);
        for (int t = 0; t < SEQ; ++t) {
            LAS float* buf = sh + (t & 1) * 384;
            if (role < 3) buf[tid] = a0;
            const float v = vr; const size_t tc = tg;
            if (t + 1 < SEQ) { ++tg; a0 = (role == 0) ? EK[tg * GL_KEY + h * 128 + ee] : (role == 1) ? bf1(PROJ[tg * PN + PC_GK + h * 128 + ee]) : bf1(PROJ[tg * PN + PC_GQ + h * 128 + ee]) * 0.08838834764831845f;
                vr = bf1(PROJ[tg * PN + PC_GV + h * 256 + e]); }
            __syncthreads();
            const LAS float* gp = buf + 64 * half;
            float o0 = 0.f, o1 = 0.f, o2 = 0.f, o3 = 0.f;
#pragma unroll
            for (int d = 0; d < 64; d += 4) { const f32x4 g4 = *(const LAS f32x4*)(gp + d); const f32x4 k4 = *(const LAS f32x4*)(gp + 128 + d); const f32x4 q4 = *(const LAS f32x4*)(gp + 256 + d);
                S[d] = g4.x * S[d] + k4.x * v; S[d + 1] = g4.y * S[d + 1] + k4.y * v; S[d + 2] = g4.z * S[d + 2] + k4.z * v; S[d + 3] = g4.w * S[d + 3] + k4.w * v;
                o0 += q4.x * S[d]; o1 += q4.y * S[d + 1]; o2 += q4.z * S[d + 2]; o3 += q4.w * S[d + 3]; }
            float ov = (o0 + o1) + (o2 + o3); ov += __shfl_xor(ov, 1);
            if (half == 0) OGLA[tc * GL_VAL + h * 256 + e] = ov;
        }
    }
}

__device__ __forceinline__ void p4_gated_norm(Frame& F) {
    const int gw = F.vcu * NWAVES + F.wave, NGW = F.G * NWAVES, lane = F.lane;
    const bf16* PROJ = (const bf16*)(F.ws + WS_PROJ); const float* ODN = (const float*)(F.ws + WS_ODN); const float* OGLA = (const float*)(F.ws + WS_OGLA);
    bf16* ONDN = (bf16*)(F.ws + WS_ONDN); bf16* ONGLA = (bf16*)(F.ws + WS_ONGLA);
    const f32x2 wd = *(const GAS f32x2*)(F.in[I_DN_NORM] + 2 * lane); const f32x4 wg = *(const GAS f32x4*)(F.in[I_GL_NORM] + 4 * lane);
    for (int tg = gw; tg < M; tg += NGW) {
        f32x2 v[16]; unsigned z[16]; f32x4 u[8]; v2u r[8];
#pragma unroll
        for (int h = 0; h < 16; ++h) { v[h] = *(const GAS f32x2*)(ODN + (size_t)tg * DN_VAL + h * 128 + 2 * lane); z[h] = *(const GAS unsigned*)(PROJ + (size_t)tg * PN + PC_Z + h * 128 + 2 * lane); }
#pragma unroll
        for (int h = 0; h < 8; ++h) { u[h] = *(const GAS f32x4*)(OGLA + (size_t)tg * GL_VAL + h * 256 + 4 * lane); r[h] = *(const GAS v2u*)(PROJ + (size_t)tg * PN + PC_GR + h * 256 + 4 * lane); }
#pragma unroll
        for (int h = 0; h < 16; ++h) { const float rstd = 1.0f / sqrtf(wave_sum(v[h].x * v[h].x + v[h].y * v[h].y) * (1.f / 128.f) + EPS);
            *(GAS unsigned*)(ONDN + (size_t)tg * DN_VAL + h * 128 + 2 * lane) = pk2(v[h].x * rstd * wd.x * silu_fast(bflo(z[h])), v[h].y * rstd * wd.y * silu_fast(bfhi(z[h]))); }
#pragma unroll
        for (int h = 0; h < 8; ++h) { const float rstd = 1.0f / sqrtf(wave_sum((u[h].x * u[h].x + u[h].y * u[h].y) + (u[h].z * u[h].z + u[h].w * u[h].w)) * (1.f / 256.f) + EPS);
            v2u ob; ob.x = pk2(u[h].x * rstd * wg.x * silu_fast(bflo(r[h].x)), u[h].y * rstd * wg.y * silu_fast(bfhi(r[h].x))); ob.y = pk2(u[h].z * rstd * wg.z * silu_fast(bflo(r[h].y)), u[h].w * rstd * wg.w * silu_fast(bfhi(r[h].y)));
            *(GAS v2u*)(ONGLA + (size_t)tg * GL_VAL + h * 256 + 4 * lane) = ob; }
    }
}

__device__ __forceinline__ void p9_glu_fixup(Frame& F) {
    bf16* HID = (bf16*)(F.ws + WS_HID); const float* GTAIL = (const float*)(F.ws + WS_GTAIL); const float* GHEAD = (const float*)(F.ws + WS_GHEAD); const float* UHEAD = (const float*)(F.ws + WS_UHEAD);
    const float* cw = F.in[I_FFN_CW]; const float* cb = F.in[I_FFN_CB];
    const int gt = F.vcu * (NWAVES * 64) + F.tid, NT = F.G * NWAVES * 64;
    constexpr int CG = DFF / 4;
    for (int id = gt; id < (M / 256) * 2 * CG; id += NT) {
        const int pm = id / (2 * CG), rr = (id / CG) & 1, c0 = 4 * (id % CG);
        const bool first = (pm & 7) == 0;
        const f32x4 z = (f32x4){0.f, 0.f, 0.f, 0.f};
        const f32x4 t0 = first ? z : *(const GAS f32x4*)(GTAIL + ((size_t)(first ? 0 : pm - 1) * 2 + 0) * DFF + c0), t1 = first ? z : *(const GAS f32x4*)(GTAIL + ((size_t)(first ? 0 : pm - 1) * 2 + 1) * DFF + c0);
        const f32x4 h0 = *(const GAS f32x4*)(GHEAD + ((size_t)pm * 2 + 0) * DFF + c0), h1 = *(const GAS f32x4*)(GHEAD + ((size_t)pm * 2 + 1) * DFF + c0);
        const f32x4 up = *(const GAS f32x4*)(UHEAD + ((size_t)pm * 2 + rr) * DFF + c0);
        const f32x4 w0 = *(const GAS f32x4*)(cw + c0), w1 = *(const GAS f32x4*)(cw + DFF + c0), w2 = *(const GAS f32x4*)(cw + 2 * DFF + c0), bb = *(const GAS f32x4*)(cb + c0);
        const f32x4 g2 = rr ? t1 : t0, g1 = rr ? h0 : t1, g0 = rr ? h1 : h0;
        const f32x4 y = bb + w0 * g2 + w1 * g1 + w2 * g0;
        v2u o; o.x = pk2(silu_fast(y.x) * up.x, silu_fast(y.y) * up.y); o.y = pk2(silu_fast(y.z) * up.z, silu_fast(y.w) * up.w);
        *(GAS v2u*)(HID + (size_t)(pm * 256 + rr) * DFF + c0) = o;
    }
}

#ifndef MK_ONE_LAUNCH
#define MK_ONE_LAUNCH 0
#endif
constexpr int N_PHASES = 12;
struct Args { const float* in[19]; float* out; unsigned char* ws; int ph_lo, ph_hi; };
__global__ void __launch_bounds__(NWAVES * 64, 2) mk_fwd(Args args) {
    extern __shared__ __attribute__((aligned(16))) unsigned char lds[];
    Frame F;
    F.lds = (LAS unsigned char*)lds;
    F.MISC = (volatile LAS unsigned*)(F.lds + MISC_OFF);
    F.tid = threadIdx.x; F.lane = F.tid & 63; F.wave = __builtin_amdgcn_readfirstlane(F.tid >> 6);
    F.G = gridDim.x; { const int bx = blockIdx.x; F.vcu = (F.G % 8 == 0) ? (bx % 8) * (F.G / 8) + bx / 8 : bx; }
    for (int u = F.tid; u < (LDS_BYTES - LDSCTL_OFF) / 4; u += NWAVES * 64) ((LAS unsigned*)(F.lds + LDSCTL_OFF))[u] = 0u;
    __syncthreads();
    if (F.tid == 0) { LAS unsigned long long* P = (LAS unsigned long long*)(F.lds + PTR_OFF);
#pragma unroll
        for (int i = 0; i < 19; ++i) P[i] = (unsigned long long)args.in[i];
        P[19] = (unsigned long long)args.out; P[20] = (unsigned long long)args.ws; }
    __syncthreads();
    frame_reload(F);
    XcdBarrier bar; bar.bar = (unsigned*)(F.ctl + CW_BAR); bar.x = 0; bar.st = nullptr;
    if (MK_ONE_LAUNCH) bar = xcd_barrier_post((unsigned*)(F.ctl + CW_BAR), F.MISC + 8);
    const int lo = args.ph_lo, hi = args.ph_hi;
#define IN(k) (lo <= (k) && (k) < hi)
#define SEAM(k) do { if (IN(k) && IN((k) + 1) && (k) != 7) xcd_barrier(bar); } while (0)

#ifndef PROBE_MASK
#define PROBE_MASK 0
#endif
#define RUN_PHASE(k, ...) do { if (IN(k)) { frame_reload(F); bf16* H = (bf16*)(F.ws + WS_H); bf16* PROJ = (bf16*)(F.ws + WS_PROJ); (void)H; (void)PROJ; __VA_ARGS__ } if ((PROBE_MASK >> (k)) & 1) { if (IN(k)) { frame_reload(F); bf16* H = (bf16*)(F.ws + WS_H); bf16* PROJ = (bf16*)(F.ws + WS_PROJ); (void)H; (void)PROJ; __VA_ARGS__ } } } while (0)
    RUN_PHASE(0, p0_prologue(F);); SEAM(0);
    RUN_PHASE(1,
        p1_skinny(F);
        pg8::Gemm g{H, (const bf16*)(F.ws + WS_WIN), M, PN, D}; pg8::StaticOrder S; S.init(M, PN, F.G, (int)blockIdx.x);
        pg8::Epi<pg8::EPI_BF16> E{PROJ, PN, nullptr, 0, nullptr, 0, nullptr, 0};
        pg8::gemm_phase<pg8::Epi<pg8::EPI_BF16>, pg8::StaticOrder, true, true>(F.lds + RING_OFF, g, S, E);
    ); SEAM(1);
    RUN_PHASE(2, p2_prep(F);); SEAM(2);
    RUN_PHASE(3,
        for (int task = F.vcu; task < 256; task += F.G) {
            if (task < 128) {
#if CHUNK_DN
                scan_task<true>(F, task >> 1, task & 1);
#else
                if (task < 32) p3_scan_naive(F, task);
#endif
            } else {
#if CHUNK_GLA
                scan_task<false>(F, (task - 128) >> 2, (task - 128) & 3);
#else
                if (task < 160) p3_scan_naive(F, task - 96);
#endif
            }
        }
    ); SEAM(3);
    RUN_PHASE(4, p4_gated_norm(F);); SEAM(4);
    RUN_PHASE(5,
        { pg8::Gemm g{(const bf16*)(F.ws + WS_ONDN), (const bf16*)(F.ws + WS_WBDN), M, D, DN_VAL}; pg8::StaticOrder S; S.init(M, D, F.G, (int)blockIdx.x);
          pg8::Epi<pg8::EPI_BRA> E{nullptr, 0, (float*)(F.ws + WS_TMP), D, nullptr, 0, PROJ + PC_GATE_DN, PN};
          pg8::gemm_phase<pg8::Epi<pg8::EPI_BRA>, pg8::StaticOrder, true, true>(F.lds + RING_OFF, g, S, E); }
        { pg8::Gemm g{(const bf16*)(F.ws + WS_ONGLA), (const bf16*)(F.ws + WS_WBGLA), M, D, GL_VAL}; pg8::StaticOrder S; S.init(M, D, F.G, (int)blockIdx.x);
          pg8::Epi<pg8::EPI_BRB> E{(bf16*)(F.ws + WS_MERGED), D, (float*)(F.ws + WS_TMP), D, nullptr, 0, PROJ + PC_GATE_GLA, PN};
          pg8::gemm_phase<pg8::Epi<pg8::EPI_BRB>, pg8::StaticOrder, true, true>(F.lds + RING_OFF, g, S, E); }
    ); SEAM(5);
    RUN_PHASE(6,
        pg8::Gemm g{(const bf16*)(F.ws + WS_MERGED), (const bf16*)(F.ws + WS_WOUT), M, D, D}; pg8::StaticOrder S; S.init(M, D, F.G, (int)blockIdx.x);
        pg8::EpiRes2 E{(float*)(F.ws + WS_X1), H, F.in[I_X], D, (unsigned long long*)(F.ws + WS_SSQ)};
        pg8::gemm_phase<pg8::EpiRes2, pg8::StaticOrder, true, true>(F.lds + RING_OFF, g, S, E);
    ); SEAM(6);
    RUN_PHASE(8,
        pg8::Gemm g{H, (const bf16*)(F.ws + WS_WFIN), M, NGU, D}; pg8::StaticOrder S; S.init(M, NGU, F.G, (int)blockIdx.x);
        pg8::EpiGlu E{(bf16*)(F.ws + WS_HID), DFF, F.in[I_FFN_CW], F.in[I_FFN_CB], DFF, (float*)(F.ws + WS_GTAIL), (float*)(F.ws + WS_GHEAD), (float*)(F.ws + WS_UHEAD), (LAS float*)(F.lds + XL_OFF), (const unsigned long long*)(F.ws + WS_SSQ)};
        pg8::gemm_phase<pg8::EpiGlu, pg8::StaticOrder, true, true>(F.lds + RING_OFF, g, S, E);
    ); SEAM(8);
    RUN_PHASE(9, p9_glu_fixup(F);); SEAM(9);
    RUN_PHASE(10,
        pg8::Gemm g{(const bf16*)(F.ws + WS_HID), (const bf16*)(F.ws + WS_WFOUT), M, D, DFF}; pg8::StaticOrder S; S.init(M, D, F.G, (int)blockIdx.x);
        pg8::Epi<pg8::EPI_RES> E{nullptr, 0, F.out, D, (const float*)(F.ws + WS_X1), D, nullptr, 0};
        pg8::gemm_phase<pg8::Epi<pg8::EPI_RES>, pg8::StaticOrder, true, true>(F.lds + RING_OFF, g, S, E);
    ); SEAM(10);
    if (IN(11)) { frame_reload(F); const int gw = F.vcu * NWAVES + F.wave, NGW = F.G * NWAVES;
        for (int m = gw; m < M; m += NGW) rms_row(F.out + (size_t)m * D, F.in[I_NORM_FIN], nullptr, F.out + (size_t)m * D, F.lane); }
#undef IN
#undef SEAM
}

extern "C" void kernel_launch(void* const* d_in, const int* in_sizes, int n_in, void* d_out, int out_size, void* d_ws, size_t ws_size, hipStream_t stream) {
    static int grid = 0;
    if (grid == 0) {
        if (n_in != 19 || in_sizes[0] != M * D || out_size != M * D || ws_size < WS_END) { fprintf(stderr, "kernel_launch: unexpected shapes: n_in %d in0 %d out %d ws %zu (need %zu)\n", n_in, n_in > 0 ? in_sizes[0] : -1, out_size, ws_size, (size_t)WS_END); grid = -1; return; }
        int dev = 0, cus = 0, per_cu = 0;
        if (hipGetDevice(&dev) != hipSuccess || hipDeviceGetAttribute(&cus, hipDeviceAttributeMultiprocessorCount, dev) != hipSuccess) { grid = -1; return; }
        if (hipFuncSetAttribute((const void*)mk_fwd, hipFuncAttributeMaxDynamicSharedMemorySize, LDS_BYTES) != hipSuccess) { fprintf(stderr, "kernel_launch: hipFuncSetAttribute failed\n"); grid = -1; return; }
        if (hipOccupancyMaxActiveBlocksPerMultiprocessor(&per_cu, (const void*)mk_fwd, NWAVES * 64, LDS_BYTES) != hipSuccess || per_cu < 1) fprintf(stderr, "kernel_launch: occupancy query says %d\n", per_cu);
        (void)hipGetLastError();
        grid = cus;
    }
    if (grid < 0) return;
    if (hipMemsetAsync((char*)d_ws + WS_CTL, 0, CTL_ZERO_BYTES, stream) != hipSuccess) return;
    Args a{};
    for (int i = 0; i < 19; ++i) a.in[i] = (const float*)d_in[i];
    a.out = (float*)d_out; a.ws = (unsigned char*)d_ws;
#if MK_ONE_LAUNCH
    a.ph_lo = 0; a.ph_hi = N_PHASES;
    hipLaunchKernelGGL(mk_fwd, dim3(grid), dim3(NWAVES * 64), LDS_BYTES, stream, a);
#else
    for (int p = 0; p < N_PHASES; ++p) { a.ph_lo = p; a.ph_hi = p + 1; hipLaunchKernelGGL(mk_fwd, dim3(grid), dim3(NWAVES * 64), LDS_BYTES, stream, a); }
#endif
}
```

```cpp
#define MK_ONE_LAUNCH 1
#include <hip/hip_runtime.h>
#include <cstdio>
#include <cstdint>
namespace pg8 {
#define PG8_LAS __attribute__((address_space(3)))
typedef unsigned short bf16_t;
typedef short bf16x8 __attribute__((ext_vector_type(8)));
typedef float f32x4 __attribute__((ext_vector_type(4)));
typedef unsigned u32x4 __attribute__((ext_vector_type(4)));
constexpr int BM = 256, BK = 64, HALF = 128, HTB = HALF * BK * 2  , STAGE_BYTES = 8 * HTB, NXCD = 8, WGM = 8;

__host__ __device__ __forceinline__ int lds_byte(int r, int c) { const int st = (r >> 4) * 2 + (c >> 5), rr = r & 15, cc = c & 31, ob = rr * 64 + cc * 2; return st * 1024 + (ob ^ (((ob >> 9) & 1) << 5)); }
__host__ __device__ __forceinline__ void stage_rc(int b, int& R, int& C) { const int st = b / 1024, sb = b % 1024, swz = sb ^ (((sb >> 9) & 1) << 5); R = (st >> 1) * 16 + swz / 64; C = (st & 1) * 32 + (swz % 64) / 2; }
__host__ __device__ __forceinline__ int perm32(int rho) { const int n = rho >> 4, i = rho & 15; return 8 * (i >> 2) + 4 * n + (i & 3); }

struct Unit { int pm, pn; };
struct Gemm { const bf16_t* A; const bf16_t* Bt; int M, N, K, ld; };

struct StaticOrder {
    int nM, nN, nwg, G, c;
    __host__ __device__ void init(int M, int N, int G_, int c_) { nM = M / BM; nN = N / BM; nwg = nM * nN; G = G_; c = c_; }
    __host__ __device__ bool next(int i, Unit& u) const {
        const long L = (long)i * G + c; if (L >= nwg) return false;
        int wgid = (int)L; { const int q = nwg / NXCD, r = nwg % NXCD, xcd = wgid % NXCD, off = wgid / NXCD; wgid = (xcd < r ? xcd * (q + 1) : r * (q + 1) + (xcd - r) * q) + off; }
        const int nig = WGM * nN, gid = wgid / nig, fm = gid * WGM, gsz = (nM - fm) < WGM ? (nM - fm) : WGM;
        u.pm = fm + ((wgid % nig) % gsz); u.pn = (wgid % nig) / gsz; return true;
    }
    __device__ __forceinline__ void a_ready(const Unit&) const {}
    __device__ __forceinline__ void done(const Unit&) const {}
};

__device__ __forceinline__ unsigned cvt_pk_bf16(float lo, float hi) { unsigned r; asm volatile("v_cvt_pk_bf16_f32 %0, %1, %2" : "=v"(r) : "v"(lo), "v"(hi)); return r; }
__device__ __forceinline__ float bf_lo(unsigned w) { return __uint_as_float(w << 16); }
__device__ __forceinline__ float bf_hi(unsigned w) { return __uint_as_float(w & 0xffff0000u); }
__device__ __forceinline__ float sigm(float x) { return __builtin_amdgcn_rcpf(1.0f + __expf(-x)); }
template <int N> __device__ __forceinline__ float dpp_shr(float old, float x) { return __int_as_float(__builtin_amdgcn_update_dpp(__float_as_int(old), __float_as_int(x), 0x110 + N, 0xf, 0xf, false)); }
template <int N> __device__ __forceinline__ float dpp_shl(float x) { return __int_as_float(__builtin_amdgcn_update_dpp(0, __float_as_int(x), 0x100 + N, 0xf, 0xf, true)); }
#define PG8_DPP_SHR(old, x, n) dpp_shr<n>((old), (x))
#define PG8_DPP_SHL(x, n) dpp_shl<n>((x))
enum { EPI_BF16 = 0, EPI_BRA = 1, EPI_BRB = 2, EPI_RES = 3 };
template <int MODE> struct Epi {
    static constexpr bool PERM = true, AFTER_DRAIN = false;
    bf16_t* Ob; int ldo; float* Of; int ldf; const bf16_t* Rb; int ldr; const bf16_t* Gt; int ldg; bf16_t* Tb; int ldt;
    __device__ __forceinline__ void operator()(const f32x4 (&acc)[2][2][4][2], const Unit& u, int wr, int wc, int fr, int fq) const {
        const int row0 = u.pm * BM + wr * 64 + fr, col0 = u.pn * BM + wc * 32 + 8 * fq;
#pragma unroll
        for (int ai = 0; ai < 2; ++ai)
#pragma unroll
            for (int m = 0; m < 4; ++m) { const size_t row = (size_t)(row0 + ai * HALF + m * 16);
#pragma unroll
                for (int bj = 0; bj < 2; ++bj) { const int col = col0 + bj * HALF; f32x4 v0 = acc[ai][bj][m][0], v1 = acc[ai][bj][m][1];
                    if (MODE == EPI_BRA || MODE == EPI_BRB) { const u32x4 g = *(const u32x4*)(Gt + row * ldg + col);
                        v0[0] *= sigm(bf_lo(g.x)); v0[1] *= sigm(bf_hi(g.x)); v0[2] *= sigm(bf_lo(g.y)); v0[3] *= sigm(bf_hi(g.y));
                        v1[0] *= sigm(bf_lo(g.z)); v1[1] *= sigm(bf_hi(g.z)); v1[2] *= sigm(bf_lo(g.w)); v1[3] *= sigm(bf_hi(g.w)); }
                    if (MODE == EPI_BRB) { const u32x4 t = *(const u32x4*)(Tb + row * ldt + col);
                        v0[0] += bf_lo(t.x); v0[1] += bf_hi(t.x); v0[2] += bf_lo(t.y); v0[3] += bf_hi(t.y); v1[0] += bf_lo(t.z); v1[1] += bf_hi(t.z); v1[2] += bf_lo(t.w); v1[3] += bf_hi(t.w); }
                    if (MODE == EPI_RES) { const u32x4 t = *(const u32x4*)(Rb + row * ldr + col);
                        v0[0] += bf_lo(t.x); v0[1] += bf_hi(t.x); v0[2] += bf_lo(t.y); v0[3] += bf_hi(t.y); v1[0] += bf_lo(t.z); v1[1] += bf_hi(t.z); v1[2] += bf_lo(t.w); v1[3] += bf_hi(t.w); }
                    if (MODE == EPI_RES) { float* o = Of + row * ldf + col; *(f32x4*)o = v0; *(f32x4*)(o + 4) = v1; }
                    else { u32x4 w; w.x = cvt_pk_bf16(v0[0], v0[1]); w.y = cvt_pk_bf16(v0[2], v0[3]); w.z = cvt_pk_bf16(v1[0], v1[1]); w.w = cvt_pk_bf16(v1[2], v1[3]);
                        if (MODE == EPI_BRA) *(u32x4*)(Tb + row * ldt + col) = w; else *(u32x4*)(Ob + row * ldo + col) = w; } }
                asm volatile("" ::: "memory"); }
    }
};

struct EpiRes2 {
    static constexpr bool PERM = true, AFTER_DRAIN = false;
    bf16_t* Xb; const float* R; int ld; int ldb; unsigned long long* ssq;
    __device__ __forceinline__ void operator()(const f32x4 (&acc)[2][2][4][2], const Unit& u, int wr, int wc, int fr, int fq) const {
        const int row0 = u.pm * BM + wr * 64 + fr, col0 = u.pn * BM + wc * 32 + 8 * fq;
#pragma unroll
        for (int ai = 0; ai < 2; ++ai)
#pragma unroll
            for (int m = 0; m < 4; ++m) { const size_t row = (size_t)(row0 + ai * HALF + m * 16); float ss = 0.f;
#pragma unroll
                for (int bj = 0; bj < 2; ++bj) { const int col = col0 + bj * HALF; const float* t = R + row * ld + col;
                    const f32x4 v0 = acc[ai][bj][m][0] + *(const f32x4*)t, v1 = acc[ai][bj][m][1] + *(const f32x4*)(t + 4);
                    u32x4 w; w.x = cvt_pk_bf16(v0[0], v0[1]); w.y = cvt_pk_bf16(v0[2], v0[3]); w.z = cvt_pk_bf16(v1[0], v1[1]); w.w = cvt_pk_bf16(v1[2], v1[3]);
                    *(u32x4*)(Xb + row * ldb + col) = w;
                    ss += (v0[0] * v0[0] + v0[1] * v0[1]) + (v0[2] * v0[2] + v0[3] * v0[3]) + (v1[0] * v1[0] + v1[1] * v1[1]) + (v1[2] * v1[2] + v1[3] * v1[3]); }
                ss += __shfl_xor(ss, 16); ss += __shfl_xor(ss, 32);
                if (fq == 0) atomicAdd(ssq + row, (unsigned long long)(ss * 16777216.0f + 0.5f));
                asm volatile("" ::: "memory"); }
    }
};

struct EpiGlu {
    static constexpr bool PERM = true, AFTER_DRAIN = false;
    bf16_t* HID; int ldh; const float* cw; const float* cb; int nch; float* GTAIL; float* GHEAD; float* UHEAD; PG8_LAS float* xl; const unsigned long long* ssq;
    __device__ __forceinline__ void operator()(f32x4 (&acc)[2][2][4][2], const Unit& u, int wr, int wc, int fr, int fq) const {
        const int ch0 = u.pn * 128 + wc * 32 + 8 * fq;
#pragma unroll
        for (int ai = 0; ai < 2; ++ai)
#pragma unroll
            for (int m = 0; m < 4; ++m) { const float rs = 1.0f / sqrtf((float)ssq[u.pm * BM + ai * HALF + wr * 64 + m * 16 + fr] * (1.0f / (16777216.0f * 4096.0f)) + 1e-6f);
#pragma unroll
                for (int bj = 0; bj < 2; ++bj) { acc[ai][bj][m][0] *= rs; acc[ai][bj][m][1] *= rs; } }
        if (fr >= 14) {
#pragma unroll
            for (int ai = 0; ai < 2; ++ai) { PG8_LAS float* d = xl + ((wr * 4 + wc) * 2 + ai) * 64 + (fr - 14) * 32 + 8 * fq; *(PG8_LAS f32x4*)d = acc[ai][0][3][0]; *(PG8_LAS f32x4*)(d + 4) = acc[ai][0][3][1]; }
        }
        asm volatile("s_waitcnt lgkmcnt(0)" ::: "memory"); __builtin_amdgcn_s_barrier(); asm volatile("" ::: "memory");
        f32x4 w[3][2], bb[2];
#pragma unroll
        for (int k = 0; k < 3; ++k) { w[k][0] = *(const f32x4*)(cw + (size_t)k * nch + ch0); w[k][1] = *(const f32x4*)(cw + (size_t)k * nch + ch0 + 4); }
        bb[0] = *(const f32x4*)(cb + ch0); bb[1] = *(const f32x4*)(cb + ch0 + 4);
#pragma unroll
        for (int ai = 0; ai < 2; ++ai) {
            f32x4 p1[2], p2[2];
            { f32x4 t0 = (f32x4){0.f, 0.f, 0.f, 0.f}, t1 = t0;
              if (!(ai == 0 && wr == 0)) { const int pwr = wr ^ 1, pai = (wr == 1) ? ai : ai - 1; const PG8_LAS float* sp = xl + ((pwr * 4 + wc) * 2 + pai) * 64 + (fr & 1) * 32 + 8 * fq; t0 = *(const PG8_LAS f32x4*)sp; t1 = *(const PG8_LAS f32x4*)(sp + 4); }
#pragma unroll
              for (int j = 0; j < 4; ++j) { p1[0][j] = PG8_DPP_SHL(t0[j], 15); p1[1][j] = PG8_DPP_SHL(t1[j], 15); p2[0][j] = PG8_DPP_SHL(t0[j], 14); p2[1][j] = PG8_DPP_SHL(t1[j], 14); } }
#pragma unroll
            for (int m = 0; m < 4; ++m) {
                const size_t row = (size_t)(u.pm * BM + ai * HALF + wr * 64 + m * 16 + fr);
                f32x4 hv[2];
#pragma unroll
                for (int n = 0; n < 2; ++n)
#pragma unroll
                    for (int j = 0; j < 4; ++j) { const float g = acc[ai][0][m][n][j];
                        const float g1 = PG8_DPP_SHR(p1[n][j], g, 1), g2 = PG8_DPP_SHR(p2[n][j], g, 2);
                        p1[n][j] = PG8_DPP_SHL(g, 15); p2[n][j] = PG8_DPP_SHL(g, 14);
                        const float y = bb[n][j] + w[0][n][j] * g2 + w[1][n][j] * g1 + w[2][n][j] * g;
                        hv[n][j] = y * __builtin_amdgcn_rcpf(1.0f + __expf(-y)) * acc[ai][1][m][n][j]; }
                u32x4 o; o.x = cvt_pk_bf16(hv[0][0], hv[0][1]); o.y = cvt_pk_bf16(hv[0][2], hv[0][3]); o.z = cvt_pk_bf16(hv[1][0], hv[1][1]); o.w = cvt_pk_bf16(hv[1][2], hv[1][3]);
                *(u32x4*)(HID + row * ldh + ch0) = o;
            }
        }
        if (wr == 0 && fr < 2) { float* g = GHEAD + ((size_t)u.pm * 2 + fr) * nch + ch0; float* q = UHEAD + ((size_t)u.pm * 2 + fr) * nch + ch0;
            *(f32x4*)g = acc[0][0][0][0]; *(f32x4*)(g + 4) = acc[0][0][0][1]; *(f32x4*)q = acc[0][1][0][0]; *(f32x4*)(q + 4) = acc[0][1][0][1]; }
        if (wr == 1 && fr >= 14) { float* g = GTAIL + ((size_t)u.pm * 2 + (fr - 14)) * nch + ch0; *(f32x4*)g = acc[1][0][3][0]; *(f32x4*)(g + 4) = acc[1][0][3][1]; }
    }
};

template <class Epi, class Sched, bool ALIGN_EPI = false, bool SP2 = false>
__device__ __forceinline__ void gemm_phase(PG8_LAS unsigned char* lds, const Gemm g, const Sched& S, const Epi& E) {
    const int tid = threadIdx.x, wid = __builtin_amdgcn_readfirstlane(tid >> 6), lane = tid & 63, wr = wid >> 2, wc = wid & 3, fr = lane & 15, fq = lane >> 4;
    const int K = g.K, nt = K / BK, LD = g.ld;
    unsigned voffA[2], voffB[2];
#pragma unroll
    for (int i = 0; i < 2; ++i) { int R, C; stage_rc(tid * 16 + i * 8192, R, C); const int Rb = Epi::PERM ? ((R & ~31) + perm32(R & 31)) : R;
        voffA[i] = (unsigned)(R * LD + C) * 2u; voffB[i] = (unsigned)(Rb * LD + C) * 2u; }
    const size_t kstep = (size_t)(BK * 2);
    const size_t hstep = (size_t)HALF * LD * 2;
    const size_t tstep = 2 * hstep;
    const unsigned ldsw = (unsigned)wid * 1024u;
    const int aoff = lds_byte(wr * 64 + fr, fq * 8), boff = lds_byte(wc * 32 + fr, fq * 8);
#define PG8_SA(b, h) (((b) * 2 + (h)) * HTB)
#define PG8_SB(b, h) ((4 + (b) * 2 + (h)) * HTB)
#define PG8_STAGE(bufoff, gbase, voff) do { _Pragma("unroll") for (int _i = 0; _i < 2; ++_i) \
        __builtin_amdgcn_global_load_lds((const unsigned*)((const char*)(gbase) + (voff)[_i]), (PG8_LAS unsigned*)(lds + (bufoff) + ldsw + _i * 8192), 16, 0, 0); } while (0)
#define PG8_LDA(dst, b, h) do { _Pragma("unroll") for (int m = 0; m < 4; ++m) _Pragma("unroll") for (int k = 0; k < 2; ++k) dst[m][k] = *(const PG8_LAS bf16x8*)(lds + PG8_SA(b, h) + aoff + m * 2048 + k * 1024); } while (0)
#define PG8_LDB(dst, b, h) do { _Pragma("unroll") for (int n = 0; n < 2; ++n) _Pragma("unroll") for (int k = 0; k < 2; ++k) dst[n][k] = *(const PG8_LAS bf16x8*)(lds + PG8_SB(b, h) + boff + n * 2048 + k * 1024); } while (0)
#define PG8_MMA(ai, bj, At, Bt) do { __builtin_amdgcn_s_setprio(1); _Pragma("unroll") for (int m = 0; m < 4; ++m) _Pragma("unroll") for (int n = 0; n < 2; ++n) _Pragma("unroll") for (int k = 0; k < 2; ++k) \
        acc[ai][bj][m][n] = __builtin_amdgcn_mfma_f32_16x16x32_bf16(Bt[n][k], At[m][k], acc[ai][bj][m][n], 0, 0, 0); __builtin_amdgcn_s_setprio(0); } while (0)
#define PG8_WAIT_V(n) asm volatile("s_waitcnt vmcnt(" #n ")" ::: "memory")
#define PG8_WAIT_L(n) asm volatile("s_waitcnt lgkmcnt(" #n ")" ::: "memory")
#define PG8_BAR __builtin_amdgcn_s_barrier()
#define PG8_SCHED __builtin_amdgcn_sched_barrier(0)
    Unit cur, nxt; int ui = 0;
    if (!S.next(0, cur)) return;
    f32x4 acc[2][2][4][2];
#pragma unroll
    for (int a = 0; a < 2; ++a)
#pragma unroll
        for (int b = 0; b < 2; ++b)
#pragma unroll
            for (int m = 0; m < 4; ++m)
#pragma unroll
                for (int n = 0; n < 2; ++n) acc[a][b][m][n] = (f32x4){0.f, 0.f, 0.f, 0.f};
    bf16x8 At[4][2], B0[2][2], B1[2][2];
    const char* cA = (const char*)g.A + (size_t)cur.pm * tstep; const char* cB = (const char*)g.Bt + (size_t)cur.pn * tstep;
    S.a_ready(cur);
    if constexpr (SP2) {
        PG8_STAGE(PG8_SB(0, 0), cB, voffB); PG8_STAGE(PG8_SB(0, 1), cB + hstep, voffB); PG8_STAGE(PG8_SA(0, 0), cA, voffA); PG8_STAGE(PG8_SA(0, 1), cA + hstep, voffA);
        if (wr == 1) PG8_BAR;
        PG8_WAIT_V(2); PG8_BAR;
        PG8_STAGE(PG8_SB(1, 0), cB + kstep, voffB); PG8_STAGE(PG8_SA(1, 0), cA + kstep, voffA); PG8_STAGE(PG8_SB(1, 1), cB + hstep + kstep, voffB);
        PG8_WAIT_V(6); PG8_BAR;
    } else {
        PG8_STAGE(PG8_SB(0, 0), cB, voffB); PG8_STAGE(PG8_SA(0, 0), cA, voffA); PG8_STAGE(PG8_SB(0, 1), cB + hstep, voffB); PG8_STAGE(PG8_SA(0, 1), cA + hstep, voffA);
        if (wr == 1) PG8_BAR;
        PG8_WAIT_V(4); PG8_BAR;
        PG8_STAGE(PG8_SB(1, 0), cB + kstep, voffB); PG8_STAGE(PG8_SA(1, 0), cA + kstep, voffA); PG8_STAGE(PG8_SB(1, 1), cB + hstep + kstep, voffB);
        PG8_WAIT_V(6); PG8_BAR;
    }
    for (;;) {
        const bool has_next = S.next(ui + 1, nxt);
        const char* nA = has_next ? (const char*)g.A + (size_t)nxt.pm * tstep : cA; const char* nB = has_next ? (const char*)g.Bt + (size_t)nxt.pn * tstep : cB;
        for (int t = 0; t < nt; t += 2) {
            const bool last = (t == nt - 2);
            const char* a1 = cA + (size_t)(t + 1) * kstep;
            const char* a2 = last ? nA : cA + (size_t)(t + 2) * kstep; const char* b2 = last ? nB : cB + (size_t)(t + 2) * kstep;
            const char* a3 = a2 + kstep; const char* b3 = b2 + kstep;
            if (last && has_next) S.a_ready(nxt);
            if constexpr (SP2) {
            PG8_LDB(B0, 0, 0); PG8_LDB(B1, 0, 1); PG8_SCHED; PG8_LDA(At, 0, 0); PG8_STAGE(PG8_SA(1, 1), a1 + hstep, voffA);
            PG8_WAIT_V(8); PG8_WAIT_L(0); PG8_BAR; PG8_MMA(0, 0, At, B0); PG8_MMA(0, 1, At, B1); PG8_BAR; PG8_SCHED;
            PG8_LDA(At, 0, 1); PG8_STAGE(PG8_SB(0, 0), b2, voffB); PG8_STAGE(PG8_SB(0, 1), b2 + hstep, voffB); PG8_STAGE(PG8_SA(0, 0), a2, voffA);
            PG8_WAIT_V(8); PG8_WAIT_L(0); PG8_BAR; PG8_MMA(1, 0, At, B0); PG8_MMA(1, 1, At, B1); PG8_BAR; PG8_SCHED;
            PG8_LDB(B0, 1, 0); PG8_LDB(B1, 1, 1); PG8_SCHED; PG8_LDA(At, 1, 0); PG8_STAGE(PG8_SA(0, 1), a2 + hstep, voffA);
            PG8_WAIT_V(8); PG8_WAIT_L(0); PG8_BAR; PG8_MMA(0, 0, At, B0); PG8_MMA(0, 1, At, B1); PG8_BAR; PG8_SCHED;
            PG8_LDA(At, 1, 1); PG8_STAGE(PG8_SB(1, 0), b3, voffB); PG8_STAGE(PG8_SB(1, 1), b3 + hstep, voffB); PG8_STAGE(PG8_SA(1, 0), a3, voffA);
            PG8_WAIT_V(8); PG8_WAIT_L(0); PG8_BAR; PG8_MMA(1, 0, At, B0); PG8_MMA(1, 1, At, B1); PG8_BAR; PG8_SCHED;
            } else {
            PG8_LDB(B0, 0, 0); PG8_SCHED; PG8_LDA(At, 0, 0); PG8_STAGE(PG8_SA(1, 1), a1 + hstep, voffA);
            PG8_WAIT_L(8); PG8_BAR; PG8_WAIT_L(0); PG8_MMA(0, 0, At, B0); PG8_BAR; PG8_SCHED;
            PG8_LDB(B1, 0, 1); PG8_STAGE(PG8_SB(0, 0), b2, voffB);
            PG8_BAR; PG8_WAIT_L(0); PG8_MMA(0, 1, At, B1); PG8_BAR;
            PG8_LDA(At, 0, 1); PG8_STAGE(PG8_SA(0, 0), a2, voffA);
            PG8_BAR; PG8_WAIT_L(0); PG8_MMA(1, 0, At, B0); PG8_BAR; PG8_SCHED;
            PG8_STAGE(PG8_SB(0, 1), b2 + hstep, voffB);
            PG8_WAIT_V(6); PG8_BAR; PG8_MMA(1, 1, At, B1); PG8_BAR;
            PG8_LDB(B0, 1, 0); PG8_SCHED; PG8_LDA(At, 1, 0); PG8_STAGE(PG8_SA(0, 1), a2 + hstep, voffA);
            PG8_WAIT_L(8); PG8_BAR; PG8_WAIT_L(0); PG8_MMA(0, 0, At, B0); PG8_BAR; PG8_SCHED;
            PG8_LDB(B1, 1, 1); PG8_STAGE(PG8_SB(1, 0), b3, voffB);
            PG8_BAR; PG8_WAIT_L(0); PG8_MMA(0, 1, At, B1); PG8_BAR;
            PG8_LDA(At, 1, 1); PG8_STAGE(PG8_SA(1, 0), a3, voffA);
            PG8_BAR; PG8_WAIT_L(0); PG8_MMA(1, 0, At, B0); PG8_BAR; PG8_SCHED;
            PG8_STAGE(PG8_SB(1, 1), b3 + hstep, voffB);
            PG8_WAIT_V(6); PG8_BAR; PG8_MMA(1, 1, At, B1); PG8_BAR;
            }
        }
        if constexpr (ALIGN_EPI) { if (wr == 0) PG8_BAR; }
        if constexpr (!Epi::AFTER_DRAIN) { E(acc, cur, wr, wc, fr, fq); S.done(cur); }
        if (!has_next) break;
#pragma unroll
        for (int a = 0; a < 2; ++a)
#pragma unroll
            for (int b = 0; b < 2; ++b)
#pragma unroll
                for (int m = 0; m < 4; ++m)
#pragma unroll
                    for (int n = 0; n < 2; ++n) acc[a][b][m][n] = (f32x4){0.f, 0.f, 0.f, 0.f};
        cur = nxt; cA = nA; cB = nB; ++ui;
        if constexpr (ALIGN_EPI) { if (wr == 1) PG8_BAR; }
    }
    PG8_WAIT_V(0);
    if constexpr (!ALIGN_EPI) { if (wr == 0) PG8_BAR; }
    PG8_BAR;
    if constexpr (Epi::AFTER_DRAIN) { E.fused(acc, cur, wr, wc, fr, fq, lds, wid, lane); S.done(cur); }
#undef PG8_SA
#undef PG8_SB
#undef PG8_STAGE
#undef PG8_LDA
#undef PG8_LDB
#undef PG8_MMA
#undef PG8_WAIT_V
#undef PG8_WAIT_L
#undef PG8_BAR
#undef PG8_SCHED
}
}

constexpr int NWAVES = 8;
constexpr int BATCH = 4, SEQ = 2048, D = 4096, M = BATCH * SEQ;
constexpr int DN_H = 16, DN_DK = 128, DN_DV = 128, DN_KEY = 2048, DN_VAL = 2048, DN_QKV = 6144;
constexpr int GL_H = 8, GL_DK = 128, GL_DV = 256, GL_KEY = 1024, GL_VAL = 2048, GL_RANK = 16;
constexpr int DFF = 11008, IN_COLS = 22576;
constexpr float EPS = 1e-6f;
constexpr int PN = 22528;
constexpr int PC_QKV = 0, PC_Z = 6144, PC_GQ = 8192, PC_GK = 9216, PC_GV = 10240, PC_GR = 12288, PC_GATE_DN = 14336, PC_GATE_GLA = 18432;
constexpr int PSM = 64;
constexpr int NGU = 2 * DFF;

constexpr size_t MiB = 1u << 20;
constexpr size_t WS_CTL = 0, CTL_ZERO_BYTES = 1 * MiB;
constexpr int LDK4 = D + 64, LDK2 = 2048 + 64;
constexpr size_t WS_WIN = 1 * MiB, WS_WSM = 181 * MiB, WS_WBDN = 182 * MiB, WS_WBGLA = 199 * MiB, WS_WOUT = 216 * MiB, WS_WFIN = 249 * MiB, WS_WFOUT = 425 * MiB;
constexpr size_t WS_H = 511 * MiB, WS_PROJ = 577 * MiB, WS_PSMALL = 929 * MiB;
constexpr size_t WS_DW = 931 * MiB, WS_DQE = 963 * MiB, WS_DKT = 995 * MiB, WS_DAT = 1027 * MiB, WS_DU = 1043 * MiB, WS_DDL = 1107 * MiB;
constexpr size_t WS_GQE = 1108 * MiB, WS_GKT = 1124 * MiB, WS_GAT = 1140 * MiB, WS_GVT = 1148 * MiB, WS_GDL = 1180 * MiB;
constexpr size_t WS_EK = 1181 * MiB;
constexpr size_t WS_QF = 931 * MiB, WS_KF = 995 * MiB, WS_VF = 1059 * MiB, WS_BETA = 1107 * MiB, WS_G = WS_BETA + 512 * 1024;
constexpr size_t WS_ODN = 1213 * MiB, WS_OGLA = 1277 * MiB, WS_ONDN = 1341 * MiB, WS_ONGLA = 1375 * MiB, WS_END = 1409 * MiB;
constexpr size_t WS_TMP = 931 * MiB, WS_MERGED = 1059 * MiB, WS_X1 = 1125 * MiB, WS_GU = WS_PROJ, WS_HID = WS_WIN;
static_assert(WS_WIN + (size_t)PN * LDK4 * 2 <= WS_WSM && WS_WBDN + (size_t)D * LDK2 * 2 <= WS_WBGLA && WS_WOUT + (size_t)D * LDK4 * 2 <= WS_WFIN && WS_WFIN + (size_t)NGU * LDK4 * 2 <= WS_WFOUT && WS_WFOUT + (size_t)D * DFF * 2 <= WS_H && WS_H + (size_t)M * LDK4 * 2 <= WS_PROJ, "ws map (weights)");
static_assert(WS_PROJ + (size_t)M * PN * 2 <= WS_PSMALL && WS_HID + (size_t)M * DFF * 2 <= WS_WSM && WS_MERGED + (size_t)M * LDK4 * 2 <= WS_X1 && WS_ONDN + (size_t)M * LDK2 * 2 <= WS_ONGLA && WS_ONGLA + (size_t)M * LDK2 * 2 <= WS_END, "ws map (activations)");
static_assert(WS_X1 + (size_t)M * D * 4 <= WS_ONDN, "ws map (x1)");
constexpr size_t WS_GTAIL = WS_MERGED, WS_GHEAD = WS_MERGED + 4 * MiB, WS_UHEAD = WS_MERGED + 8 * MiB;
constexpr size_t WS_SSQ = WS_CTL + 256 * 1024;
constexpr int CW_BAR = 4096;

constexpr int RING_OFF = 0, RING_BYTES = 131072;
constexpr int LDSCTL_OFF = RING_BYTES, MISC_OFF = LDSCTL_OFF + 320;
constexpr int PTR_OFF = LDSCTL_OFF + 512;
constexpr int XL_OFF = LDSCTL_OFF + 1024;
constexpr int LDS_BYTES = 147456;

#define GAS __attribute__((address_space(1)))
#define LAS __attribute__((address_space(3)))
typedef unsigned short bf16;
typedef unsigned v4u __attribute__((ext_vector_type(4)));
typedef unsigned v2u __attribute__((ext_vector_type(2)));
typedef float f32x4 __attribute__((ext_vector_type(4)));
typedef float f32x2 __attribute__((ext_vector_type(2)));
typedef short bf16x8 __attribute__((ext_vector_type(8)));
typedef GAS unsigned gu32;
#define RLX_AGENT __ATOMIC_RELAXED, __HIP_MEMORY_SCOPE_AGENT
#define LDS_WAIT() asm volatile("s_waitcnt lgkmcnt(0)" ::: "memory")
#define VM_WAIT() asm volatile("s_waitcnt vmcnt(0)" ::: "memory")
__device__ __forceinline__ unsigned f2bf(float f) { unsigned u = __builtin_bit_cast(unsigned, f); return (u + 0x7fffu + ((u >> 16) & 1u)) >> 16; }
__device__ __forceinline__ unsigned pk2(float lo, float hi) { return f2bf(lo) | (f2bf(hi) << 16); }
__device__ __forceinline__ float bflo(unsigned w) { return __uint_as_float(w << 16); }
__device__ __forceinline__ float bfhi(unsigned w) { return __uint_as_float(w & 0xffff0000u); }
__device__ __forceinline__ float bf1(bf16 b) { return __uint_as_float((unsigned)b << 16); }
__device__ __forceinline__ float sigmoid_f(float x) { return 1.0f / (1.0f + expf(-x)); }
__device__ __forceinline__ float silu_f(float x) { return x / (1.0f + expf(-x)); }
__device__ __forceinline__ float softplus_f(float x) { return fmaxf(x, 0.f) + log1pf(expf(-fabsf(x))); }
__device__ __forceinline__ float logsigmoid_f(float x) { return fminf(x, 0.f) - log1pf(expf(-fabsf(x))); }
__device__ __forceinline__ float wave_sum(float v) {
#pragma unroll
    for (int o = 1; o < 64; o <<= 1) v += __shfl_xor(v, o);
    return v;
}

#define XB_TMO      128
#define XB_XCNT(j)  (256  + 64 * (j))
#define XB_XSUB(j)  (1280 + 64 * (j))
#define XB_XGEN(j)  (2304 + 64 * (j))
#define XB_TOP      3328
#define XB_TOPGEN   3392
#define XCD_BAR_WORDS 3456
#define XB_SPIN_CAP (1u << 18)

__device__ __forceinline__ unsigned xb_ld(unsigned* p)              { return __hip_atomic_load(p, __ATOMIC_RELAXED, __HIP_MEMORY_SCOPE_AGENT); }
__device__ __forceinline__ unsigned xb_add(unsigned* p, unsigned v) { return __hip_atomic_fetch_add(p, v, __ATOMIC_RELAXED, __HIP_MEMORY_SCOPE_AGENT); }
__device__ __forceinline__ unsigned xb_xcc_id() { return (unsigned)__builtin_amdgcn_s_getreg((3 << 11) | 20) & 0xFu; }
#define XB_SPIN(cond, bar) do { unsigned _sp = 0; while (cond) { __builtin_amdgcn_s_sleep(1); \
    if ((++_sp & 255u) == 0u) { if (xb_ld(&(bar)[XB_TMO])) break; if (_sp > XB_SPIN_CAP) { atomicAdd(&(bar)[XB_TMO], 1u); break; } } } } while (0)

struct XcdBarrier {
    unsigned* bar; unsigned x;
    volatile LAS unsigned* st;
};

__device__ __forceinline__ XcdBarrier xcd_barrier_post(unsigned* bar, volatile LAS unsigned* st) {
    XcdBarrier b; b.bar = bar; b.x = xb_xcc_id(); b.st = st;
    if (threadIdx.x == 0) (void)xb_add(&bar[XB_XCNT(b.x)], 1u);
    return b;
}
__device__ __forceinline__ void xcd_barrier_complete(unsigned* bar, unsigned x, unsigned& nloc, unsigned& nx) {
    const unsigned G = gridDim.x * gridDim.y * gridDim.z;
    unsigned sum, cnt, mine, sp = 0u;
    for (;;) {
        sum = 0u; cnt = 0u; mine = 0u;
#pragma unroll
        for (unsigned j = 0; j < 16; ++j) { const unsigned c = xb_ld(&bar[XB_XCNT(j)]); sum += c; cnt += (c > 0u) ? 1u : 0u; mine = (j == x) ? c : mine; }
        if (sum == G) break;
        __builtin_amdgcn_s_sleep(1);
        if ((++sp & 255u) == 0u) { if (xb_ld(&bar[XB_TMO])) break; if (sp > XB_SPIN_CAP) { atomicAdd(&bar[XB_TMO], 1u); break; } }
    }
    nloc = mine > 0u ? mine : 1u; nx = cnt > 0u ? cnt : 1u;
}

__device__ __forceinline__ void xcd_barrier(const XcdBarrier& b) {
    asm volatile("s_waitcnt vmcnt(0)" ::: "memory");
    __syncthreads();
    if (threadIdx.x == 0) {
        unsigned* bar = b.bar;
        __builtin_amdgcn_s_waitcnt(0);
        unsigned nloc = b.st[0], nx = b.st[1];
        if (nloc == 0u) { xcd_barrier_complete(bar, b.x, nloc, nx); b.st[0] = nloc; b.st[1] = nx; }
        const unsigned old = xb_add(&bar[XB_XSUB(b.x)], 1u);
        const unsigned gen = old / nloc;
        if (old + 1u == (gen + 1u) * nloc) {
            __builtin_amdgcn_fence(__ATOMIC_RELEASE, "agent");
            asm volatile("s_waitcnt vmcnt(0)" ::: "memory");
            const unsigned og = xb_add(&bar[XB_TOP], 1u);
            const unsigned tg = og / nx;
            if (og + 1u == (tg + 1u) * nx) xb_add(&bar[XB_TOPGEN], 1u);
            else XB_SPIN(xb_ld(&bar[XB_TOPGEN]) == tg, bar);
            __builtin_amdgcn_fence(__ATOMIC_ACQUIRE, "agent");
            xb_add(&bar[XB_XGEN(b.x)], 1u);
            asm volatile("s_waitcnt vmcnt(0)" ::: "memory");
        } else {
            XB_SPIN(xb_ld(&bar[XB_XGEN(b.x)]) == gen, bar);
            __builtin_amdgcn_fence(__ATOMIC_ACQUIRE, "agent");
            asm volatile("s_waitcnt vmcnt(0)" ::: "memory");
        }
    }
    __syncthreads();
}

struct Frame {
    LAS unsigned char* lds;
    volatile LAS unsigned* MISC;
    gu32* ctl;
    int tid, lane, wave;
    int vcu, G;
    unsigned char* ws;
    const float* in[19];
    float* out;
};
enum { I_X = 0, I_NORM_MIX, I_W_IN, I_DN_CONV, I_DN_ALOG, I_DN_DTB, I_DN_NORM, I_GL_WA2, I_GL_BA, I_GL_NORM, I_W_BDN, I_W_BGLA, I_W_OUT, I_NORM_FFN, I_W_FIN, I_FFN_CW, I_FFN_CB, I_W_FOUT, I_NORM_FIN };

__device__ __forceinline__ unsigned long long lds_ptr_get(Frame& F, int i) {
    const volatile LAS unsigned* p = (const volatile LAS unsigned*)(F.lds + PTR_OFF) + 2 * i;
    const unsigned lo = __builtin_amdgcn_readfirstlane(p[0]), hi = __builtin_amdgcn_readfirstlane(p[1]);
    return ((unsigned long long)hi << 32) | lo;
}
__device__ __forceinline__ void frame_reload(Frame& F) {
#pragma unroll
    for (int i = 0; i < 19; ++i) F.in[i] = (const float*)lds_ptr_get(F, i);
    F.out = (float*)lds_ptr_get(F, 19); F.ws = (unsigned char*)lds_ptr_get(F, 20); F.ctl = (gu32*)(F.ws + WS_CTL);
}

__device__ __forceinline__ void transpose_item(const float* W, size_t ldw, int k0, int sn0, bf16* WT, size_t ldk, int dn0, LAS float* scr, int lane, const float* ksc) {
    const int nq = lane & 7, kr = lane >> 3;
    f32x4 v[8];
#pragma unroll
    for (int i = 0; i < 8; ++i) v[i] = *(const GAS f32x4*)(W + (size_t)(k0 + 8 * i + kr) * ldw + sn0 + 4 * nq);
    if (ksc) {
#pragma unroll
        for (int i = 0; i < 8; ++i) v[i] *= ksc[k0 + 8 * i + kr]; }
#pragma unroll
    for (int i = 0; i < 8; ++i) { LAS float* d = scr + (8 * i + kr) * 33 + 4 * nq; d[0] = v[i].x; d[1] = v[i].y; d[2] = v[i].z; d[3] = v[i].w; }
    LDS_WAIT(); asm volatile("" ::: "memory");
    const int c = lane >> 3;
#pragma unroll
    for (int j = 0; j < 4; ++j) { const int n = (lane & 7) + 8 * j; const LAS float* s = scr + (8 * c) * 33 + n;
        v4u o; o.x = pk2(s[0 * 33], s[1 * 33]); o.y = pk2(s[2 * 33], s[3 * 33]); o.z = pk2(s[4 * 33], s[5 * 33]); o.w = pk2(s[6 * 33], s[7 * 33]);
        *(GAS v4u*)(WT + (size_t)(dn0 + n) * ldk + k0 + 8 * c) = o; }
    LDS_WAIT(); asm volatile("" ::: "memory");
}
__device__ __forceinline__ void rms_row(const float* xrow, const float* w, bf16* obf, float* of32, int lane) {
    const GAS f32x4* xr = (const GAS f32x4*)xrow + lane;
    f32x4 v[16]; float s = 0.f;
#pragma unroll
    for (int j = 0; j < 16; ++j) { v[j] = xr[64 * j]; s += (v[j].x * v[j].x + v[j].y * v[j].y) + (v[j].z * v[j].z + v[j].w * v[j].w); }
    const float rstd = 1.0f / sqrtf(wave_sum(s) * (1.f / D) + EPS);
    const GAS f32x4* wr = (const GAS f32x4*)w + lane;
    if (obf) { GAS v2u* o8 = (GAS v2u*)obf + lane;
#pragma unroll
        for (int j = 0; j < 16; ++j) { const f32x4 g = wr[64 * j]; v2u o; o.x = pk2(v[j].x * rstd * g.x, v[j].y * rstd * g.y); o.y = pk2(v[j].z * rstd * g.z, v[j].w * rstd * g.w); o8[64 * j] = o; } }
    else { GAS f32x4* o = (GAS f32x4*)of32 + lane;
#pragma unroll
        for (int j = 0; j < 16; ++j) { const f32x4 g = wr[64 * j]; o[64 * j] = (f32x4){v[j].x * rstd * g.x, v[j].y * rstd * g.y, v[j].z * rstd * g.z, v[j].w * rstd * g.w}; } }
}

__device__ __forceinline__ void p0_prologue(Frame& F) {
    LAS float* scr = (LAS float*)(F.lds + RING_OFF + F.wave * 16384);
    const int gw = F.vcu * NWAVES + F.wave, NGW = F.G * NWAVES;
    bf16* WIN = (bf16*)(F.ws + WS_WIN); bf16* WSM = (bf16*)(F.ws + WS_WSM); bf16* WBDN = (bf16*)(F.ws + WS_WBDN); bf16* WBGLA = (bf16*)(F.ws + WS_WBGLA);
    bf16* WOUT = (bf16*)(F.ws + WS_WOUT); bf16* WFIN = (bf16*)(F.ws + WS_WFIN); bf16* WFOUT = (bf16*)(F.ws + WS_WFOUT);
    constexpr int NB_IN = PN / 32, I_IN = (D / 64) * NB_IN;
    constexpr int I_SM = (D / 64) * 2;
    constexpr int I_BR = (2048 / 64) * (D / 32);
    constexpr int I_OUT = (D / 64) * (D / 32);
    constexpr int NB_FI = NGU / 32, I_FI = (D / 64) * NB_FI;
    constexpr int I_FO = (DFF / 64) * (D / 32);
    constexpr int NITEMS = I_IN + I_SM + 2 * I_BR + I_OUT + I_FI + I_FO;
    for (int it = gw; it < NITEMS; it += NGW) {
        int r = it;
        if (r < I_IN) { const int kb = r / NB_IN, nb = r % NB_IN, n0 = 32 * nb; const int sn0 = n0 + (n0 >= PC_GATE_DN ? 48 : (n0 >= PC_GQ ? 32 : 0));
            transpose_item(F.in[I_W_IN], IN_COLS, 64 * kb, sn0, WIN, LDK4, n0, scr, F.lane, nullptr); continue; } r -= I_IN;
        if (r < I_SM) { const int kb = r >> 1, nb = r & 1; transpose_item(F.in[I_W_IN], IN_COLS, 64 * kb, nb ? 14368 : 8192, WSM, LDK4, 32 * nb, scr, F.lane, nullptr); continue; } r -= I_SM;
        if (r < I_BR) { const int kb = r / (D / 32), nb = r % (D / 32); transpose_item(F.in[I_W_BDN], D, 64 * kb, 32 * nb, WBDN, LDK2, 32 * nb, scr, F.lane, nullptr); continue; } r -= I_BR;
        if (r < I_BR) { const int kb = r / (D / 32), nb = r % (D / 32); transpose_item(F.in[I_W_BGLA], D, 64 * kb, 32 * nb, WBGLA, LDK2, 32 * nb, scr, F.lane, nullptr); continue; } r -= I_BR;
        if (r < I_OUT) { const int kb = r / (D / 32), nb = r % (D / 32); transpose_item(F.in[I_W_OUT], D, 64 * kb, 32 * nb, WOUT, LDK4, 32 * nb, scr, F.lane, nullptr); continue; } r -= I_OUT;
        if (r < I_FI) { const int kb = r / NB_FI, nb = r % NB_FI, n0 = 32 * nb, j = n0 >> 8, i = n0 & 255; const int sn0 = (i < 128) ? (128 * j + i) : (DFF + 128 * j + (i - 128));
            transpose_item(F.in[I_W_FIN], NGU, 64 * kb, sn0, WFIN, LDK4, n0, scr, F.lane, F.in[I_NORM_FFN]); continue; } r -= I_FI;
        { const int kb = r / (D / 32), nb = r % (D / 32); transpose_item(F.in[I_W_FOUT], D, 64 * kb, 32 * nb, WFOUT, DFF, 32 * nb, scr, F.lane, nullptr); }
    }
    bf16* H = (bf16*)(F.ws + WS_H);
    for (int m = gw; m < M; m += NGW) rms_row(F.in[I_X] + (size_t)m * D, F.in[I_NORM_MIX], H + (size_t)m * LDK4, nullptr, F.lane);
}

__device__ __forceinline__ void p1_skinny(Frame& F) {
    const bf16* H = (const bf16*)(F.ws + WS_H); const bf16* WSM = (const bf16*)(F.ws + WS_WSM); float* PS = (float*)(F.ws + WS_PSMALL);
    const int lane = F.lane, fr = lane & 15, fq = lane >> 4;
    for (int t = (int)blockIdx.x + F.G * F.wave; t < M / 16; t += F.G * NWAVES) {
        const int row0 = 16 * t;
        const bf16* ap = H + (size_t)(row0 + fr) * LDK4 + 8 * fq; const bf16* bp = WSM + (size_t)fr * LDK4 + 8 * fq;
        f32x4 acc[4] = {{0.f, 0.f, 0.f, 0.f}, {0.f, 0.f, 0.f, 0.f}, {0.f, 0.f, 0.f, 0.f}, {0.f, 0.f, 0.f, 0.f}};
#pragma unroll 4
        for (int kk = 0; kk < D / 32; ++kk) {
            const bf16x8 a = *(const GAS bf16x8*)(ap + kk * 32);
#pragma unroll
            for (int cb = 0; cb < 4; ++cb) { const bf16x8 b = *(const GAS bf16x8*)(bp + (size_t)cb * 16 * LDK4 + kk * 32); acc[cb] = __builtin_amdgcn_mfma_f32_16x16x32_bf16(a, b, acc[cb], 0, 0, 0); }
        }
#pragma unroll
        for (int cb = 0; cb < 4; ++cb)
#pragma unroll
            for (int r = 0; r < 4; ++r) PS[(size_t)(row0 + 4 * fq + r) * PSM + cb * 16 + fr] = acc[cb][r];
    }
}


constexpr int PQ = 136, PT = 72;
constexpr float QSCALE = 0.08838834764831845f;
__device__ __forceinline__ float silu_fast(float x) { return x / (1.0f + __expf(-x)); }
__device__ __forceinline__ v4u pack8(const float* y) { v4u o; o.x = pk2(y[0], y[1]); o.y = pk2(y[2], y[3]); o.z = pk2(y[4], y[5]); o.w = pk2(y[6], y[7]); return o; }
#define MFMA16(a, b, c) __builtin_amdgcn_mfma_f32_16x16x32_bf16((a), (b), (c), 0, 0, 0)

__device__ __forceinline__ void dn_conv16(const bf16* P, const float* cw, int tg, int t, int col, float (&y)[16]) {
#pragma unroll
    for (int c = 0; c < 16; ++c) y[c] = 0.f;
    v4u x0[4], x1[4];
#pragma unroll
    for (int i = 0; i < 4; ++i) {
        const bf16* src = P + (size_t)((t - 3 + i >= 0) ? tg - 3 + i : tg) * PN + PC_QKV + col;
        x0[i] = *(const GAS v4u*)src; x1[i] = *(const GAS v4u*)(src + 8);
    }
#pragma unroll
    for (int i = 0; i < 4; ++i) {
        const float m = (t - 3 + i >= 0) ? 1.f : 0.f;
        const float* w = cw + (size_t)i * DN_QKV + col;
        const f32x4 w0 = *(const GAS f32x4*)w * m, w1 = *(const GAS f32x4*)(w + 4) * m, w2 = *(const GAS f32x4*)(w + 8) * m, w3 = *(const GAS f32x4*)(w + 12) * m;
        y[0] += w0.x * bflo(x0[i].x); y[1] += w0.y * bfhi(x0[i].x); y[2] += w0.z * bflo(x0[i].y); y[3] += w0.w * bfhi(x0[i].y);
        y[4] += w1.x * bflo(x0[i].z); y[5] += w1.y * bfhi(x0[i].z); y[6] += w1.z * bflo(x0[i].w); y[7] += w1.w * bfhi(x0[i].w);
        y[8] += w2.x * bflo(x1[i].x); y[9] += w2.y * bfhi(x1[i].x); y[10] += w2.z * bflo(x1[i].y); y[11] += w2.w * bfhi(x1[i].y);
        y[12] += w3.x * bflo(x1[i].z); y[13] += w3.y * bfhi(x1[i].z); y[14] += w3.z * bflo(x1[i].w); y[15] += w3.w * bfhi(x1[i].w);
        asm volatile("" ::: "memory");
    }
#pragma unroll
    for (int c = 0; c < 16; ++c) y[c] = silu_fast(y[c]);
}

constexpr int LP_KN = 0, LP_QN = 17408, LP_KB = 34816, LP_KDT = 52224, LP_RHS = 0, LP_A = 70656, LP_BV = 87040, LP_BETA = 87296;
__device__ __forceinline__ void dn_prep_chunk(Frame& F, int ch) {
    int tid = F.tid; asm volatile("" : "+v"(tid));
    const int lane = tid & 63, wave = F.wave, fr = lane & 15, fq = lane >> 4;
    const int h = ch & 15, bn = ch >> 4, n = bn & 31, b = bn >> 5, tg0 = b * SEQ + n * 64;
    const size_t id = (size_t)((b * DN_H + h) * 32 + n);
    LAS unsigned char* L = F.lds + RING_OFF;
    LAS bf16* Kn = (LAS bf16*)(L + LP_KN); LAS bf16* Qn = (LAS bf16*)(L + LP_QN); LAS bf16* KB = (LAS bf16*)(L + LP_KB); LAS bf16* KDTl = (LAS bf16*)(L + LP_KDT);
    LAS float* RHS = (LAS float*)(L + LP_RHS); LAS float* Al = (LAS float*)(L + LP_A);
    const bf16* PROJ = (const bf16*)(F.ws + WS_PROJ); const float* PS = (const float*)(F.ws + WS_PSMALL);
    bf16* DW = (bf16*)(F.ws + WS_DW) + id * 8192; bf16* DQE = (bf16*)(F.ws + WS_DQE) + id * 8192; bf16* DKT = (bf16*)(F.ws + WS_DKT) + id * 8192;
    bf16* DAT = (bf16*)(F.ws + WS_DAT) + id * 4096; float* DU = (float*)(F.ws + WS_DU) + id * 8192; float* DDL = (float*)(F.ws + WS_DDL);
    float gp, betal;
    { const int tgl = tg0 + lane;
      gp = -expf(F.in[I_DN_ALOG][h]) * softplus_f(PS[(size_t)tgl * PSM + 16 + h] + F.in[I_DN_DTB][h]);
#pragma unroll
      for (int o = 1; o < 64; o <<= 1) { const float tt = __shfl_up(gp, o); if (lane >= o) gp += tt; }
      betal = sigmoid_f(PS[(size_t)tgl * PSM + h]); }
    const int row = tid >> 3, cg = tid & 7, t = n * 64 + row, tg = tg0 + row, c0 = 16 * cg;
    const float bt = __shfl(gp, row), bl = __shfl(gp, 63), beta = __shfl(betal, row), eb = __expf(bt), ekd = __expf(bl - bt);
    float k[16], v[16];
    {
        float q[16], tmp[16];
        dn_conv16(PROJ, F.in[I_DN_CONV], tg, t, h * 128 + c0, q);
        float sq = 0.f;
#pragma unroll
        for (int c = 0; c < 16; ++c) sq += q[c] * q[c];
        sq += __shfl_xor(sq, 1); sq += __shfl_xor(sq, 2); sq += __shfl_xor(sq, 4);
        const float iq = QSCALE * __builtin_amdgcn_rsqf(sq + EPS);
#pragma unroll
        for (int c = 0; c < 16; ++c) { q[c] *= iq; tmp[c] = q[c] * eb; }
        *(LAS v4u*)(Qn + row * PQ + c0) = pack8(q); *(LAS v4u*)(Qn + row * PQ + c0 + 8) = pack8(q + 8);
        *(GAS v4u*)(DQE + row * 128 + c0) = pack8(tmp); *(GAS v4u*)(DQE + row * 128 + c0 + 8) = pack8(tmp + 8);
        asm volatile("" ::: "memory");
    }
    {
        float tmp[16];
        dn_conv16(PROJ, F.in[I_DN_CONV], tg, t, 2048 + h * 128 + c0, k);
        float sk = 0.f;
#pragma unroll
        for (int c = 0; c < 16; ++c) sk += k[c] * k[c];
        sk += __shfl_xor(sk, 1); sk += __shfl_xor(sk, 2); sk += __shfl_xor(sk, 4);
        const float ik = __builtin_amdgcn_rsqf(sk + EPS);
#pragma unroll
        for (int c = 0; c < 16; ++c) { k[c] *= ik; tmp[c] = k[c] * beta; }
        *(LAS v4u*)(Kn + row * PQ + c0) = pack8(k); *(LAS v4u*)(Kn + row * PQ + c0 + 8) = pack8(k + 8);
        *(LAS v4u*)(KB + row * PQ + c0) = pack8(tmp); *(LAS v4u*)(KB + row * PQ + c0 + 8) = pack8(tmp + 8);
#pragma unroll
        for (int c = 0; c < 16; ++c) KDTl[(c0 + c) * PT + row] = (bf16)f2bf(k[c] * ekd);
        asm volatile("" ::: "memory");
    }
    dn_conv16(PROJ, F.in[I_DN_CONV], tg, t, 4096 + h * 128 + c0, v);
    if (tid == 0) DDL[id] = __expf(bl);
    __syncthreads();
    {
        const int rb = wave >> 1;
        f32x4 kk[2] = {{0.f, 0.f, 0.f, 0.f}, {0.f, 0.f, 0.f, 0.f}}, qk[2] = {{0.f, 0.f, 0.f, 0.f}, {0.f, 0.f, 0.f, 0.f}};
#pragma unroll
        for (int ks = 0; ks < 4; ++ks) {
            const bf16x8 a = *(const LAS bf16x8*)(Kn + (16 * rb + fr) * PQ + 32 * ks + 8 * fq);
#pragma unroll
            for (int c2 = 0; c2 < 2; ++c2) { const int cb = (wave & 1) * 2 + c2;
                const bf16x8 b1 = *(const LAS bf16x8*)(KB + (16 * cb + fr) * PQ + 32 * ks + 8 * fq);
                const bf16x8 b2 = *(const LAS bf16x8*)(Qn + (16 * cb + fr) * PQ + 32 * ks + 8 * fq);
                kk[c2] = MFMA16(a, b1, kk[c2]); qk[c2] = MFMA16(a, b2, qk[c2]); }
        }
#pragma unroll
        for (int c2 = 0; c2 < 2; ++c2) { const int cb = (wave & 1) * 2 + c2, i = 16 * cb + fr, j0 = 16 * rb + 4 * fq; const float bi = __shfl(gp, i);
            f32x4 av; float at[4];
#pragma unroll
            for (int r = 0; r < 4; ++r) { const int j = j0 + r; const float bj = __shfl(gp, j); const float dec = (i >= j) ? __expf(bi - bj) : 0.f; av[r] = (i > j) ? kk[c2][r] * dec : 0.f; at[r] = (i >= j) ? qk[c2][r] * dec : 0.f; }
            *(LAS f32x4*)(Al + i * 64 + j0) = av;
            v2u w; w.x = pk2(at[0], at[1]); w.y = pk2(at[2], at[3]); *(GAS v2u*)(DAT + i * 64 + j0) = w; }
#pragma unroll
        for (int i = 0; i < 2; ++i) { const int id2 = tid + 512 * i, r = id2 >> 3, c = id2 & 7; *(GAS v4u*)(DKT + r * 64 + 8 * c) = *(const LAS v4u*)(KDTl + r * PT + 8 * c); }
    }
    __syncthreads();
    {
#pragma unroll
        for (int c = 0; c < 16; c += 4) {
            *(LAS f32x4*)(RHS + row * 256 + c0 + c) = (f32x4){k[c] * beta * eb, k[c + 1] * beta * eb, k[c + 2] * beta * eb, k[c + 3] * beta * eb};
            *(LAS f32x4*)(RHS + row * 256 + 128 + c0 + c) = (f32x4){v[c] * beta, v[c + 1] * beta, v[c + 2] * beta, v[c + 3] * beta}; }
    }
    __syncthreads();
    if (wave < 4) {
        const int c = 64 * wave + lane;
        unsigned abase = LP_A; asm volatile("" : "+v"(abase));
        const LAS float* Av = (const LAS float*)(L + abase);
        float X[64];
#pragma unroll
        for (int i = 0; i < 64; ++i) {
            float x0 = RHS[i * 256 + c], x1 = 0.f, x2 = 0.f, x3 = 0.f;
#pragma unroll
            for (int j4 = 0; j4 < i; j4 += 4) {
                const f32x4 a = *(const LAS f32x4*)(Av + i * 64 + j4);
                x0 -= a.x * X[j4];
                if (j4 + 1 < i) x1 -= a.y * X[j4 + 1];
                if (j4 + 2 < i) x2 -= a.z * X[j4 + 2];
                if (j4 + 3 < i) x3 -= a.w * X[j4 + 3];
            }
            X[i] = (x0 + x1) + (x2 + x3);
            asm volatile("" ::: "memory");
        }
        if (wave < 2) { bf16* pw = DW + c;
#pragma unroll
            for (int i = 0; i < 64; ++i) { *pw = (bf16)f2bf(-X[i]); pw += 128; asm volatile("" : "+v"(pw)); }
        } else { float* pu = DU + (c - 128);
#pragma unroll
            for (int i = 0; i < 64; ++i) { *pu = X[i]; pu += 128; asm volatile("" : "+v"(pu)); }
        }
    }
    __syncthreads();
}

constexpr int LG_QE = 0, LG_KE = 17408, LG_VT = 34816, LG_LR = 71680, LG_TOT = 75776;
__device__ __forceinline__ void gla_prep_chunk(Frame& F, int ch) {
    int tid = F.tid; asm volatile("" : "+v"(tid));
    const int lane = tid & 63, wave = F.wave, fr = lane & 15, fq = lane >> 4;
    const int h = ch & 7, bn = ch >> 3, n = bn & 31, b = bn >> 5, tg0 = b * SEQ + n * 64;
    const size_t id = (size_t)((b * GL_H + h) * 32 + n);
    LAS unsigned char* L = F.lds + RING_OFF;
    LAS bf16* QEl = (LAS bf16*)(L + LG_QE); LAS bf16* KEl = (LAS bf16*)(L + LG_KE); LAS bf16* VTl = (LAS bf16*)(L + LG_VT);
    LAS float* lrl = (LAS float*)(L + LG_LR); LAS float* tot = (LAS float*)(L + LG_TOT);
    const bf16* PROJ = (const bf16*)(F.ws + WS_PROJ); const float* PS = (const float*)(F.ws + WS_PSMALL);
    bf16* GQE = (bf16*)(F.ws + WS_GQE) + id * 8192; bf16* GKT = (bf16*)(F.ws + WS_GKT) + id * 8192; bf16* GAT = (bf16*)(F.ws + WS_GAT) + id * 4096;
    bf16* GVT = (bf16*)(F.ws + WS_GVT) + id * 16384; float* GDL = (float*)(F.ws + WS_GDL) + id * 128;
#pragma unroll
    for (int i = 0; i < 2; ++i) { const int e = tid + 512 * i; lrl[e] = PS[(size_t)(tg0 + (e >> 4)) * PSM + 32 + (e & 15)]; }
#pragma unroll
    for (int i = 0; i < 4; ++i) { const int e = tid + 512 * i, r = e >> 5, c = e & 31; const v4u x = *(const GAS v4u*)(PROJ + (size_t)(tg0 + r) * PN + PC_GV + h * 256 + 8 * c);
        LAS bf16* d = VTl + (8 * c) * PT + r;
        d[0 * PT] = (bf16)(x.x & 0xffffu); d[1 * PT] = (bf16)(x.x >> 16); d[2 * PT] = (bf16)(x.y & 0xffffu); d[3 * PT] = (bf16)(x.y >> 16);
        d[4 * PT] = (bf16)(x.z & 0xffffu); d[5 * PT] = (bf16)(x.z >> 16); d[6 * PT] = (bf16)(x.w & 0xffffu); d[7 * PT] = (bf16)(x.w >> 16); }
    const int d = tid & 127, rg = tid >> 7, r0 = 16 * rg, col = h * 128 + d;
    float w2[16];
#pragma unroll
    for (int r = 0; r < 16; ++r) w2[r] = F.in[I_GL_WA2][(size_t)r * GL_KEY + col];
    const float ba = F.in[I_GL_BA][col];
    float qv[16], kv[16];
#pragma unroll
    for (int i = 0; i < 16; ++i) { const size_t o = (size_t)(tg0 + r0 + i) * PN + h * 128 + d; qv[i] = bf1(PROJ[o + PC_GQ]) * QSCALE; kv[i] = bf1(PROJ[o + PC_GK]); }
    __syncthreads();
    float cs[16]; float run = 0.f;
#pragma unroll
    for (int i = 0; i < 16; ++i) { float x = ba;
#pragma unroll
        for (int r = 0; r < 16; r += 4) { const f32x4 l4 = *(const LAS f32x4*)(lrl + (r0 + i) * 16 + r); x += l4.x * w2[r] + l4.y * w2[r + 1] + l4.z * w2[r + 2] + l4.w * w2[r + 3]; }
        run += (fminf(x, 0.f) - __logf(1.0f + __expf(-fabsf(x)))) * (1.f / 16.f); cs[i] = run; }
    tot[rg * 128 + d] = run;
    __syncthreads();
    float off = 0.f, bl = 0.f;
#pragma unroll
    for (int g = 0; g < 4; ++g) { const float tg_ = tot[g * 128 + d]; if (g < rg) off += tg_; bl += tg_; }
    {
        float kd[16];
#pragma unroll
        for (int i = 0; i < 16; ++i) { const float bb = off + cs[i]; QEl[(r0 + i) * PQ + d] = (bf16)f2bf(qv[i] * __expf(bb)); KEl[(r0 + i) * PQ + d] = (bf16)f2bf(kv[i] * __expf(-bb)); kd[i] = kv[i] * __expf(bl - bb); }
        *(GAS v4u*)(GKT + d * 64 + r0) = pack8(kd); *(GAS v4u*)(GKT + d * 64 + r0 + 8) = pack8(kd + 8);
        if (rg == 0) GDL[d] = expf(bl);
    }
    __syncthreads();
    {
        const int rb = wave >> 1;
        f32x4 qk[2] = {{0.f, 0.f, 0.f, 0.f}, {0.f, 0.f, 0.f, 0.f}};
#pragma unroll
        for (int ks = 0; ks < 4; ++ks) {
            const bf16x8 a = *(const LAS bf16x8*)(KEl + (16 * rb + fr) * PQ + 32 * ks + 8 * fq);
#pragma unroll
            for (int c2 = 0; c2 < 2; ++c2) { const int cb = (wave & 1) * 2 + c2; const bf16x8 b2 = *(const LAS bf16x8*)(QEl + (16 * cb + fr) * PQ + 32 * ks + 8 * fq); qk[c2] = MFMA16(a, b2, qk[c2]); }
        }
#pragma unroll
        for (int c2 = 0; c2 < 2; ++c2) { const int cb = (wave & 1) * 2 + c2, i = 16 * cb + fr, j0 = 16 * rb + 4 * fq; float at[4];
#pragma unroll
            for (int r = 0; r < 4; ++r) at[r] = (i >= j0 + r) ? qk[c2][r] : 0.f;
            v2u w; w.x = pk2(at[0], at[1]); w.y = pk2(at[2], at[3]); *(GAS v2u*)(GAT + i * 64 + j0) = w; }
#pragma unroll
        for (int i = 0; i < 2; ++i) { const int e = tid + 512 * i, r = e >> 4, c = e & 15; *(GAS v4u*)(GQE + r * 128 + 8 * c) = *(const LAS v4u*)(QEl + r * PQ + 8 * c); }
#pragma unroll
        for (int i = 0; i < 4; ++i) { const int e = tid + 512 * i, r = e >> 3, c = e & 7; *(GAS v4u*)(GVT + r * 64 + 8 * c) = *(const LAS v4u*)(VTl + r * PT + 8 * c); }
    }
    __syncthreads();
}

constexpr int LS_W = 0, LS_QE = 17408, LS_KDT = 34816, LS_ATT = 53248, LS_VN = 62464, LS_ST0 = 71680, LS_ST1 = 89088, LS_END = 106496;
template <bool DN> __device__ __forceinline__ void scan_task(Frame& F, int bh, int part) {
    constexpr int H = DN ? DN_H : GL_H, DV = DN ? DN_DV : GL_DV;
    const int tid = F.tid, lane = F.lane, wave = F.wave, fr = lane & 15, fq = lane >> 4;
    const int b = bh / H, h = bh % H, dv0 = 64 * part;
    LAS unsigned char* L = F.lds + RING_OFF;
    LAS bf16* Wl = (LAS bf16*)(L + LS_W); LAS bf16* QEl = (LAS bf16*)(L + LS_QE); LAS bf16* KDTl = (LAS bf16*)(L + LS_KDT); LAS bf16* ATTl = (LAS bf16*)(L + LS_ATT);
    LAS bf16* VNt = (LAS bf16*)(L + LS_VN);
    const bf16* gW = (const bf16*)(F.ws + WS_DW) + (size_t)bh * 32 * 8192;
    const bf16* gQE = (const bf16*)(F.ws + (DN ? WS_DQE : WS_GQE)) + (size_t)bh * 32 * 8192;
    const bf16* gKT = (const bf16*)(F.ws + (DN ? WS_DKT : WS_GKT)) + (size_t)bh * 32 * 8192;
    const bf16* gAT = (const bf16*)(F.ws + (DN ? WS_DAT : WS_GAT)) + (size_t)bh * 32 * 4096;
    const float* gU = (const float*)(F.ws + WS_DU) + (size_t)bh * 32 * 8192;
    const bf16* gVT = (const bf16*)(F.ws + WS_GVT) + (size_t)bh * 32 * 16384 + (size_t)dv0 * 64;
    const float* gDL = DN ? (const float*)(F.ws + WS_DDL) + (size_t)bh * 32 : (const float*)(F.ws + WS_GDL) + (size_t)bh * 32 * 128;
    float* gO = (float*)(F.ws + (DN ? WS_ODN : WS_OGLA)) + (size_t)(b * SEQ) * 2048 + h * DV + dv0;
    for (int e = tid; e < 17408 / 4; e += NWAVES * 64) ((LAS unsigned*)(L + LS_ST0))[e] = 0u;
    f32x4 Sacc[4] = {{0.f, 0.f, 0.f, 0.f}, {0.f, 0.f, 0.f, 0.f}, {0.f, 0.f, 0.f, 0.f}, {0.f, 0.f, 0.f, 0.f}};
    const int rw0 = tid >> 4, cw0 = tid & 15;
    const int rk0 = tid >> 3, ck0 = tid & 7;
    const int rb = wave >> 1, cbw = (wave & 1) * 2;
    v4u sW[2], sQ[2], sK[2], sA, sV; f32x4 sDL; float sdl = 0.f; float uN[2][4];
    sW[0] = sW[1] = sQ[0] = sQ[1] = sK[0] = sK[1] = sA = sV = (v4u){0u, 0u, 0u, 0u}; sDL = (f32x4){0.f, 0.f, 0.f, 0.f};
#define SCAN_LOAD(n_) do { const size_t o8 = (size_t)(n_) * 8192, o4 = (size_t)(n_) * 4096; \
        if (DN) { sW[0] = *(const GAS v4u*)(gW + o8 + tid * 8); sW[1] = *(const GAS v4u*)(gW + o8 + 4096 + tid * 8); } \
        sQ[0] = *(const GAS v4u*)(gQE + o8 + tid * 8); sQ[1] = *(const GAS v4u*)(gQE + o8 + 4096 + tid * 8); \
        sK[0] = *(const GAS v4u*)(gKT + o8 + tid * 8); sK[1] = *(const GAS v4u*)(gKT + o8 + 4096 + tid * 8); \
        sA = *(const GAS v4u*)(gAT + o4 + tid * 8); \
        if (DN) { sdl = gDL[(n_)]; _Pragma("unroll") for (int c2 = 0; c2 < 2; ++c2) _Pragma("unroll") for (int r = 0; r < 4; ++r) uN[c2][r] = gU[o8 + (16 * rb + 4 * fq + r) * 128 + dv0 + 16 * (cbw + c2) + fr]; } \
        else { sV = *(const GAS v4u*)(gVT + (size_t)(n_) * 16384 + tid * 8); sDL = *(const GAS f32x4*)(gDL + (n_) * 128 + 16 * wave + 4 * fq); } } while (0)
#define SCAN_STORE() do { \
        if (DN) { *(LAS v4u*)(Wl + rw0 * PQ + 8 * cw0) = sW[0]; *(LAS v4u*)(Wl + (rw0 + 32) * PQ + 8 * cw0) = sW[1]; } \
        *(LAS v4u*)(QEl + rw0 * PQ + 8 * cw0) = sQ[0]; *(LAS v4u*)(QEl + (rw0 + 32) * PQ + 8 * cw0) = sQ[1]; \
        *(LAS v4u*)(KDTl + rk0 * PT + 8 * ck0) = sK[0]; *(LAS v4u*)(KDTl + (rk0 + 64) * PT + 8 * ck0) = sK[1]; \
        *(LAS v4u*)(ATTl + rk0 * PT + 8 * ck0) = sA; \
        if (!DN) *(LAS v4u*)(VNt + rk0 * PT + 8 * ck0) = sV; } while (0)
    SCAN_LOAD(0);
    SCAN_STORE();
    float uC[2][4]; float dlC = sdl; f32x4 dlV = sDL;
#pragma unroll
    for (int c2 = 0; c2 < 2; ++c2)
#pragma unroll
        for (int r = 0; r < 4; ++r) uC[c2][r] = DN ? uN[c2][r] : 0.f;
    __syncthreads();
    for (int n = 0; n < 32; ++n) {
        LAS bf16* Sc = (LAS bf16*)(L + ((n & 1) ? LS_ST1 : LS_ST0)); LAS bf16* Sn = (LAS bf16*)(L + ((n & 1) ? LS_ST0 : LS_ST1));
        if (n + 1 < 32) SCAN_LOAD(n + 1);
        if (DN) {
            f32x4 va[2];
#pragma unroll
            for (int c2 = 0; c2 < 2; ++c2) va[c2] = (f32x4){uC[c2][0], uC[c2][1], uC[c2][2], uC[c2][3]};
#pragma unroll
            for (int ks = 0; ks < 4; ++ks) { const bf16x8 a = *(const LAS bf16x8*)(Wl + (16 * rb + fr) * PQ + 32 * ks + 8 * fq);
#pragma unroll
                for (int c2 = 0; c2 < 2; ++c2) { const bf16x8 bb = *(const LAS bf16x8*)(Sc + (16 * (cbw + c2) + fr) * PQ + 32 * ks + 8 * fq); va[c2] = MFMA16(a, bb, va[c2]); } }
#pragma unroll
            for (int c2 = 0; c2 < 2; ++c2) { v2u w; w.x = pk2(va[c2][0], va[c2][1]); w.y = pk2(va[c2][2], va[c2][3]); *(LAS v2u*)(VNt + (16 * (cbw + c2) + fr) * PT + 16 * rb + 4 * fq) = w; }
            __syncthreads();
        }
        {
            f32x4 oa[2] = {{0.f, 0.f, 0.f, 0.f}, {0.f, 0.f, 0.f, 0.f}};
#pragma unroll
            for (int ks = 0; ks < 4; ++ks) { const bf16x8 a = *(const LAS bf16x8*)(QEl + (16 * rb + fr) * PQ + 32 * ks + 8 * fq);
#pragma unroll
                for (int c2 = 0; c2 < 2; ++c2) { const bf16x8 bb = *(const LAS bf16x8*)(Sc + (16 * (cbw + c2) + fr) * PQ + 32 * ks + 8 * fq); oa[c2] = MFMA16(a, bb, oa[c2]); } }
#pragma unroll
            for (int ks = 0; ks < 2; ++ks) { const bf16x8 a = *(const LAS bf16x8*)(ATTl + (16 * rb + fr) * PT + 32 * ks + 8 * fq);
#pragma unroll
                for (int c2 = 0; c2 < 2; ++c2) { const bf16x8 bb = *(const LAS bf16x8*)(VNt + (16 * (cbw + c2) + fr) * PT + 32 * ks + 8 * fq); oa[c2] = MFMA16(a, bb, oa[c2]); } }
#pragma unroll
            for (int c2 = 0; c2 < 2; ++c2)
#pragma unroll
                for (int r = 0; r < 4; ++r) gO[(size_t)(n * 64 + 16 * rb + 4 * fq + r) * 2048 + 16 * (cbw + c2) + fr] = oa[c2][r];
        }
        {
#pragma unroll
            for (int cb = 0; cb < 4; ++cb) { if (DN) Sacc[cb] *= dlC; else Sacc[cb] *= dlV; }
#pragma unroll
            for (int ks = 0; ks < 2; ++ks) { const bf16x8 a = *(const LAS bf16x8*)(KDTl + (16 * wave + fr) * PT + 32 * ks + 8 * fq);
#pragma unroll
                for (int cb = 0; cb < 4; ++cb) { const bf16x8 bb = *(const LAS bf16x8*)(VNt + (16 * cb + fr) * PT + 32 * ks + 8 * fq); Sacc[cb] = MFMA16(a, bb, Sacc[cb]); } }
#pragma unroll
            for (int cb = 0; cb < 4; ++cb) { v2u w; w.x = pk2(Sacc[cb][0], Sacc[cb][1]); w.y = pk2(Sacc[cb][2], Sacc[cb][3]); *(LAS v2u*)(Sn + (16 * cb + fr) * PQ + 16 * wave + 4 * fq) = w; }
        }
        __syncthreads();
        if (n + 1 < 32) { SCAN_STORE(); dlC = sdl; dlV = sDL;
#pragma unroll
            for (int c2 = 0; c2 < 2; ++c2)
#pragma unroll
                for (int r = 0; r < 4; ++r) uC[c2][r] = DN ? uN[c2][r] : 0.f; }
        __syncthreads();
    }
#undef SCAN_LOAD
#undef SCAN_STORE
}

#ifndef CHUNK_DN
#define CHUNK_DN 1
#endif
#ifndef CHUNK_GLA
#define CHUNK_GLA 1
#endif
__device__ __forceinline__ void p2_prep(Frame& F) {
    const int gw = F.vcu * NWAVES + F.wave, NGW = F.G * NWAVES, lane = F.lane;
    const bf16* PROJ = (const bf16*)(F.ws + WS_PROJ); const float* PS = (const float*)(F.ws + WS_PSMALL);
    float* QF = (float*)(F.ws + WS_QF); float* KF = (float*)(F.ws + WS_KF); float* VF = (float*)(F.ws + WS_VF);
    float* EK = (float*)(F.ws + WS_EK); float* BETA = (float*)(F.ws + WS_BETA); float* GD = (float*)(F.ws + WS_G);
    const float* cw = F.in[I_DN_CONV];
#if !CHUNK_DN
    for (int id = gw; id < M * DN_H; id += NGW) {
        const int tg = id >> 4, h = id & 15, t = tg & (SEQ - 1), d0 = 2 * lane;
        float res[3][2];
#pragma unroll
        for (int p = 0; p < 3; ++p) { const int col = p * 2048 + h * 128 + d0; float y0 = 0.f, y1 = 0.f;
#pragma unroll
            for (int i = 0; i < 4; ++i) { const int tt = t - 3 + i; if (tt >= 0) { const unsigned xw = *(const GAS unsigned*)(PROJ + (size_t)(tg - 3 + i) * PN + PC_QKV + col);
                    const f32x2 w = *(const GAS f32x2*)(cw + (size_t)i * DN_QKV + col); y0 += w.x * bflo(xw); y1 += w.y * bfhi(xw); } }
            res[p][0] = silu_f(y0); res[p][1] = silu_f(y1); }
        const float sq = wave_sum(res[0][0] * res[0][0] + res[0][1] * res[0][1]), sk = wave_sum(res[1][0] * res[1][0] + res[1][1] * res[1][1]);
        const float iq = (1.0f / sqrtf(sq + EPS)) * 0.08838834764831845f, ik = 1.0f / sqrtf(sk + EPS);
        const size_t o = (size_t)tg * DN_KEY + h * 128 + d0;
        *(GAS f32x2*)(QF + o) = (f32x2){res[0][0] * iq, res[0][1] * iq}; *(GAS f32x2*)(KF + o) = (f32x2){res[1][0] * ik, res[1][1] * ik}; *(GAS f32x2*)(VF + o) = (f32x2){res[2][0], res[2][1]};
        if (lane == 0) { BETA[id] = sigmoid_f(PS[(size_t)tg * PSM + h]); GD[id] = -expf(F.in[I_DN_ALOG][h]) * softplus_f(PS[(size_t)tg * PSM + 16 + h] + F.in[I_DN_DTB][h]); }
    }
#else
    for (int ch = F.vcu; ch < BATCH * 32 * DN_H; ch += F.G) dn_prep_chunk(F, ch);
#endif
#if !CHUNK_GLA
    const float* wa2 = F.in[I_GL_WA2]; const float* ba = F.in[I_GL_BA];
    for (int id = gw; id < M * GL_H; id += NGW) {
        const int tg = id >> 3, h = id & 7, c = h * 128 + 2 * lane;
        f32x2 x = *(const GAS f32x2*)(ba + c);
#pragma unroll
        for (int r = 0; r < GL_RANK; ++r) { const float lr = PS[(size_t)tg * PSM + 32 + r]; const f32x2 w = *(const GAS f32x2*)(wa2 + (size_t)r * GL_KEY + c); x.x += lr * w.x; x.y += lr * w.y; }
        *(GAS f32x2*)(EK + (size_t)tg * GL_KEY + c) = (f32x2){expf(logsigmoid_f(x.x) * (1.f / 16.f)), expf(logsigmoid_f(x.y) * (1.f / 16.f))};
    }
#else
    for (int ch = F.vcu; ch < BATCH * 32 * GL_H; ch += F.G) gla_prep_chunk(F, ch);
#endif
}

__device__ __forceinline__ void p3_scan_naive(Frame& F, const int wg) {
    LAS float* sh = (LAS float*)(F.lds + RING_OFF);
    const int tid = F.tid;
    if (wg < 32) {
        const int sub = tid >> 8, tt = tid & 255, e = tt >> 1, half = tt & 1, bh = wg * 2 + sub, b = bh >> 4, h = bh & 15;
        const float* QF = (const float*)(F.ws + WS_QF); const float* KF = (const float*)(F.ws + WS_KF); const float* VF = (const float*)(F.ws + WS_VF);
        const float* BETA = (const float*)(F.ws + WS_BETA); const float* GD = (const float*)(F.ws + WS_G); float* ODN = (float*)(F.ws + WS_ODN);
        float S[64];
#pragma unroll
        for (int d = 0; d < 64; ++d) S[d] = 0.f;
        const float* KQ = (tt < 128) ? KF : QF;
        size_t o = (size_t)(b * SEQ) * DN_KEY + h * 128; int gi = (b * SEQ) * DN_H + h;
        float kqr = KQ[o + (tt & 127)], vr = VF[o + e], be = BETA[gi], gg = GD[gi];
        for (int t = 0; t < SEQ; ++t) {
            LAS float* kq = sh + ((t & 1) * 2 + sub) * 256;
            kq[tt] = kqr; const float v = vr, beta = be, decay = expf(gg); const size_t oc = o;
            if (t + 1 < SEQ) { o += DN_KEY; gi += DN_H; kqr = KQ[o + (tt & 127)]; vr = VF[o + e]; be = BETA[gi]; gg = GD[gi]; }
            __syncthreads();
            const LAS float* kp = kq + 64 * half; const LAS float* qp = kq + 128 + 64 * half;
            float ks0 = 0.f, ks1 = 0.f, ks2 = 0.f, ks3 = 0.f;
#pragma unroll
            for (int d = 0; d < 64; d += 4) { const f32x4 k4 = *(const LAS f32x4*)(kp + d); ks0 += k4.x * S[d]; ks1 += k4.y * S[d + 1]; ks2 += k4.z * S[d + 2]; ks3 += k4.w * S[d + 3]; }
            float ks = (ks0 + ks1) + (ks2 + ks3); ks += __shfl_xor(ks, 1);
            const float delta = beta * (v - decay * ks);
            float o0 = 0.f, o1 = 0.f, o2 = 0.f, o3 = 0.f;
#pragma unroll
            for (int d = 0; d < 64; d += 4) { const f32x4 k4 = *(const LAS f32x4*)(kp + d); const f32x4 q4 = *(const LAS f32x4*)(qp + d);
                S[d] = k4.x * delta + decay * S[d]; S[d + 1] = k4.y * delta + decay * S[d + 1]; S[d + 2] = k4.z * delta + decay * S[d + 2]; S[d + 3] = k4.w * delta + decay * S[d + 3];
                o0 += q4.x * S[d]; o1 += q4.y * S[d + 1]; o2 += q4.z * S[d + 2]; o3 += q4.w * S[d + 3]; }
            float ov = (o0 + o1) + (o2 + o3); ov += __shfl_xor(ov, 1);
            if (half == 0) ODN[oc + e] = ov;
        }
    } else if (wg < 64) {
        const int e = tid >> 1, half = tid & 1, bh = wg - 32, b = bh >> 3, h = bh & 7;
        const bf16* PROJ = (const bf16*)(F.ws + WS_PROJ); const float* EK = (const float*)(F.ws + WS_EK); float* OGLA = (float*)(F.ws + WS_OGLA);
        float S[64];
#pragma unroll
        for (int d = 0; d < 64; ++d) S[d] = 0.f;
        const int ee = tid & 127, role = tid >> 7;
        size_t tg = (size_t)b * SEQ;
        float a0 = (role == 0) ? EK[tg * GL_KEY + h * 128 + ee] : (role == 1) ? bf1(PROJ[tg * PN + PC_GK + h * 128 + ee]) : bf1(PROJ[tg * PN + PC_GQ + h * 128 + ee]) * 0.08838834764831845f;
        float vr = bf1(PROJ[tg * PN + PC_GV + h * 256 + e]);
        for (int t = 0; t < SEQ; ++t) {
            LAS float* buf = sh + (t & 1) * 384;
            if (role < 3) buf[tid] = a0;
            const float v = vr; const size_t tc = tg;
            if (t + 1 < SEQ) { ++tg; a0 = (role == 0) ? EK[tg * GL_KEY + h * 128 + ee] : (role == 1) ? bf1(PROJ[tg * PN + PC_GK + h * 128 + ee]) : bf1(PROJ[tg * PN + PC_GQ + h * 128 + ee]) * 0.08838834764831845f;
                vr = bf1(PROJ[tg * PN + PC_GV + h * 256 + e]); }
            __syncthreads();
            const LAS float* gp = buf + 64 * half;
            float o0 = 0.f, o1 = 0.f, o2 = 0.f, o3 = 0.f;
#pragma unroll
            for (int d = 0; d < 64; d += 4) { const f32x4 g4 = *(const LAS f32x4*)(gp + d); const f32x4 k4 = *(const LAS f32x4*)(gp + 128 + d); const f32x4 q4 = *(const LAS f32x4*)(gp + 256 + d);
                S[d] = g4.x * S[d] + k4.x * v; S[d + 1] = g4.y * S[d + 1] + k4.y * v; S[d + 2] = g4.z * S[d + 2] + k4.z * v; S[d + 3] = g4.w * S[d + 3] + k4.w * v;
                o0 += q4.x * S[d]; o1 += q4.y * S[d + 1]; o2 += q4.z * S[d + 2]; o3 += q4.w * S[d + 3]; }
            float ov = (o0 + o1) + (o2 + o3); ov += __shfl_xor(ov, 1);
            if (half == 0) OGLA[tc * GL_VAL + h * 256 + e] = ov;
        }
    }
}

__device__ __forceinline__ void p4_gated_norm(Frame& F) {
    const int gw = F.vcu * NWAVES + F.wave, NGW = F.G * NWAVES, lane = F.lane;
    const bf16* PROJ = (const bf16*)(F.ws + WS_PROJ); const float* ODN = (const float*)(F.ws + WS_ODN); const float* OGLA = (const float*)(F.ws + WS_OGLA);
    bf16* ONDN = (bf16*)(F.ws + WS_ONDN); bf16* ONGLA = (bf16*)(F.ws + WS_ONGLA);
    const f32x2 wd = *(const GAS f32x2*)(F.in[I_DN_NORM] + 2 * lane); const f32x4 wg = *(const GAS f32x4*)(F.in[I_GL_NORM] + 4 * lane);
    for (int tg = gw; tg < M; tg += NGW) {
        f32x2 v[16]; unsigned z[16]; f32x4 u[8]; v2u r[8];
#pragma unroll
        for (int h = 0; h < 16; ++h) { v[h] = *(const GAS f32x2*)(ODN + (size_t)tg * DN_VAL + h * 128 + 2 * lane); z[h] = *(const GAS unsigned*)(PROJ + (size_t)tg * PN + PC_Z + h * 128 + 2 * lane); }
#pragma unroll
        for (int h = 0; h < 8; ++h) { u[h] = *(const GAS f32x4*)(OGLA + (size_t)tg * GL_VAL + h * 256 + 4 * lane); r[h] = *(const GAS v2u*)(PROJ + (size_t)tg * PN + PC_GR + h * 256 + 4 * lane); }
#pragma unroll
        for (int h = 0; h < 16; ++h) { const float rstd = 1.0f / sqrtf(wave_sum(v[h].x * v[h].x + v[h].y * v[h].y) * (1.f / 128.f) + EPS);
            *(GAS unsigned*)(ONDN + (size_t)tg * LDK2 + h * 128 + 2 * lane) = pk2(v[h].x * rstd * wd.x * silu_fast(bflo(z[h])), v[h].y * rstd * wd.y * silu_fast(bfhi(z[h]))); }
#pragma unroll
        for (int h = 0; h < 8; ++h) { const float rstd = 1.0f / sqrtf(wave_sum((u[h].x * u[h].x + u[h].y * u[h].y) + (u[h].z * u[h].z + u[h].w * u[h].w)) * (1.f / 256.f) + EPS);
            v2u ob; ob.x = pk2(u[h].x * rstd * wg.x * silu_fast(bflo(r[h].x)), u[h].y * rstd * wg.y * silu_fast(bfhi(r[h].x))); ob.y = pk2(u[h].z * rstd * wg.z * silu_fast(bflo(r[h].y)), u[h].w * rstd * wg.w * silu_fast(bfhi(r[h].y)));
            *(GAS v2u*)(ONGLA + (size_t)tg * LDK2 + h * 256 + 4 * lane) = ob; }
    }
}

__device__ __forceinline__ void p9_glu_fixup(Frame& F) {
    bf16* HID = (bf16*)(F.ws + WS_HID); const float* GTAIL = (const float*)(F.ws + WS_GTAIL); const float* GHEAD = (const float*)(F.ws + WS_GHEAD); const float* UHEAD = (const float*)(F.ws + WS_UHEAD);
    const float* cw = F.in[I_FFN_CW]; const float* cb = F.in[I_FFN_CB];
    const int gt = F.vcu * (NWAVES * 64) + F.tid, NT = F.G * NWAVES * 64;
    constexpr int CG = DFF / 4;
    for (int id = gt; id < (M / 256) * 2 * CG; id += NT) {
        const int pm = id / (2 * CG), rr = (id / CG) & 1, c0 = 4 * (id % CG);
        const bool first = (pm & 7) == 0;
        const f32x4 z = (f32x4){0.f, 0.f, 0.f, 0.f};
        const f32x4 t0 = first ? z : *(const GAS f32x4*)(GTAIL + ((size_t)(first ? 0 : pm - 1) * 2 + 0) * DFF + c0), t1 = first ? z : *(const GAS f32x4*)(GTAIL + ((size_t)(first ? 0 : pm - 1) * 2 + 1) * DFF + c0);
        const f32x4 h0 = *(const GAS f32x4*)(GHEAD + ((size_t)pm * 2 + 0) * DFF + c0), h1 = *(const GAS f32x4*)(GHEAD + ((size_t)pm * 2 + 1) * DFF + c0);
        const f32x4 up = *(const GAS f32x4*)(UHEAD + ((size_t)pm * 2 + rr) * DFF + c0);
        const f32x4 w0 = *(const GAS f32x4*)(cw + c0), w1 = *(const GAS f32x4*)(cw + DFF + c0), w2 = *(const GAS f32x4*)(cw + 2 * DFF + c0), bb = *(const GAS f32x4*)(cb + c0);
        const f32x4 g2 = rr ? t1 : t0, g1 = rr ? h0 : t1, g0 = rr ? h1 : h0;
        const f32x4 y = bb + w0 * g2 + w1 * g1 + w2 * g0;
        v2u o; o.x = pk2(silu_fast(y.x) * up.x, silu_fast(y.y) * up.y); o.y = pk2(silu_fast(y.z) * up.z, silu_fast(y.w) * up.w);
        *(GAS v2u*)(HID + (size_t)(pm * 256 + rr) * DFF + c0) = o;
    }
}

#ifndef MK_ONE_LAUNCH
#define MK_ONE_LAUNCH 0
#endif
constexpr int N_PHASES = 12;
struct Args { const float* in[19]; float* out; unsigned char* ws; int ph_lo, ph_hi; };
__global__ void __launch_bounds__(NWAVES * 64, 2) mk_fwd(Args args) {
    extern __shared__ __attribute__((aligned(16))) unsigned char lds[];
    Frame F;
    F.lds = (LAS unsigned char*)lds;
    F.MISC = (volatile LAS unsigned*)(F.lds + MISC_OFF);
    F.tid = threadIdx.x; F.lane = F.tid & 63; F.wave = __builtin_amdgcn_readfirstlane(F.tid >> 6);
    F.G = gridDim.x; { const int bx = blockIdx.x; F.vcu = (F.G % 8 == 0) ? (bx % 8) * (F.G / 8) + bx / 8 : bx; }
    for (int u = F.tid; u < (LDS_BYTES - LDSCTL_OFF) / 4; u += NWAVES * 64) ((LAS unsigned*)(F.lds + LDSCTL_OFF))[u] = 0u;
    __syncthreads();
    if (F.tid == 0) { LAS unsigned long long* P = (LAS unsigned long long*)(F.lds + PTR_OFF);
#pragma unroll
        for (int i = 0; i < 19; ++i) P[i] = (unsigned long long)args.in[i];
        P[19] = (unsigned long long)args.out; P[20] = (unsigned long long)args.ws; }
    __syncthreads();
    frame_reload(F);
    XcdBarrier bar; bar.bar = (unsigned*)(F.ctl + CW_BAR); bar.x = 0; bar.st = nullptr;
    if (MK_ONE_LAUNCH) bar = xcd_barrier_post((unsigned*)(F.ctl + CW_BAR), F.MISC + 8);
    const int lo = args.ph_lo, hi = args.ph_hi;
#define IN(k) (lo <= (k) && (k) < hi)
#define SEAM(k) do { if (IN(k) && IN((k) + 1) && (k) != 7) xcd_barrier(bar); } while (0)

#ifndef PROBE_MASK
#define PROBE_MASK 0
#endif
#define RUN_PHASE(k, ...) do { if (IN(k)) { frame_reload(F); bf16* H = (bf16*)(F.ws + WS_H); bf16* PROJ = (bf16*)(F.ws + WS_PROJ); (void)H; (void)PROJ; __VA_ARGS__ } if ((PROBE_MASK >> (k)) & 1) { if (IN(k)) { frame_reload(F); bf16* H = (bf16*)(F.ws + WS_H); bf16* PROJ = (bf16*)(F.ws + WS_PROJ); (void)H; (void)PROJ; __VA_ARGS__ } } } while (0)
    RUN_PHASE(0, p0_prologue(F);); SEAM(0);
    RUN_PHASE(1,
        p1_skinny(F);
        pg8::Gemm g{H, (const bf16*)(F.ws + WS_WIN), M, PN, D, LDK4}; pg8::StaticOrder S; S.init(M, PN, F.G, (int)blockIdx.x);
        pg8::Epi<pg8::EPI_BF16> E{PROJ, PN, nullptr, 0, nullptr, 0, nullptr, 0, nullptr, 0};
        pg8::gemm_phase<pg8::Epi<pg8::EPI_BF16>, pg8::StaticOrder, true, true>(F.lds + RING_OFF, g, S, E);
    ); SEAM(1);
    RUN_PHASE(2, p2_prep(F);); SEAM(2);
    RUN_PHASE(3,
        for (int task = F.vcu; task < 256; task += F.G) {
            if (task < 128) {
#if CHUNK_DN
                scan_task<true>(F, task >> 1, task & 1);
#else
                if (task < 32) p3_scan_naive(F, task);
#endif
            } else {
#if CHUNK_GLA
                scan_task<false>(F, (task - 128) >> 2, (task - 128) & 3);
#else
                if (task < 160) p3_scan_naive(F, task - 96);
#endif
            }
        }
    ); SEAM(3);
    RUN_PHASE(4, p4_gated_norm(F);); SEAM(4);
    RUN_PHASE(5,
        { pg8::Gemm g{(const bf16*)(F.ws + WS_ONDN), (const bf16*)(F.ws + WS_WBDN), M, D, DN_VAL, LDK2}; pg8::StaticOrder S; S.init(M, D, F.G, (int)blockIdx.x);
          pg8::Epi<pg8::EPI_BRA> E{nullptr, 0, nullptr, 0, nullptr, 0, PROJ + PC_GATE_DN, PN, (bf16*)(F.ws + WS_TMP), D};
          pg8::gemm_phase<pg8::Epi<pg8::EPI_BRA>, pg8::StaticOrder, true, true>(F.lds + RING_OFF, g, S, E); }
        { pg8::Gemm g{(const bf16*)(F.ws + WS_ONGLA), (const bf16*)(F.ws + WS_WBGLA), M, D, GL_VAL, LDK2}; pg8::StaticOrder S; S.init(M, D, F.G, (int)blockIdx.x);
          pg8::Epi<pg8::EPI_BRB> E{(bf16*)(F.ws + WS_MERGED), LDK4, nullptr, 0, nullptr, 0, PROJ + PC_GATE_GLA, PN, (bf16*)(F.ws + WS_TMP), D};
          pg8::gemm_phase<pg8::Epi<pg8::EPI_BRB>, pg8::StaticOrder, true, true>(F.lds + RING_OFF, g, S, E); }
    ); SEAM(5);
    RUN_PHASE(6,
        pg8::Gemm g{(const bf16*)(F.ws + WS_MERGED), (const bf16*)(F.ws + WS_WOUT), M, D, D, LDK4}; pg8::StaticOrder S; S.init(M, D, F.G, (int)blockIdx.x);
        pg8::EpiRes2 E{H, F.in[I_X], D, LDK4, (unsigned long long*)(F.ws + WS_SSQ)};
        pg8::gemm_phase<pg8::EpiRes2, pg8::StaticOrder, true, true>(F.lds + RING_OFF, g, S, E);
    ); SEAM(6);
    RUN_PHASE(8,
        pg8::Gemm g{H, (const bf16*)(F.ws + WS_WFIN), M, NGU, D, LDK4}; pg8::StaticOrder S; S.init(M, NGU, F.G, (int)blockIdx.x);
        pg8::EpiGlu E{(bf16*)(F.ws + WS_HID), DFF, F.in[I_FFN_CW], F.in[I_FFN_CB], DFF, (float*)(F.ws + WS_GTAIL), (float*)(F.ws + WS_GHEAD), (float*)(F.ws + WS_UHEAD), (LAS float*)(F.lds + XL_OFF), (const unsigned long long*)(F.ws + WS_SSQ)};
        pg8::gemm_phase<pg8::EpiGlu, pg8::StaticOrder, true, true>(F.lds + RING_OFF, g, S, E);
    ); SEAM(8);
    RUN_PHASE(9, p9_glu_fixup(F);); SEAM(9);
    RUN_PHASE(10,
        pg8::Gemm g{(const bf16*)(F.ws + WS_HID), (const bf16*)(F.ws + WS_WFOUT), M, D, DFF, DFF}; pg8::StaticOrder S; S.init(M, D, F.G, (int)blockIdx.x);
        pg8::Epi<pg8::EPI_RES> E{nullptr, 0, F.out, D, H, LDK4, nullptr, 0, nullptr, 0};
        pg8::gemm_phase<pg8::Epi<pg8::EPI_RES>, pg8::StaticOrder, true, true>(F.lds + RING_OFF, g, S, E);
    ); SEAM(10);
    if (IN(11)) { frame_reload(F); const int gw = F.vcu * NWAVES + F.wave, NGW = F.G * NWAVES;
        for (int m = gw; m < M; m += NGW) rms_row(F.out + (size_t)m * D, F.in[I_NORM_FIN], nullptr, F.out + (size_t)m * D, F.lane); }
#undef IN
#undef SEAM
}

extern "C" void kernel_launch(void* const* d_in, const int* in_sizes, int n_in, void* d_out, int out_size, void* d_ws, size_t ws_size, hipStream_t stream) {
    static int grid = 0;
    if (grid == 0) {
        if (n_in != 19 || in_sizes[0] != M * D || out_size != M * D || ws_size < WS_END) { fprintf(stderr, "kernel_launch: unexpected shapes: n_in %d in0 %d out %d ws %zu (need %zu)\n", n_in, n_in > 0 ? in_sizes[0] : -1, out_size, ws_size, (size_t)WS_END); grid = -1; return; }
        int dev = 0, cus = 0, per_cu = 0;
        if (hipGetDevice(&dev) != hipSuccess || hipDeviceGetAttribute(&cus, hipDeviceAttributeMultiprocessorCount, dev) != hipSuccess) { grid = -1; return; }
        if (hipFuncSetAttribute((const void*)mk_fwd, hipFuncAttributeMaxDynamicSharedMemorySize, LDS_BYTES) != hipSuccess) { fprintf(stderr, "kernel_launch: hipFuncSetAttribute failed\n"); grid = -1; return; }
        if (hipOccupancyMaxActiveBlocksPerMultiprocessor(&per_cu, (const void*)mk_fwd, NWAVES * 64, LDS_BYTES) != hipSuccess || per_cu < 1) fprintf(stderr, "kernel_launch: occupancy query says %d\n", per_cu);
        (void)hipGetLastError();
        grid = cus;
    }
    if (grid < 0) return;
    if (hipMemsetAsync((char*)d_ws + WS_CTL, 0, CTL_ZERO_BYTES, stream) != hipSuccess) return;
    Args a{};
    for (int i = 0; i < 19; ++i) a.in[i] = (const float*)d_in[i];
    a.out = (float*)d_out; a.ws = (unsigned char*)d_ws;
#if MK_ONE_LAUNCH
    a.ph_lo = 0; a.ph_hi = N_PHASES;
    hipLaunchKernelGGL(mk_fwd, dim3(grid), dim3(NWAVES * 64), LDS_BYTES, stream, a);
#else
    for (int p = 0; p < N_PHASES; ++p) { a.ph_lo = p; a.ph_hi = p + 1; hipLaunchKernelGGL(mk_fwd, dim3(grid), dim3(NWAVES * 64), LDS_BYTES, stream, a); }
#endif
}
```
